# Optimizing an MI355X kernel written in HIP

```python
import jax, jax.numpy as jnp
from jax import lax
import numpy as np

D_MODEL = 1024
BATCH = 2
SEQ = 8192
DEPTH = 2

GRID_W = 64
CTX_LEN = 256
N_MIXERS = 2
RET_HEADS = 4
RET_QK_DIM = D_MODEL // RET_HEADS
RET_V_DIM = 2 * D_MODEL // RET_HEADS
RET_CHUNK = 128
DECAY_EXP_FWD = 5.0
DECAY_EXP_BWD = 5.5
ROPE_BASE = 10000.0
CONV_WIDTH = 3
FFN_HIDDEN = -(-8 * D_MODEL // (3 * 256)) * 256
N_RET_LAYERS = (DEPTH + N_MIXERS - 1) // N_MIXERS
N_CONV_LAYERS = DEPTH // N_MIXERS
EPS = 1e-6

kernel_name = "hybrid_retention_shortconv_dit"


def rms_norm(x, gain=None):
    xf = x.astype(jnp.float32)
    y = xf * lax.rsqrt(jnp.mean(xf * xf, axis=-1, keepdims=True) + EPS)
    if gain is not None:
        y = y * gain.astype(jnp.float32)
    return y.astype(x.dtype)


def ada_params(cond, w, b):
    return jnp.split(jax.nn.silu(cond) @ w + b, 6, axis=-1)


def modulate(x, shift, scale):
    return x * (1 + scale) + shift


def rope_1d(x, pos):
    n = x.shape[-1] // 2
    freqs = ROPE_BASE ** (-jnp.arange(n, dtype=jnp.float32) / n)
    ang = pos.astype(jnp.float32)[:, None] * freqs[None, :]
    cos, sin = jnp.cos(ang).astype(x.dtype), jnp.sin(ang).astype(x.dtype)
    x1, x2 = x[..., :n], x[..., n:]
    return jnp.concatenate([x1 * cos - x2 * sin, x1 * sin + x2 * cos], axis=-1)


def rope_2d(x, row, col):
    half = x.shape[-1] // 2
    return jnp.concatenate([rope_1d(x[..., :half], row), rope_1d(x[..., half:], col)], axis=-1)


def retention_log_decays():
    h = jnp.arange(RET_HEADS, dtype=jnp.float32)
    lg_f = jnp.log1p(-jnp.exp2(-DECAY_EXP_FWD - h))
    lg_b = jnp.log1p(-jnp.exp2(-DECAY_EXP_BWD - h))
    return lg_f, lg_b


def retention_chunk_scan(q, k, v, log_g, s0):
    bsz, nh, L, _ = q.shape
    dv = v.shape[-1]
    n_chunks = L // RET_CHUNK

    def to_chunks(t):
        return t.reshape(bsz, nh, n_chunks, RET_CHUNK, t.shape[-1]).transpose(2, 0, 1, 3, 4)

    idx = jnp.arange(RET_CHUNK, dtype=jnp.float32)
    diff = idx[:, None] - idx[None, :]
    decay_mat = jnp.where(diff[None] >= 0,
                          jnp.exp(jnp.maximum(diff, 0.0)[None] * log_g[:, None, None]), 0.0)
    q_dec = jnp.exp((idx[None, :] + 1.0) * log_g[:, None])[None, :, :, None]
    k_dec = jnp.exp((RET_CHUNK - 1.0 - idx[None, :]) * log_g[:, None])[None, :, :, None]
    chunk_dec = jnp.exp(RET_CHUNK * log_g)[None, :, None, None]

    def step(s, inp):
        qc, kc, vc = inp
        scores = jnp.einsum('bhid,bhjd->bhij', qc, kc) * decay_mat[None]
        intra = jnp.einsum('bhij,bhje->bhie', scores, vc)
        cross = jnp.einsum('bhid,bhde->bhie', qc * q_dec, s)
        s_new = s * chunk_dec + jnp.einsum('bhjd,bhje->bhde', kc * k_dec, vc)
        return s_new, intra + cross

    _, out = lax.scan(step, s0, (to_chunks(q), to_chunks(k), to_chunks(v)))
    return out.transpose(1, 2, 0, 3, 4).reshape(bsz, nh, L, dv)


def context_state(k, v, log_g, reverse):
    L = k.shape[2]
    j = jnp.arange(L, dtype=jnp.float32)
    dist = j if reverse else (L - 1.0) - j
    w = jnp.exp(dist[None, :] * log_g[:, None])
    return jnp.einsum('bhld,bhle->bhde', k * w[None, :, :, None], v)


def context_parallel(q, k, v, lg_f, lg_b):
    L = q.shape[2]
    idx = jnp.arange(L, dtype=jnp.float32)
    diff = idx[:, None] - idx[None, :]
    d_f = jnp.where(diff[None] >= 0, jnp.exp(jnp.maximum(diff, 0.0)[None] * lg_f[:, None, None]), 0.0)
    d_b = jnp.where(diff[None] <= 0, jnp.exp(jnp.maximum(-diff, 0.0)[None] * lg_b[:, None, None]), 0.0)
    scores = jnp.einsum('bhid,bhjd->bhij', q, k) * (d_f + d_b)[None]
    return jnp.einsum('bhij,bhje->bhie', scores, v)


def retention_output(o, g, w_o):
    bsz, nh, L, dv = o.shape
    o = o * lax.rsqrt(jnp.mean(o * o, axis=-1, keepdims=True) + EPS)
    o = o.transpose(0, 2, 1, 3).reshape(bsz, L, nh * dv).astype(g.dtype)
    return (jax.nn.silu(g) * o) @ w_o


def retention_mixer(ax, ac, w_qkvg, w_o, row, col, with_ctx_out):
    D = D_MODEL
    scale = RET_QK_DIM ** -0.5

    def heads(t, d):
        return t.reshape(t.shape[0], t.shape[1], RET_HEADS, d).transpose(0, 2, 1, 3).astype(jnp.float32)

    qx, kx, vx, gx = jnp.split(ax @ w_qkvg, [D, 2 * D, 4 * D], axis=-1)
    qx = rope_2d(heads(qx, RET_QK_DIM), row, col)
    kx = rope_2d(heads(kx, RET_QK_DIM), row, col) * scale
    vx = heads(vx, RET_V_DIM)

    if with_ctx_out:
        qc, kc, vc, gc = jnp.split(ac @ w_qkvg, [D, 2 * D, 4 * D], axis=-1)
    else:
        kc, vc = jnp.split(ac @ w_qkvg[:, D:4 * D], [D], axis=-1)
    kc = heads(kc, RET_QK_DIM) * scale
    vc = heads(vc, RET_V_DIM)

    lg_f, lg_b = retention_log_decays()
    s_f = context_state(kc, vc, lg_f, reverse=False)
    s_b = context_state(kc, vc, lg_b, reverse=True)

    o_f = retention_chunk_scan(qx, kx, vx, lg_f, s_f)
    o_b = jnp.flip(retention_chunk_scan(jnp.flip(qx, 2), jnp.flip(kx, 2), jnp.flip(vx, 2), lg_b, s_b), 2)
    yx = retention_output(o_f + o_b, gx, w_o)

    yc = None
    if with_ctx_out:
        yc = retention_output(context_parallel(heads(qc, RET_QK_DIM), kc, vc, lg_f, lg_b), gc, w_o)
    return yx, yc


def short_conv(u, w):
    return lax.conv_general_dilated(
        u, w[:, None, :].astype(u.dtype), window_strides=(1,),
        padding=[(CONV_WIDTH // 2, CONV_WIDTH // 2)],
        dimension_numbers=('NWC', 'WIO', 'NWC'), feature_group_count=u.shape[-1])


def conv_mixer(h, w_in, w_conv, w_out):
    b_gate, c_gate, xv = jnp.split(h @ w_in, 3, axis=-1)
    return (b_gate * short_conv(c_gate * xv, w_conv)) @ w_out


def swiglu(h, w1, w3, w2):
    return (jax.nn.silu(h @ w1) * (h @ w3)) @ w2


def setup_inputs(seed: int = 0) -> dict:
    key = jax.random.key(seed)
    ks = jax.random.split(key, 20)
    D, F = D_MODEL, FFN_HIDDEN
    nrm = jax.random.normal
    f32 = jnp.float32
    return {
        "x": nrm(ks[0], (BATCH, SEQ, D), f32),
        "c": nrm(ks[1], (BATCH, D), f32),
        "ctx": nrm(ks[2], (BATCH, CTX_LEN, D), f32),
        "c_ctx": nrm(ks[3], (D,), f32),
        "ada_w": nrm(ks[4], (DEPTH, D, 6 * D), f32) * (0.5 * D ** -0.5),
        "ada_b": nrm(ks[5], (DEPTH, 6 * D), f32) * 0.02,
        "norm_mix": 1.0 + 0.02 * nrm(ks[6], (DEPTH, D), f32),
        "norm_ffn": 1.0 + 0.02 * nrm(ks[7], (DEPTH, D), f32),
        "ret_w_qkvg": nrm(ks[8], (N_RET_LAYERS, D, 6 * D), f32) * D ** -0.5,
        "ret_w_o": nrm(ks[9], (N_RET_LAYERS, 2 * D, D), f32) * (2 * D) ** -0.5,
        "conv_w_in": nrm(ks[10], (N_CONV_LAYERS, D, 3 * D), f32) * D ** -0.5,
        "conv_w": nrm(ks[11], (N_CONV_LAYERS, CONV_WIDTH, D), f32) * CONV_WIDTH ** -0.5,
        "conv_w_out": nrm(ks[12], (N_CONV_LAYERS, D, D), f32) * D ** -0.5,
        "ffn_w1": nrm(ks[13], (DEPTH, D, F), f32) * D ** -0.5,
        "ffn_w3": nrm(ks[14], (DEPTH, D, F), f32) * D ** -0.5,
        "ffn_w2": nrm(ks[15], (DEPTH, F, D), f32) * F ** -0.5,
        "final_norm": 1.0 + 0.02 * nrm(ks[16], (D,), f32),
    }


def reference(x, c, ctx, c_ctx, ada_w, ada_b, norm_mix, norm_ffn, ret_w_qkvg, ret_w_o,
              conv_w_in, conv_w, conv_w_out, ffn_w1, ffn_w3, ffn_w2, final_norm):
    T = x.shape[1]
    rows = T // GRID_W
    row = jnp.repeat(jnp.arange(rows, dtype=jnp.int32), GRID_W)
    col = jnp.tile(jnp.arange(GRID_W, dtype=jnp.int32), rows)

    hx, hc = x, ctx
    for i in range(DEPTH):
        mixer = i % N_MIXERS
        ctx_needed = any(j % N_MIXERS == 0 for j in range(i + 1, DEPTH))
        sh1, sc1, g1, sh2, sc2, g2 = [t[:, None, :] for t in ada_params(c, ada_w[i], ada_b[i])]
        ax = modulate(rms_norm(hx, norm_mix[i]), sh1, sc1)
        if mixer == 0 or ctx_needed:
            csh1, csc1, cg1, csh2, csc2, cg2 = ada_params(c_ctx, ada_w[i], ada_b[i])
            ac = modulate(rms_norm(hc, norm_mix[i]), csh1, csc1)

        if mixer == 0:
            r = i // N_MIXERS
            yx, yc = retention_mixer(ax, ac, ret_w_qkvg[r], ret_w_o[r], row, col, ctx_needed)
        else:
            r = i // N_MIXERS
            yx = conv_mixer(ax, conv_w_in[r], conv_w[r], conv_w_out[r])
            yc = conv_mixer(ac, conv_w_in[r], conv_w[r], conv_w_out[r]) if ctx_needed else None

        hx = hx + g1 * yx
        fx = modulate(rms_norm(hx, norm_ffn[i]), sh2, sc2)
        hx = hx + g2 * swiglu(fx, ffn_w1[i], ffn_w3[i], ffn_w2[i])

        if ctx_needed:
            hc = hc + cg1 * yc
            fc = modulate(rms_norm(hc, norm_ffn[i]), csh2, csc2)
            hc = hc + cg2 * swiglu(fc, ffn_w1[i], ffn_w3[i], ffn_w2[i])

    return rms_norm(hx, final_norm)
```

```cpp
#include <hip/hip_runtime.h>
#include <cstdio>
#include <cstdint>

#define LAS __attribute__((address_space(3)))
#define GAS __attribute__((address_space(1)))
typedef unsigned short bf16;
typedef short bf16x8 __attribute__((ext_vector_type(8)));
typedef float f32x4 __attribute__((ext_vector_type(4)));
typedef float f32x2 __attribute__((ext_vector_type(2)));
typedef unsigned u32x4 __attribute__((ext_vector_type(4)));
typedef unsigned u32x2 __attribute__((ext_vector_type(2)));

__device__ __forceinline__ int opaque(int v) { asm volatile("" : "+v"(v)); return v; }
constexpr int D = 1024, BATCH = 2, SEQ = 8192, M = BATCH * SEQ, CTXL = 256, MC = BATCH * CTXL, NH = 4, DK = 256, DV = 512, FF = 2816, NQ = 6 * D;
constexpr int SC = 512, NSC = SEQ / SC;
constexpr float EPS = 1e-6f;
constexpr int NWAVES = 8, NTHR = 512;

constexpr size_t MiB = 1u << 20, HMiB = 1u << 19;
constexpr size_t WS_CTL = 0, CTL_ZERO_BYTES = 1 * MiB;
constexpr size_t CTL_ADA = 65536;
constexpr size_t WS_MISC = 1 * MiB;
constexpr size_t MS_ROPE = WS_MISC;
constexpr size_t MS_RSTDX = MS_ROPE + 65536;
constexpr size_t MS_RSTDC = MS_RSTDX + 65536;
constexpr size_t MS_BIAS1 = MS_RSTDC + 4096;
constexpr int NKQ = 8;
constexpr size_t MS_BIAS3 = 262144;
constexpr size_t MS_BIAS5 = MS_BIAS1 + 3 * 6144 * 4;
static_assert(MS_BIAS3 + 4 * NKQ * 5632 * 4 <= 1 * MiB && MS_BIAS5 + 2 * NKQ * 3072 * 4 <= 1 * MiB + 512 * 1024, "misc region");
constexpr size_t MS_XPART = 1 * MiB + 512 * 1024;
constexpr size_t WS_SSQ = 2 * MiB;
constexpr size_t WS_WQKVG = 3 * MiB;
constexpr size_t WS_WO = 15 * MiB;
constexpr size_t WS_W2_0 = 19 * MiB;
constexpr size_t WS_W2_1 = 24 * MiB + HMiB;
constexpr size_t WS_WCO = 30 * MiB;
constexpr size_t WS_ACB = 60 * MiB;
constexpr size_t WS_XB = 61 * MiB;
constexpr size_t WS_Q = 93 * MiB;
constexpr size_t WS_K = 125 * MiB;
constexpr size_t WS_VT = 157 * MiB;
constexpr size_t WS_SB = 221 * MiB;
constexpr size_t WS_KC = 253 * MiB;
constexpr size_t WS_VCT = 254 * MiB;
constexpr size_t WS_SF = WS_XB;
constexpr size_t WS_HID = 93 * MiB;
constexpr size_t WS_CU = 93 * MiB, WS_CB = 125 * MiB, WS_ACV = 157 * MiB;
constexpr size_t WS_W13_0 = 181 * MiB;
constexpr size_t WS_WCI = 203 * MiB;
constexpr size_t WS_W13_1 = 215 * MiB;
constexpr size_t WS_END = 256 * MiB;

namespace pg8 {
typedef unsigned short bf16_t;
constexpr int BM = 256, BK = 64, HALF = 128, HTB = HALF * BK * 2, STAGE_BYTES = 8 * HTB, NXCD = 8, WGM = 8;
__host__ __device__ __forceinline__ int lds_byte(int r, int c) { const int st = (r >> 4) * 2 + (c >> 5), rr = r & 15, cc = c & 31, ob = rr * 64 + cc * 2; return st * 1024 + (ob ^ (((ob >> 9) & 1) << 5)); }
__host__ __device__ __forceinline__ void stage_rc(int b, int& R, int& C) { const int st = b / 1024, sb = b % 1024, swz = sb ^ (((sb >> 9) & 1) << 5); R = (st >> 1) * 16 + swz / 64; C = (st & 1) * 32 + (swz % 64) / 2; }
__host__ __device__ __forceinline__ int perm32(int rho) { const int n = rho >> 4, i = rho & 15; return 8 * (i >> 2) + 4 * n + (i & 3); }
struct Unit { int pm, pn; };
struct Gemm { const bf16_t* A; const bf16_t* Bt; int M, N, K; size_t bstride; };
struct StaticOrder {
    int nM, nN, nwg, G, c;
    __host__ __device__ void init(int M_, int N_, int G_, int c_) { nM = M_ / BM; nN = N_ / BM; nwg = nM * nN; G = G_; c = c_; }
    __host__ __device__ bool next(int i, Unit& u) const {
        const long L = (long)i * G + c; if (L >= nwg) return false;
        int wgid = (int)L; { const int q = nwg / NXCD, r = nwg % NXCD, xcd = wgid % NXCD, off = wgid / NXCD; wgid = (xcd < r ? xcd * (q + 1) : r * (q + 1) + (xcd - r) * q) + off; }
        const int nig = WGM * nN, gid = wgid / nig, fm = gid * WGM, gsz = (nM - fm) < WGM ? (nM - fm) : WGM;
        u.pm = fm + ((wgid % nig) % gsz); u.pn = (wgid % nig) / gsz; return true;
    }
    __device__ __forceinline__ void a_ready(const Unit&) const {}
    __device__ __forceinline__ void done(const Unit&) const {}
};
struct OneUnit { int pm, pn; bool have;
    __device__ __forceinline__ bool next(int i, Unit& u) const { if (i != 0 || !have) return false; u.pm = pm; u.pn = pn; return true; }
    __device__ __forceinline__ void a_ready(const Unit&) const {}
    __device__ __forceinline__ void done(const Unit&) const {}
};
template <class Epi, class Sched, bool ALIGN_EPI, bool SP2, bool SWAP>
__device__ __forceinline__ void gemm_phase(LAS unsigned char* lds, const Gemm g, const Sched& S, const Epi& E, const int tid) {
    const int wid = __builtin_amdgcn_readfirstlane(tid >> 6), lane = tid & 63, wr = wid >> 2, wc = wid & 3, fr = lane & 15, fq = lane >> 4;
    const int K = g.K, nt = K / BK;
    unsigned voffA[2], voffB[2];
#pragma unroll
    for (int i = 0; i < 2; ++i) { int R, C; stage_rc(tid * 16 + i * 8192, R, C); const int Rp = (R & ~31) + perm32(R & 31);
        voffA[i] = (unsigned)((SWAP ? Rp : R) * K + C) * 2u; voffB[i] = (unsigned)((SWAP ? R : Rp) * K + C) * 2u; }
    const size_t kstep = (size_t)(BK * 2);
    const size_t hstep = (size_t)HALF * K * 2;
    const size_t tstep = 2 * hstep;
    const unsigned ldsw = (unsigned)wid * 1024u;
    const int aoff = lds_byte(wr * 64 + fr, fq * 8), boff = lds_byte(wc * 32 + fr, fq * 8);
#define PG8_SA(b, h) (((b) * 2 + (h)) * HTB)
#define PG8_SB(b, h) ((4 + (b) * 2 + (h)) * HTB)
#define PG8_STAGE(bufoff, gbase, voff) do { _Pragma("unroll") for (int _i = 0; _i < 2; ++_i) \
        __builtin_amdgcn_global_load_lds((const unsigned*)((const char*)(gbase) + (voff)[_i]), (LAS unsigned*)(lds + (bufoff) + ldsw + _i * 8192), 16, 0, 0); } while (0)
#define PG8_LDA(dst, b, h) do { _Pragma("unroll") for (int m = 0; m < 4; ++m) _Pragma("unroll") for (int k = 0; k < 2; ++k) dst[m][k] = *(const LAS bf16x8*)(lds + PG8_SA(b, h) + aoff + m * 2048 + k * 1024); } while (0)
#define PG8_LDB(dst, b, h) do { _Pragma("unroll") for (int n = 0; n < 2; ++n) _Pragma("unroll") for (int k = 0; k < 2; ++k) dst[n][k] = *(const LAS bf16x8*)(lds + PG8_SB(b, h) + boff + n * 2048 + k * 1024); } while (0)
#define PG8_MMA(ai, bj, At, Bt) do { __builtin_amdgcn_s_setprio(1); _Pragma("unroll") for (int m = 0; m < 4; ++m) _Pragma("unroll") for (int n = 0; n < 2; ++n) _Pragma("unroll") for (int k = 0; k < 2; ++k) \
        acc[ai][bj][m][n] = SWAP ? __builtin_amdgcn_mfma_f32_16x16x32_bf16(At[m][k], Bt[n][k], acc[ai][bj][m][n], 0, 0, 0) \
                                 : __builtin_amdgcn_mfma_f32_16x16x32_bf16(Bt[n][k], At[m][k], acc[ai][bj][m][n], 0, 0, 0); __builtin_amdgcn_s_setprio(0); } while (0)
#define PG8_WAIT_V(n) asm volatile("s_waitcnt vmcnt(" #n ")" ::: "memory")
#define PG8_WAIT_L(n) asm volatile("s_waitcnt lgkmcnt(" #n ")" ::: "memory")
#define PG8_BAR __builtin_amdgcn_s_barrier()
#define PG8_SCHED __builtin_amdgcn_sched_barrier(0)
    Unit cur, nxt; int ui = 0;
    if (!S.next(0, cur)) return;
    f32x4 acc[2][2][4][2];
#pragma unroll
    for (int a = 0; a < 2; ++a)
#pragma unroll
        for (int b = 0; b < 2; ++b)
#pragma unroll
            for (int m = 0; m < 4; ++m)
#pragma unroll
                for (int n = 0; n < 2; ++n) acc[a][b][m][n] = (f32x4){0.f, 0.f, 0.f, 0.f};
    bf16x8 At[4][2], B0[2][2], B1[2][2];
    const char* cA = (const char*)g.A + (size_t)cur.pm * tstep; const char* cB = (const char*)g.Bt + (size_t)cur.pn * tstep + (cur.pm >= 32 ? g.bstride : 0);
    S.a_ready(cur);
    if constexpr (SP2) {
        PG8_STAGE(PG8_SB(0, 0), cB, voffB); PG8_STAGE(PG8_SB(0, 1), cB + hstep, voffB); PG8_STAGE(PG8_SA(0, 0), cA, voffA); PG8_STAGE(PG8_SA(0, 1), cA + hstep, voffA);
        if (wr == 1) PG8_BAR;
        PG8_WAIT_V(2); PG8_BAR;
        PG8_STAGE(PG8_SB(1, 0), cB + kstep, voffB); PG8_STAGE(PG8_SA(1, 0), cA + kstep, voffA); PG8_STAGE(PG8_SB(1, 1), cB + hstep + kstep, voffB);
        PG8_WAIT_V(6); PG8_BAR;
    } else {
        PG8_STAGE(PG8_SB(0, 0), cB, voffB); PG8_STAGE(PG8_SA(0, 0), cA, voffA); PG8_STAGE(PG8_SB(0, 1), cB + hstep, voffB); PG8_STAGE(PG8_SA(0, 1), cA + hstep, voffA);
        if (wr == 1) PG8_BAR;
        PG8_WAIT_V(4); PG8_BAR;
        PG8_STAGE(PG8_SB(1, 0), cB + kstep, voffB); PG8_STAGE(PG8_SA(1, 0), cA + kstep, voffA); PG8_STAGE(PG8_SB(1, 1), cB + hstep + kstep, voffB);
        PG8_WAIT_V(6); PG8_BAR;
    }
    for (;;) {
        const bool has_next = S.next(ui + 1, nxt);
        const char* nA = has_next ? (const char*)g.A + (size_t)nxt.pm * tstep : cA; const char* nB = has_next ? (const char*)g.Bt + (size_t)nxt.pn * tstep + (nxt.pm >= 32 ? g.bstride : 0) : cB;
        for (int t = 0; t < nt; t += 2) {
            const bool last = (t == nt - 2);
            const char* a1 = cA + (size_t)(t + 1) * kstep;
            const char* a2 = last ? nA : cA + (size_t)(t + 2) * kstep; const char* b2 = last ? nB : cB + (size_t)(t + 2) * kstep;
            const char* a3 = a2 + kstep; const char* b3 = b2 + kstep;
            if (last && has_next) S.a_ready(nxt);
            if constexpr (SP2) {
            PG8_LDB(B0, 0, 0); PG8_LDB(B1, 0, 1); PG8_SCHED; PG8_LDA(At, 0, 0); PG8_STAGE(PG8_SA(1, 1), a1 + hstep, voffA);
            PG8_WAIT_V(8); PG8_WAIT_L(0); PG8_BAR; PG8_MMA(0, 0, At, B0); PG8_MMA(0, 1, At, B1); PG8_BAR; PG8_SCHED;
            PG8_LDA(At, 0, 1); PG8_STAGE(PG8_SB(0, 0), b2, voffB); PG8_STAGE(PG8_SB(0, 1), b2 + hstep, voffB); PG8_STAGE(PG8_SA(0, 0), a2, voffA);
            PG8_WAIT_V(8); PG8_WAIT_L(0); PG8_BAR; PG8_MMA(1, 0, At, B0); PG8_MMA(1, 1, At, B1); PG8_BAR; PG8_SCHED;
            PG8_LDB(B0, 1, 0); PG8_LDB(B1, 1, 1); PG8_SCHED; PG8_LDA(At, 1, 0); PG8_STAGE(PG8_SA(0, 1), a2 + hstep, voffA);
            PG8_WAIT_V(8); PG8_WAIT_L(0); PG8_BAR; PG8_MMA(0, 0, At, B0); PG8_MMA(0, 1, At, B1); PG8_BAR; PG8_SCHED;
            PG8_LDA(At, 1, 1); PG8_STAGE(PG8_SB(1, 0), b3, voffB); PG8_STAGE(PG8_SB(1, 1), b3 + hstep, voffB); PG8_STAGE(PG8_SA(1, 0), a3, voffA);
            PG8_WAIT_V(8); PG8_WAIT_L(0); PG8_BAR; PG8_MMA(1, 0, At, B0); PG8_MMA(1, 1, At, B1); PG8_BAR; PG8_SCHED;
            } else {
            PG8_LDB(B0, 0, 0); PG8_SCHED; PG8_LDA(At, 0, 0); PG8_STAGE(PG8_SA(1, 1), a1 + hstep, voffA);
            PG8_WAIT_L(8); PG8_BAR; PG8_WAIT_L(0); PG8_MMA(0, 0, At, B0); PG8_BAR; PG8_SCHED;
            PG8_LDB(B1, 0, 1); PG8_STAGE(PG8_SB(0, 0), b2, voffB);
            PG8_BAR; PG8_WAIT_L(0); PG8_MMA(0, 1, At, B1); PG8_BAR;
            PG8_LDA(At, 0, 1); PG8_STAGE(PG8_SA(0, 0), a2, voffA);
            PG8_BAR; PG8_WAIT_L(0); PG8_MMA(1, 0, At, B0); PG8_BAR; PG8_SCHED;
            PG8_STAGE(PG8_SB(0, 1), b2 + hstep, voffB);
            PG8_WAIT_V(6); PG8_BAR; PG8_MMA(1, 1, At, B1); PG8_BAR;
            PG8_LDB(B0, 1, 0); PG8_SCHED; PG8_LDA(At, 1, 0); PG8_STAGE(PG8_SA(0, 1), a2 + hstep, voffA);
            PG8_WAIT_L(8); PG8_BAR; PG8_WAIT_L(0); PG8_MMA(0, 0, At, B0); PG8_BAR; PG8_SCHED;
            PG8_LDB(B1, 1, 1); PG8_STAGE(PG8_SB(1, 0), b3, voffB);
            PG8_BAR; PG8_WAIT_L(0); PG8_MMA(0, 1, At, B1); PG8_BAR;
            PG8_LDA(At, 1, 1); PG8_STAGE(PG8_SA(1, 0), a3, voffA);
            PG8_BAR; PG8_WAIT_L(0); PG8_MMA(1, 0, At, B0); PG8_BAR; PG8_SCHED;
            PG8_STAGE(PG8_SB(1, 1), b3 + hstep, voffB);
            PG8_WAIT_V(6); PG8_BAR; PG8_MMA(1, 1, At, B1); PG8_BAR;
            }
        }
        if constexpr (ALIGN_EPI) { if (wr == 0) PG8_BAR; }
        E(acc, cur, wr, wc, fr, fq, ui); S.done(cur);
        if (!has_next) break;
#pragma unroll
        for (int a = 0; a < 2; ++a)
#pragma unroll
            for (int b = 0; b < 2; ++b)
#pragma unroll
                for (int m = 0; m < 4; ++m)
#pragma unroll
                    for (int n = 0; n < 2; ++n) acc[a][b][m][n] = (f32x4){0.f, 0.f, 0.f, 0.f};
        cur = nxt; cA = nA; cB = nB; ++ui;
        if constexpr (ALIGN_EPI) { if (wr == 1) PG8_BAR; }
    }
    PG8_WAIT_V(0);
    if constexpr (!ALIGN_EPI) { if (wr == 0) PG8_BAR; }
    PG8_BAR;
#undef PG8_SA
#undef PG8_SB
#undef PG8_STAGE
#undef PG8_LDA
#undef PG8_LDB
#undef PG8_MMA
#undef PG8_WAIT_V
#undef PG8_WAIT_L
#undef PG8_BAR
#undef PG8_SCHED
}
}

#define RLX_AGENT __ATOMIC_RELAXED, __HIP_MEMORY_SCOPE_AGENT
#define LDS_WAIT() asm volatile("s_waitcnt lgkmcnt(0)" ::: "memory")
typedef __bf16 hbf16x2 __attribute__((ext_vector_type(2)));
__device__ __forceinline__ unsigned pk2(float lo, float hi) { const f32x2 v = {lo, hi}; return __builtin_bit_cast(unsigned, __builtin_convertvector(v, hbf16x2)); }
__device__ __forceinline__ unsigned f2bf(float f) { return pk2(f, 0.f) & 0xffffu; }
__device__ __forceinline__ float bf2f(unsigned h) { return __builtin_bit_cast(float, h << 16); }
__device__ __forceinline__ float bflo(unsigned w) { return __builtin_bit_cast(float, w << 16); }
__device__ __forceinline__ float bfhi(unsigned w) { return __builtin_bit_cast(float, w & 0xffff0000u); }
__device__ __forceinline__ float siluf(float x) { return x * __builtin_amdgcn_rcpf(1.0f + __builtin_amdgcn_exp2f(-1.44269504089f * x)); }
__device__ __forceinline__ float wave_sum(float v) {
#pragma unroll
    for (int o = 1; o < 64; o <<= 1) v += __shfl_xor(v, o);
    return v;
}
__device__ __forceinline__ u32x4 pack8(const f32x4 a, const f32x4 b) { u32x4 w; w.x = pk2(a[0], a[1]); w.y = pk2(a[2], a[3]); w.z = pk2(b[0], b[1]); w.w = pk2(b[2], b[3]); return w; }

using pg8::Unit;
typedef f32x4 Acc[2][2][4][2];
struct EpiQKG {
    bf16* Q; bf16* K; bf16* G; const float* rstd; const float* bias;
    __device__ __forceinline__ void operator()(const Acc& acc, const Unit& u, int wr, int wc, int fr_, int fq_, int ui) const {
        const int fr = opaque(fr_), fq = opaque(fq_);
        const int b = u.pm >> 5; const float* bb = bias + b * NQ + u.pn * 256 + wc * 32 + 8 * fq;
        const int row0 = u.pm * 256 + wr * 64 + fr;
        f32x4 bv[2][2]; float rs[2][4];
#pragma unroll
        for (int ai = 0; ai < 2; ++ai)
#pragma unroll
            for (int m = 0; m < 4; ++m) rs[ai][m] = rstd[row0 + ai * 128 + m * 16];
#pragma unroll
        for (int bj = 0; bj < 2; ++bj)
#pragma unroll
            for (int n = 0; n < 2; ++n) bv[bj][n] = *(const f32x4*)(bb + bj * 128 + 4 * n);
        if (u.pn < 8) {
            const bool isk = u.pn >= 4; bf16* O = isk ? K : Q; const float osc = isk ? 0.0625f : 1.0f;
            const int a = wc >> 1, i0 = (wc & 1) * 32 + 8 * fq, colo = (u.pn & 3) * 256 + wc * 32 + 8 * fq;
            f32x4 frv[2];
#pragma unroll
            for (int n = 0; n < 2; ++n)
#pragma unroll
                for (int j = 0; j < 4; ++j) frv[n][j] = __builtin_amdgcn_exp2f(-(float)(i0 + 4 * n + j) * (13.287712379549449f / 64.0f)) * 0.15915494309189535f;
#pragma unroll
            for (int ai = 0; ai < 2; ++ai)
#pragma unroll
                for (int m = 0; m < 4; ++m) {
                    const int r = row0 + ai * 128 + m * 16; const float rsv = rs[ai][m]; const int t = r & (SEQ - 1); const float pos = (float)(a ? (t & 63) : (t >> 6));
                    f32x4 o1[2], o2[2];
#pragma unroll
                    for (int n = 0; n < 2; ++n) {
                        f32x4 cs, sn;
#pragma unroll
                        for (int j = 0; j < 4; ++j) { const float rv = __builtin_amdgcn_fractf(pos * frv[n][j]); cs[j] = __builtin_amdgcn_cosf(rv); sn[j] = __builtin_amdgcn_sinf(rv); }
                        const f32x4 x1 = acc[ai][0][m][n] * rsv + bv[0][n], x2 = acc[ai][1][m][n] * rsv + bv[1][n];
                        o1[n] = (x1 * cs - x2 * sn) * osc; o2[n] = (x1 * sn + x2 * cs) * osc;
                    }
                    bf16* rowp = O + (size_t)r * D + colo;
                    *(u32x4*)(rowp) = pack8(o1[0], o1[1]); *(u32x4*)(rowp + 128) = pack8(o2[0], o2[1]);
                }
        } else {
            const int colo = (u.pn - 8) * 256 + wc * 32 + 8 * fq;
#pragma unroll
            for (int ai = 0; ai < 2; ++ai)
#pragma unroll
                for (int m = 0; m < 4; ++m) {
                    const int r = row0 + ai * 128 + m * 16; const float rsv = rs[ai][m]; bf16* rowp = G + (size_t)r * 2048 + colo;
#pragma unroll
                    for (int bj = 0; bj < 2; ++bj) *(u32x4*)(rowp + bj * 128) = pack8(acc[ai][bj][m][0] * rsv + bv[bj][0], acc[ai][bj][m][1] * rsv + bv[bj][1]);
                }
        }
    }
};
struct EpiVT {
    bf16* VT; const float* rstd; const float* bias; int ldt; int tiles_per_b; int bias_row;
    __device__ __forceinline__ void operator()(const Acc& acc, const Unit& u, int wr, int wc, int fr_, int fq_, int ui) const {
        const int fr = opaque(fr_), fq = opaque(fq_);
        const int b = u.pm / tiles_per_b, t00 = (u.pm % tiles_per_b) * 256 + wr * 64 + 8 * fq, h = u.pn >> 1, e0 = (u.pn & 1) * 256 + wc * 32 + fr;
        const float* bb = bias + (bias_row < 0 ? b : bias_row) * NQ;
        float bs[2][2];
#pragma unroll
        for (int bj = 0; bj < 2; ++bj)
#pragma unroll
            for (int n = 0; n < 2; ++n) bs[bj][n] = bb[u.pn * 256 + bj * 128 + wc * 32 + n * 16 + fr];
        f32x4 rsv[2][2][2];
#pragma unroll
        for (int ai = 0; ai < 2; ++ai)
#pragma unroll
            for (int mp = 0; mp < 2; ++mp) { const float* rp = rstd + b * ldt + t00 + ai * 128 + mp * 32; rsv[ai][mp][0] = *(const f32x4*)rp; rsv[ai][mp][1] = *(const f32x4*)(rp + 4); }
#pragma unroll
        for (int ai = 0; ai < 2; ++ai)
#pragma unroll
            for (int mp = 0; mp < 2; ++mp) {
                const int tl = t00 + ai * 128 + mp * 32;
                const f32x4 r0 = rsv[ai][mp][0], r1 = rsv[ai][mp][1];
#pragma unroll
                for (int bj = 0; bj < 2; ++bj)
#pragma unroll
                    for (int n = 0; n < 2; ++n) {
                        const f32x4 v0 = acc[ai][bj][2 * mp][n] * r0 + bs[bj][n], v1 = acc[ai][bj][2 * mp + 1][n] * r1 + bs[bj][n];
                        bf16* p = VT + ((size_t)(((b * NH + h) * (ldt >> 7) + (tl >> 7)) * DV + e0 + bj * 128 + n * 16)) * 128 + (tl & 127);
                        *(u32x4*)p = pack8(v0, v1);
                    }
            }
    }
};
struct EpiRes {
    const float* res32; const bf16* res16; bf16* hx; const float* gate; float* ssq; int dry;
    __device__ __forceinline__ void operator()(const Acc& acc, const Unit& u, int wr, int wc, int fr_, int fq_, int ui) const {
        const int fr = opaque(fr_), fq = opaque(fq_);
        const int b = u.pm >> 5, col0 = u.pn * 256 + wc * 32 + 8 * fq, row0 = u.pm * 256 + wr * 64 + fr;
        f32x4 gv[2][2];
#pragma unroll
        for (int bj = 0; bj < 2; ++bj)
#pragma unroll
            for (int n = 0; n < 2; ++n) gv[bj][n] = *(const f32x4*)(gate + b * NQ + col0 + bj * 128 + 4 * n);
#pragma unroll
        for (int am = 0; am < 8; am += 2) {
            f32x4 rv[2][2][2];
            if (res32) {
#pragma unroll
                for (int q = 0; q < 2; ++q)
#pragma unroll
                    for (int bj = 0; bj < 2; ++bj) { const float* p = res32 + (size_t)(row0 + ((am + q) >> 2) * 128 + ((am + q) & 3) * 16) * D + col0 + bj * 128; rv[q][bj][0] = *(const f32x4*)p; rv[q][bj][1] = *(const f32x4*)(p + 4); }
            } else {
                u32x4 rw[2][2];
#pragma unroll
                for (int q = 0; q < 2; ++q)
#pragma unroll
                    for (int bj = 0; bj < 2; ++bj) rw[q][bj] = *(const u32x4*)(res16 + (size_t)(row0 + ((am + q) >> 2) * 128 + ((am + q) & 3) * 16) * D + col0 + bj * 128);
#pragma unroll
                for (int q = 0; q < 2; ++q)
#pragma unroll
                    for (int bj = 0; bj < 2; ++bj) { const u32x4 w = rw[q][bj]; rv[q][bj][0] = (f32x4){bflo(w.x), bfhi(w.x), bflo(w.y), bfhi(w.y)}; rv[q][bj][1] = (f32x4){bflo(w.z), bfhi(w.z), bflo(w.w), bfhi(w.w)}; }
            }
#pragma unroll
            for (int q = 0; q < 2; ++q) {
                const int ai = (am + q) >> 2, m = (am + q) & 3;
                const int r = row0 + ai * 128 + m * 16; const size_t off = (size_t)r * D + col0; float ss = 0.f;
#pragma unroll
                for (int bj = 0; bj < 2; ++bj) {
                    const f32x4 o0 = rv[q][bj][0] + gv[bj][0] * acc[ai][bj][m][0], o1 = rv[q][bj][1] + gv[bj][1] * acc[ai][bj][m][1];
                    ss += (o0[0] * o0[0] + o0[1] * o0[1]) + (o0[2] * o0[2] + o0[3] * o0[3]) + (o1[0] * o1[0] + o1[1] * o1[1]) + (o1[2] * o1[2] + o1[3] * o1[3]);
                    if (!dry) *(u32x4*)(hx + off + bj * 128) = pack8(o0, o1);
                }
                ss += __shfl_xor(ss, 16); ss += __shfl_xor(ss, 32);
                if (fq == 0) ssq[(size_t)r * 16 + u.pn * 4 + wc] = ss;
            }
        }
    }
};
constexpr int CW_PANEL = 8192;
struct EpiResFinal {
    const bf16* res16; float* out; const float* gate; const float* fn; float* xpart; unsigned* cnt; LAS unsigned char* ldsb;
    __device__ __forceinline__ void operator()(Acc& acc, const Unit& u, int wr, int wc, int fr_, int fq_, int ui) const {
        const int fr = opaque(fr_), fq = opaque(fq_), tid = opaque((int)threadIdx.x);
        const int b = u.pm >> 5, col0 = u.pn * 256 + wc * 32 + 8 * fq, row0 = u.pm * 256 + wr * 64 + fr;
        LAS float* part = (LAS float*)ldsb;
        LAS float* rtab = (LAS float*)(ldsb + 4096);
        f32x4 gv[2][2];
#pragma unroll
        for (int bj = 0; bj < 2; ++bj)
#pragma unroll
            for (int n = 0; n < 2; ++n) gv[bj][n] = *(const f32x4*)(gate + b * NQ + col0 + bj * 128 + 4 * n);
#pragma unroll
        for (int am = 0; am < 8; am += 2) {
            u32x4 rw[2][2];
#pragma unroll
            for (int q = 0; q < 2; ++q)
#pragma unroll
                for (int bj = 0; bj < 2; ++bj) rw[q][bj] = *(const u32x4*)(res16 + (size_t)(row0 + ((am + q) >> 2) * 128 + ((am + q) & 3) * 16) * D + col0 + bj * 128);
#pragma unroll
            for (int q = 0; q < 2; ++q) { const int ai = (am + q) >> 2, m = (am + q) & 3; float ss = 0.f;
#pragma unroll
                for (int bj = 0; bj < 2; ++bj) { const u32x4 w = rw[q][bj];
                    const f32x4 o0 = (f32x4){bflo(w.x), bfhi(w.x), bflo(w.y), bfhi(w.y)} + gv[bj][0] * acc[ai][bj][m][0], o1 = (f32x4){bflo(w.z), bfhi(w.z), bflo(w.w), bfhi(w.w)} + gv[bj][1] * acc[ai][bj][m][1];
                    ss += (o0[0] * o0[0] + o0[1] * o0[1]) + (o0[2] * o0[2] + o0[3] * o0[3]) + (o1[0] * o1[0] + o1[1] * o1[1]) + (o1[2] * o1[2] + o1[3] * o1[3]);
                    acc[ai][bj][m][0] = o0; acc[ai][bj][m][1] = o1; }
                ss += __shfl_xor(ss, 16); ss += __shfl_xor(ss, 32);
                if (fq == 0) part[(ai * 128 + wr * 64 + m * 16 + fr) * 4 + wc] = ss; }
        }
        asm volatile("s_waitcnt lgkmcnt(0)" ::: "memory"); __builtin_amdgcn_s_barrier(); asm volatile("" ::: "memory");
        if (tid < 256) { const f32x4 p4 = *(const LAS f32x4*)(part + tid * 4);
            __hip_atomic_store(xpart + (size_t)(u.pm * 256 + tid) * 4 + u.pn, (p4[0] + p4[1]) + (p4[2] + p4[3]), __ATOMIC_RELAXED, __HIP_MEMORY_SCOPE_AGENT); }
        asm volatile("s_waitcnt vmcnt(0)" ::: "memory"); __builtin_amdgcn_s_barrier(); asm volatile("" ::: "memory");
        if (tid == 0) { __hip_atomic_fetch_add(cnt + CW_PANEL + 64 * u.pm, 1u, __ATOMIC_RELAXED, __HIP_MEMORY_SCOPE_AGENT);
            unsigned sp = 0; while (__hip_atomic_load(cnt + CW_PANEL + 64 * u.pm, __ATOMIC_RELAXED, __HIP_MEMORY_SCOPE_AGENT) < 4u) { __builtin_amdgcn_s_sleep(2); if (++sp > (1u << 22)) break; } }
        asm volatile("s_waitcnt vmcnt(0) lgkmcnt(0)" ::: "memory"); __builtin_amdgcn_s_barrier(); asm volatile("" ::: "memory");
        if (tid < 256) { const float* xp = xpart + (size_t)(u.pm * 256 + tid) * 4; float t = 0.f;
#pragma unroll
            for (int q = 0; q < 4; ++q) t += __hip_atomic_load(xp + q, __ATOMIC_RELAXED, __HIP_MEMORY_SCOPE_AGENT);
            rtab[tid] = 1.0f / sqrtf(t * (1.0f / D) + EPS); }
        asm volatile("s_waitcnt vmcnt(0) lgkmcnt(0)" ::: "memory"); __builtin_amdgcn_s_barrier(); asm volatile("" ::: "memory");
        f32x4 fv[2][2];
#pragma unroll
        for (int bj = 0; bj < 2; ++bj)
#pragma unroll
            for (int n = 0; n < 2; ++n) fv[bj][n] = *(const f32x4*)(fn + col0 + bj * 128 + 4 * n);
#pragma unroll
        for (int ai = 0; ai < 2; ++ai)
#pragma unroll
            for (int m = 0; m < 4; ++m) { const float rs = rtab[ai * 128 + wr * 64 + m * 16 + fr]; float* op = out + (size_t)(row0 + ai * 128 + m * 16) * D + col0;
#pragma unroll
                for (int bj = 0; bj < 2; ++bj) { *(f32x4*)(op + bj * 128) = acc[ai][bj][m][0] * rs * fv[bj][0]; *(f32x4*)(op + bj * 128 + 4) = acc[ai][bj][m][1] * rs * fv[bj][1]; } }
    }
};
__device__ __forceinline__ float rstd_from_ssq(const float* ssq, int r) {
    const f32x4* p = (const f32x4*)(ssq + (size_t)r * 16); const f32x4 a = p[0], b = p[1], c = p[2], d = p[3];
    const float s = ((a[0] + a[1]) + (a[2] + a[3])) + ((b[0] + b[1]) + (b[2] + b[3])) + ((c[0] + c[1]) + (c[2] + c[3])) + ((d[0] + d[1]) + (d[2] + d[3]));
    return 1.0f / sqrtf(s * (1.0f / D) + EPS);
}
constexpr int RSTD_LDS = 131072, BIAS_LDS = 131072 + 8192;
struct EpiSwiGLU {
    bf16* HID; const LAS float* rtab; const LAS float* btab; int dry;
    __device__ __forceinline__ void operator()(const Acc& acc, const Unit& u, int wr, int wc, int fr_, int fq_, int ui) const {
        const int fr = opaque(fr_), fq = opaque(fq_); if (dry) return;
        f32x4 bv[2][2]; float rs[2][4];
#pragma unroll
        for (int ai = 0; ai < 2; ++ai)
#pragma unroll
            for (int m = 0; m < 4; ++m) rs[ai][m] = rtab[ui * 256 + ai * 128 + wr * 64 + m * 16 + fr];
#pragma unroll
        for (int bj = 0; bj < 2; ++bj)
#pragma unroll
            for (int n = 0; n < 2; ++n) bv[bj][n] = *(const LAS f32x4*)(btab + ui * 256 + bj * 128 + wc * 32 + 8 * fq + 4 * n);
        const int row0 = u.pm * 256 + wr * 64 + fr, colo = u.pn * 128 + wc * 32 + 8 * fq;
#pragma unroll
        for (int ai = 0; ai < 2; ++ai)
#pragma unroll
            for (int m = 0; m < 4; ++m) {
                const int r = row0 + ai * 128 + m * 16;
                f32x4 hv[2];
#pragma unroll
                for (int n = 0; n < 2; ++n) { const f32x4 a1 = acc[ai][0][m][n] * rs[ai][m] + bv[0][n], a3 = acc[ai][1][m][n] * rs[ai][m] + bv[1][n];
#pragma unroll
                    for (int j = 0; j < 4; ++j) hv[n][j] = siluf(a1[j]) * a3[j]; }
                *(u32x4*)(HID + (size_t)r * FF + colo) = pack8(hv[0], hv[1]);
            }
    }
};
struct EpiConvIn {
    bf16* CU; bf16* CB; const LAS float* rtab; const LAS float* btab;
    __device__ __forceinline__ void operator()(const Acc& acc, const Unit& u, int wr, int wc, int fr_, int fq_, int ui) const {
        const int fr = opaque(fr_), fq = opaque(fq_);
        f32x4 bv[2][2]; float rs[2][4];
#pragma unroll
        for (int ai = 0; ai < 2; ++ai)
#pragma unroll
            for (int m = 0; m < 4; ++m) rs[ai][m] = rtab[ui * 256 + ai * 128 + wr * 64 + m * 16 + fr];
#pragma unroll
        for (int bj = 0; bj < 2; ++bj)
#pragma unroll
            for (int n = 0; n < 2; ++n) bv[bj][n] = *(const LAS f32x4*)(btab + ui * 256 + bj * 128 + wc * 32 + 8 * fq + 4 * n);
        const int row0 = u.pm * 256 + wr * 64 + fr;
#pragma unroll
        for (int ai = 0; ai < 2; ++ai)
#pragma unroll
            for (int m = 0; m < 4; ++m) {
                const int r = row0 + ai * 128 + m * 16; const float rs_ = rs[ai][m];
                if (u.pn < 8) {
                    const f32x4 u0 = (acc[ai][0][m][0] * rs_ + bv[0][0]) * (acc[ai][1][m][0] * rs_ + bv[1][0]), u1 = (acc[ai][0][m][1] * rs_ + bv[0][1]) * (acc[ai][1][m][1] * rs_ + bv[1][1]);
                    *(u32x4*)(CU + (size_t)r * D + u.pn * 128 + wc * 32 + 8 * fq) = pack8(u0, u1);
                } else {
#pragma unroll
                    for (int bj = 0; bj < 2; ++bj) *(u32x4*)(CB + (size_t)r * D + (u.pn - 8) * 256 + bj * 128 + wc * 32 + 8 * fq) = pack8(acc[ai][bj][m][0] * rs_ + bv[bj][0], acc[ai][bj][m][1] * rs_ + bv[bj][1]);
                }
            }
    }
};

#define XB_TMO      128
#define XB_XCNT(j)  (256  + 64 * (j))
#define XB_XSUB(j)  (1280 + 64 * (j))
#define XB_XGEN(j)  (2304 + 64 * (j))
#define XB_TOP      3328
#define XB_TOPGEN   3392
#define XCD_BAR_WORDS 3456
#define XB_SPIN_CAP (1u << 20)
__device__ __forceinline__ unsigned xb_ld(unsigned* p)              { return __hip_atomic_load(p, __ATOMIC_RELAXED, __HIP_MEMORY_SCOPE_AGENT); }
__device__ __forceinline__ unsigned xb_add(unsigned* p, unsigned v) { return __hip_atomic_fetch_add(p, v, __ATOMIC_RELAXED, __HIP_MEMORY_SCOPE_AGENT); }
__device__ __forceinline__ unsigned xb_xcc_id() { return (unsigned)__builtin_amdgcn_s_getreg((3 << 11) | 20) & 0xFu; }
#define XB_SPIN(cond, bar) do { unsigned _sp = 0; while (cond) { __builtin_amdgcn_s_sleep(1); \
    if ((++_sp & 255u) == 0u) { if (xb_ld(&(bar)[XB_TMO])) break; if (_sp > XB_SPIN_CAP) { atomicAdd(&(bar)[XB_TMO], 1u); break; } } } } while (0)
struct XcdBarrier { unsigned* bar; unsigned x; volatile LAS unsigned* st; };
__device__ __forceinline__ XcdBarrier xcd_barrier_post(unsigned* bar, volatile LAS unsigned* st) {
    XcdBarrier b; b.bar = bar; b.x = xb_xcc_id(); b.st = st;
    if (threadIdx.x == 0) (void)xb_add(&bar[XB_XCNT(b.x)], 1u);
    return b;
}
__device__ __forceinline__ void xcd_barrier_complete(unsigned* bar, unsigned x, unsigned& nloc, unsigned& nx) {
    const unsigned G = gridDim.x * gridDim.y * gridDim.z;
    unsigned sum, cnt, mine, sp = 0u;
    for (;;) {
        sum = 0u; cnt = 0u; mine = 0u;
#pragma unroll
        for (unsigned j = 0; j < 16; ++j) { const unsigned c = xb_ld(&bar[XB_XCNT(j)]); sum += c; cnt += (c > 0u) ? 1u : 0u; mine = (j == x) ? c : mine; }
        if (sum == G) break;
        __builtin_amdgcn_s_sleep(1);
        if ((++sp & 255u) == 0u) { if (xb_ld(&bar[XB_TMO])) break; if (sp > XB_SPIN_CAP) { atomicAdd(&bar[XB_TMO], 1u); break; } }
    }
    nloc = mine > 0u ? mine : 1u; nx = cnt > 0u ? cnt : 1u;
}
__device__ __forceinline__ void xcd_barrier(const XcdBarrier& b) {
    asm volatile("s_waitcnt vmcnt(0)" ::: "memory");
    __syncthreads();
    if (threadIdx.x == 0) {
        unsigned* bar = b.bar;
        __builtin_amdgcn_s_waitcnt(0);
        unsigned nloc = b.st[0], nx = b.st[1];
        if (nloc == 0u) { xcd_barrier_complete(bar, b.x, nloc, nx); b.st[0] = nloc; b.st[1] = nx; }
        const unsigned old = xb_add(&bar[XB_XSUB(b.x)], 1u);
        const unsigned gen = old / nloc;
        if (old + 1u == (gen + 1u) * nloc) {
            __builtin_amdgcn_fence(__ATOMIC_RELEASE, "agent");
            asm volatile("s_waitcnt vmcnt(0)" ::: "memory");
            const unsigned og = xb_add(&bar[XB_TOP], 1u);
            const unsigned tg = og / nx;
            if (og + 1u == (tg + 1u) * nx) xb_add(&bar[XB_TOPGEN], 1u);
            else XB_SPIN(xb_ld(&bar[XB_TOPGEN]) == tg, bar);
            __builtin_amdgcn_fence(__ATOMIC_ACQUIRE, "agent");
            xb_add(&bar[XB_XGEN(b.x)], 1u);
            asm volatile("s_waitcnt vmcnt(0)" ::: "memory");
        } else {
            XB_SPIN(xb_ld(&bar[XB_XGEN(b.x)]) == gen, bar);
            __builtin_amdgcn_fence(__ATOMIC_ACQUIRE, "agent");
            asm volatile("s_waitcnt vmcnt(0)" ::: "memory");
        }
    }
    __syncthreads();
}

enum { IN_X = 0, IN_C, IN_CTX, IN_CCTX, IN_ADAW, IN_ADAB, IN_NMIX, IN_NFFN, IN_WQKVG, IN_WO, IN_WCI, IN_CW, IN_WCO, IN_W1, IN_W3, IN_W2, IN_FN, N_IN };
struct Args { const float* in[N_IN]; float* out; unsigned char* ws; int ph_lo, ph_hi; };
constexpr int CW_BAR = 4096;
constexpr int LDS_BYTES = 163840, MISC_OFF = 163712;
constexpr int NPH = 13;
#ifndef G1SEL
#define G1SEL 7
#endif
#ifndef PHMASK
#define PHMASK 0xFFFF
#endif

__device__ __forceinline__ void transpose_item(const float* W, int Nsrc, int K, bf16* WT, int k0, int n_src0, int dst_row0, LAS float* scr, int lane) {
#pragma unroll
    for (int i = 0; i < 32; ++i) { const int kk = 2 * i + (lane >> 5); scr[kk * 33 + (lane & 31)] = W[(size_t)(k0 + kk) * Nsrc + n_src0 + (lane & 31)]; }
    LDS_WAIT(); asm volatile("" ::: "memory");
    const int c = lane & 7;
#pragma unroll
    for (int j = 0; j < 4; ++j) { const int n = (lane >> 3) + 8 * j; const LAS float* s = scr + (8 * c) * 33 + n;
        u32x4 o; o.x = pk2(s[0 * 33], s[1 * 33]); o.y = pk2(s[2 * 33], s[3 * 33]); o.z = pk2(s[4 * 33], s[5 * 33]); o.w = pk2(s[6 * 33], s[7 * 33]);
        *(u32x4*)(WT + (size_t)(dst_row0 + n) * K + k0 + 8 * c) = o; }
    LDS_WAIT(); asm volatile("" ::: "memory");
}
__device__ __forceinline__ void transpose_item_scaled(const float* W, int Nsrc, bf16* WT0, bf16* WT1, int k0, int n_src0, int dst_row0, LAS float* scr, const LAS float* tab, float& a0, float& a1, int lane) {
    LAS float* s0 = scr; LAS float* s1 = scr + 64 * 33;
#pragma unroll
    for (int i = 0; i < 32; ++i) { const int kk = 2 * i + (lane >> 5); const float w = W[(size_t)(k0 + kk) * Nsrc + n_src0 + (lane & 31)];
        s0[kk * 33 + (lane & 31)] = w * tab[k0 + kk]; s1[kk * 33 + (lane & 31)] = w * tab[1024 + k0 + kk]; a0 += w * tab[2048 + k0 + kk]; a1 += w * tab[3072 + k0 + kk]; }
    LDS_WAIT(); asm volatile("" ::: "memory");
    const int c = lane & 7;
#pragma unroll
    for (int j = 0; j < 4; ++j) { const int n = (lane >> 3) + 8 * j; const LAS float* p0 = s0 + (8 * c) * 33 + n; const LAS float* p1 = s1 + (8 * c) * 33 + n;
        u32x4 o; o.x = pk2(p0[0 * 33], p0[1 * 33]); o.y = pk2(p0[2 * 33], p0[3 * 33]); o.z = pk2(p0[4 * 33], p0[5 * 33]); o.w = pk2(p0[6 * 33], p0[7 * 33]);
        *(u32x4*)(WT0 + (size_t)(dst_row0 + n) * D + k0 + 8 * c) = o;
        o.x = pk2(p1[0 * 33], p1[1 * 33]); o.y = pk2(p1[2 * 33], p1[3 * 33]); o.z = pk2(p1[4 * 33], p1[5 * 33]); o.w = pk2(p1[6 * 33], p1[7 * 33]);
        *(u32x4*)(WT1 + (size_t)(dst_row0 + n) * D + k0 + 8 * c) = o; }
    LDS_WAIT(); asm volatile("" ::: "memory");
}
template <bool SCALED>
__device__ __forceinline__ void tr64(const float* W, int Nsrc, int K, bf16* WT0, bf16* WT1, int k0, int n_src0, int dst_row0, const LAS float* tab, f32x4& a0, f32x4& a1, int lane) {
    const int n4 = lane & 15, kr = lane >> 4;
    const float* src = W + (size_t)(k0 + 16 * kr) * Nsrc + n_src0 + 4 * n4;
    f32x4 v[16];
#pragma unroll
    for (int i = 0; i < 16; ++i) v[i] = *(const f32x4*)(src + (size_t)i * Nsrc);
    if constexpr (!SCALED) {
#pragma unroll
        for (int j = 0; j < 4; ++j) { bf16* drow = WT0 + (size_t)(dst_row0 + 4 * n4 + j) * K + k0 + 16 * kr;
#pragma unroll
            for (int h = 0; h < 2; ++h) { u32x4 o; o.x = pk2(v[8 * h][j], v[8 * h + 1][j]); o.y = pk2(v[8 * h + 2][j], v[8 * h + 3][j]); o.z = pk2(v[8 * h + 4][j], v[8 * h + 5][j]); o.w = pk2(v[8 * h + 6][j], v[8 * h + 7][j]);
                *(u32x4*)(drow + 8 * h) = o; } }
    } else {
        float s0[16], s1[16];
#pragma unroll
        for (int i = 0; i < 16; ++i) { const int k = k0 + 16 * kr + i; s0[i] = tab[k]; s1[i] = tab[1024 + k]; a0 += v[i] * tab[2048 + k]; a1 += v[i] * tab[3072 + k]; }
#pragma unroll
        for (int j = 0; j < 4; ++j) { bf16* d0 = WT0 + (size_t)(dst_row0 + 4 * n4 + j) * K + k0 + 16 * kr; bf16* d1 = WT1 + (size_t)(dst_row0 + 4 * n4 + j) * K + k0 + 16 * kr;
#pragma unroll
            for (int h = 0; h < 2; ++h) { u32x4 o;
                o.x = pk2(v[8 * h][j] * s0[8 * h], v[8 * h + 1][j] * s0[8 * h + 1]); o.y = pk2(v[8 * h + 2][j] * s0[8 * h + 2], v[8 * h + 3][j] * s0[8 * h + 3]);
                o.z = pk2(v[8 * h + 4][j] * s0[8 * h + 4], v[8 * h + 5][j] * s0[8 * h + 5]); o.w = pk2(v[8 * h + 6][j] * s0[8 * h + 6], v[8 * h + 7][j] * s0[8 * h + 7]);
                *(u32x4*)(d0 + 8 * h) = o;
                o.x = pk2(v[8 * h][j] * s1[8 * h], v[8 * h + 1][j] * s1[8 * h + 1]); o.y = pk2(v[8 * h + 2][j] * s1[8 * h + 2], v[8 * h + 3][j] * s1[8 * h + 3]);
                o.z = pk2(v[8 * h + 4][j] * s1[8 * h + 4], v[8 * h + 5][j] * s1[8 * h + 5]); o.w = pk2(v[8 * h + 6][j] * s1[8 * h + 6], v[8 * h + 7][j] * s1[8 * h + 7]);
                *(u32x4*)(d1 + 8 * h) = o; } }
    }
}
__device__ __forceinline__ int map_qkvg(int np) {
    if (np < 2048) { const int qk = np >> 10, h = (np >> 8) & 3, cp = np & 255; const int d = 128 * ((cp >> 6) & 1) + 64 * (cp >> 7) + (cp & 63); return qk * 1024 + h * 256 + d; }
    if (np < 4096) return 4096 + (np - 2048);
    return 2048 + (np - 4096);
}
__device__ __forceinline__ int map_wci(int np) { const int tile = np >> 8, cp = np & 255; if (tile < 8) return (cp < 128) ? (1024 + 128 * tile + cp) : (2048 + 128 * tile + cp - 128); return 256 * (tile - 8) + cp; }
__device__ __forceinline__ void unpack8(const u32x4 w, float (&f)[8]) { f[0] = bflo(w.x); f[1] = bfhi(w.x); f[2] = bflo(w.y); f[3] = bfhi(w.y); f[4] = bflo(w.z); f[5] = bfhi(w.z); f[6] = bflo(w.w); f[7] = bfhi(w.w); }

template <int RB>
__device__ __forceinline__ void modrows(const float* xrow0, const float* gain, const float* scale, bf16* orow0, float* rstd0, int lane) {
    f32x4 v[RB][4]; float ss[RB];
#pragma unroll
    for (int r = 0; r < RB; ++r)
#pragma unroll
        for (int j = 0; j < 4; ++j) v[r][j] = ((const f32x4*)(xrow0 + (size_t)r * D) + lane)[64 * j];
    f32x4 w[4];
#pragma unroll
    for (int j = 0; j < 4; ++j) w[j] = ((const f32x4*)gain + lane)[64 * j] * (((const f32x4*)scale + lane)[64 * j] + 1.0f);
#pragma unroll
    for (int r = 0; r < RB; ++r) { float s_ = 0.f;
#pragma unroll
        for (int j = 0; j < 4; ++j) s_ += (v[r][j][0] * v[r][j][0] + v[r][j][1] * v[r][j][1]) + (v[r][j][2] * v[r][j][2] + v[r][j][3] * v[r][j][3]);
        ss[r] = wave_sum(s_); }
#pragma unroll
    for (int r = 0; r < RB; ++r) { if (lane == 0) rstd0[r] = 1.0f / sqrtf(ss[r] * (1.0f / D) + EPS);
        unsigned long long* o8 = (unsigned long long*)(orow0 + (size_t)r * D) + lane;
#pragma unroll
        for (int j = 0; j < 4; ++j) { const f32x4 o = v[r][j] * w[j]; o8[64 * j] = (unsigned long long)pk2(o[0], o[1]) | ((unsigned long long)pk2(o[2], o[3]) << 32); } }
}
template <int RB>
__device__ __forceinline__ void biasrows(const bf16* wrow0, const float* sh, int q_lo, int q_hi, float* out0, int lane) {
    u32x4 wv[RB][2];
#pragma unroll
    for (int r = 0; r < RB; ++r)
#pragma unroll
        for (int j = 0; j < 2; ++j) wv[r][j] = *(const u32x4*)(wrow0 + (size_t)r * D + j * 512 + lane * 8);
#pragma unroll
    for (int q = 0; q < 3; ++q) if (q >= q_lo && q < q_hi) {
        float a[RB];
#pragma unroll
        for (int r = 0; r < RB; ++r) a[r] = 0.f;
#pragma unroll
        for (int j = 0; j < 2; ++j) { const float* s_ = sh + q * NQ + j * 512 + lane * 8; const f32x4 s0 = *(const f32x4*)s_, s1 = *(const f32x4*)(s_ + 4);
#pragma unroll
            for (int r = 0; r < RB; ++r) { float wf[8]; unpack8(wv[r][j], wf);
                a[r] += (wf[0] * s0[0] + wf[1] * s0[1]) + (wf[2] * s0[2] + wf[3] * s0[3]) + (wf[4] * s1[0] + wf[5] * s1[1]) + (wf[6] * s1[2] + wf[7] * s1[3]); } }
#pragma unroll
        for (int r = 0; r < RB; ++r) { const float t = wave_sum(a[r]); if (lane == 0) out0[q * NQ + r] = t; }
    }
}

#define BUILD_TABS(S_, RS_, BS_) do { LAS float* rt_ = (LAS float*)(lds + RSTD_LDS); LAS float* bt_ = (LAS float*)(lds + BIAS_LDS); pg8::Unit u_; \
        for (int i_ = (tid >> 8); S_.next(i_, u_); i_ += 2) { const int t_ = tid & 255; rt_[i_ * 256 + t_] = RS_(u_.pm * 256 + t_); bt_[i_ * 256 + t_] = BS_(u_, t_); } \
        __syncthreads(); } while (0)
__device__ __forceinline__ float bias_sum(const float* slab, int ncol, int col) { float t = slab[col];
#pragma unroll
    for (int q = 1; q < NKQ; ++q) t += slab[q * ncol + col];
    return t; }
#define RS_SSQ(r) rstd_from_ssq(SSQ, (r))
#define RS_X(r) RSTDX[(r)]

#define WPREP_JOBS(job_lo, job_hi, gwq, ngwq) do { LAS float* tab = (LAS float*)lds; \
                for (int job = (job_lo); job < (job_hi); ++job) { \
                    const int jl = (job == 0) ? 0 : 1; const bool isci = (job == 1); \
                    const float* gain_ = (isci ? args.in[IN_NMIX] : args.in[IN_NFFN]) + jl * D; const float* ad = ADA + jl * 3 * NQ + (isci ? 0 : 3 * D); \
                    __syncthreads(); \
                    for (int i = tid; i < 2 * D; i += NTHR) { const int b_ = i >> 10, k = i & (D - 1); tab[i] = gain_[k] * (1.0f + ad[b_ * NQ + D + k]); tab[2 * D + i] = ad[b_ * NQ + k]; } \
                    __syncthreads(); \
                    const int nnb = isci ? 48 : 88, ncol = isci ? 3072 : 5632; \
                    float* bslab = isci ? BIAS5 : BIAS3 + jl * 2 * NKQ * 5632; \
                    for (int it = (gwq); it < nnb * NKQ; it += (ngwq)) { const int nb = it / NKQ, kq = it % NKQ, np = nb * 64; f32x4 a0 = {0.f, 0.f, 0.f, 0.f}, a1 = a0; \
                        for (int kb = kq * (16 / NKQ); kb < (kq + 1) * (16 / NKQ); ++kb) { \
                            if (isci) tr64<true>(args.in[IN_WCI], 3072, D, WCI, WCI + (size_t)3072 * D, kb * 64, map_wci(np), np, tab, a0, a1, lane); \
                            else { const int tile = np >> 8, cp = np & 255; const float* src = (cp < 128 ? args.in[IN_W1] : args.in[IN_W3]) + (size_t)jl * D * FF; \
                                tr64<true>(src, FF, D, W13[jl], W13[jl] + (size_t)5632 * D, kb * 64, 128 * tile + (cp & 127), np, tab, a0, a1, lane); } } \
                        _Pragma("unroll") for (int e = 0; e < 4; ++e) { a0[e] += __shfl_xor(a0[e], 16); a0[e] += __shfl_xor(a0[e], 32); a1[e] += __shfl_xor(a1[e], 16); a1[e] += __shfl_xor(a1[e], 32); } \
                        if (lane < 16) { *(f32x4*)(bslab + (0 * NKQ + kq) * ncol + np + 4 * lane) = a0; *(f32x4*)(bslab + (1 * NKQ + kq) * ncol + np + 4 * lane) = a1; } \
                    } } \
                __syncthreads(); } while (0)

__global__ void __launch_bounds__(NTHR, 2) fwd_kernel(Args args) {
    extern __shared__ __attribute__((aligned(16))) unsigned char lds_raw[];
    LAS unsigned char* lds = (LAS unsigned char*)lds_raw;
    volatile LAS unsigned* MISC = (volatile LAS unsigned*)(lds + MISC_OFF);
    const int tid0 = threadIdx.x, wave = __builtin_amdgcn_readfirstlane(tid0 >> 6);
    const int G = gridDim.x, bx = blockIdx.x;
    const int vcu = (G % 8 == 0) ? (bx % 8) * (G / 8) + bx / 8 : bx;
    const int gw = vcu * NWAVES + wave, NGW = G * NWAVES;
    unsigned char* ws = args.ws;
    unsigned* ctl = (unsigned*)(ws + WS_CTL);
    float* ADA = (float*)(ws + CTL_ADA);
    float* ROPE = (float*)(ws + MS_ROPE); float* RSTDX = (float*)(ws + MS_RSTDX); float* RSTDC = (float*)(ws + MS_RSTDC);
    float* BIAS1 = (float*)(ws + MS_BIAS1); float* BIAS3 = (float*)(ws + MS_BIAS3); float* BIAS5 = (float*)(ws + MS_BIAS5);
    float* SSQ = (float*)(ws + WS_SSQ);
    bf16* WQKVG = (bf16*)(ws + WS_WQKVG); bf16* WO = (bf16*)(ws + WS_WO); bf16* WCI = (bf16*)(ws + WS_WCI); bf16* WCO = (bf16*)(ws + WS_WCO);
    bf16* W13[2] = {(bf16*)(ws + WS_W13_0), (bf16*)(ws + WS_W13_1)};
    bf16* XB = (bf16*)(ws + WS_XB); bf16* QB = (bf16*)(ws + WS_Q); bf16* KB = (bf16*)(ws + WS_K); bf16* VT = (bf16*)(ws + WS_VT);
    bf16* SFB = (bf16*)(ws + WS_SF); bf16* SBB = (bf16*)(ws + WS_SB); bf16* KC = (bf16*)(ws + WS_KC); bf16* VCT = (bf16*)(ws + WS_VCT); bf16* ACB = (bf16*)(ws + WS_ACB);
    bf16* HID = (bf16*)(ws + WS_HID); bf16* CU = (bf16*)(ws + WS_CU); bf16* CB = (bf16*)(ws + WS_CB); bf16* ACV = (bf16*)(ws + WS_ACV);
    bf16* GB = (bf16*)args.out;
    const float* x = args.in[IN_X];

    for (int u = tid0; u < (LDS_BYTES - 131072) / 4; u += NTHR) ((LAS unsigned*)(lds + 131072))[u] = 0u;
    __syncthreads();
    const bool multi = (args.ph_hi - args.ph_lo) > 1;
    XcdBarrier bar; bar.bar = ctl + CW_BAR; bar.x = 0; bar.st = nullptr;
    if (multi) bar = xcd_barrier_post(ctl + CW_BAR, MISC + 8);

#ifndef PROBE_DUP
#define PROBE_DUP -1
#endif
#ifndef SSVAR
#define SSVAR 0
#endif
    for (int ph0 = args.ph_lo, rep = 0; ph0 < args.ph_hi; ) {
        const int ph = ph0; if (ph == PROBE_DUP && rep == 0) { rep = 1; } else { rep = 0; ++ph0; }
        const int tid = opaque((int)threadIdx.x), lane = tid & 63;
        switch (ph) {
        case 0: if (PHMASK & (1<<0)) {
            { LAS float* sl = (LAS float*)(lds + 131072); LAS f32x4* red = (LAS f32x4*)lds;
              for (int i = tid; i < 3 * D; i += NTHR) { const int r = i >> 10, k = i & (D - 1); sl[i] = siluf(r < 2 ? args.in[IN_C][r * D + k] : args.in[IN_CCTX][k]); }
              __syncthreads();
              for (int it = bx; it < 256; it += G) {
                  const int l = it >> 7, c0 = (it & 127) * 48, cg = tid % 12, kg = tid / 12;
                  if (tid < 504) {
                      const float* W = args.in[IN_ADAW] + (size_t)l * D * NQ + c0 + 4 * cg;
                      f32x4 a0 = {0.f, 0.f, 0.f, 0.f}, a1 = a0, a2 = a0;
#pragma unroll 5
                      for (int k = kg; k < D; k += 42) { const f32x4 w = *(const f32x4*)(W + (size_t)k * NQ); a0 += w * sl[k]; a1 += w * sl[D + k]; a2 += w * sl[2 * D + k]; }
                      red[(kg * 12 + cg) * 3 + 0] = a0; red[(kg * 12 + cg) * 3 + 1] = a1; red[(kg * 12 + cg) * 3 + 2] = a2;
                  }
                  __syncthreads();
                  if (tid < 36) { const int cg2 = tid / 3, r = tid % 3; f32x4 t = *(const f32x4*)(args.in[IN_ADAB] + l * NQ + c0 + 4 * cg2);
                      for (int q = 0; q < 42; ++q) t += red[(q * 12 + cg2) * 3 + r];
                      *(f32x4*)(ADA + (l * 3 + r) * NQ + c0 + 4 * cg2) = t; }
                  __syncthreads();
              }
            }
            { constexpr int I_QKVG = 16 * 96, I_WO = 32 * 16, I_W2 = 44 * 16, I_WCO = 16 * 16;
              constexpr int NIT = I_QKVG + I_WO + 2 * I_W2 + I_WCO;
              f32x4 d0, d1;
              for (int it = gw; it < NIT; it += NGW) {
                  int r = it;
                  if (r < I_QKVG) { const int kb = r / 96, nb = r % 96; tr64<false>(args.in[IN_WQKVG], NQ, D, WQKVG, nullptr, kb * 64, map_qkvg(nb * 64), nb * 64, nullptr, d0, d1, lane); continue; } r -= I_QKVG;
                  if (r < I_WO) { const int kb = r / 16, nb = r % 16; tr64<false>(args.in[IN_WO], D, 2048, WO, nullptr, kb * 64, nb * 64, nb * 64, nullptr, d0, d1, lane); continue; } r -= I_WO;
                  if (r < 2 * I_W2) { const int l = r / I_W2; r %= I_W2; const int kb = r / 16, nb = r % 16;
                      tr64<false>(args.in[IN_W2] + (size_t)l * FF * D, D, FF, (bf16*)(ws + (l ? WS_W2_1 : WS_W2_0)), nullptr, kb * 64, nb * 64, nb * 64, nullptr, d0, d1, lane); continue; } r -= 2 * I_W2;
                  { const int kb = r / 16, nb = r % 16; tr64<false>(args.in[IN_WCO], D, D, WCO, nullptr, kb * 64, nb * 64, nb * 64, nullptr, d0, d1, lane); }
              }
            }
        } break;
        case 1: if (PHMASK & (1<<1)) {
            const float* gain = args.in[IN_NMIX];
            for (int it = 4 * gw; it < 6144; it += 4 * NGW) biasrows<4>(WQKVG + (size_t)it * D, ADA, 0, 2, BIAS1 + it, lane);
            const bool hasctx = vcu < 192;
            const bool isv = vcu >= 64; const int tl = isv ? vcu - 64 : vcu, rb = tl & 7, cbk = tl >> 3, row0 = 64 * rb, col0 = 128 * cbk;
            const int wt0 = (isv ? 4096 : 1024) + col0;
            if (hasctx) {
                modrows<8>(args.in[IN_CTX] + (size_t)(row0 + 8 * wave) * D, gain, ADA + 2 * NQ + D, ACB + (size_t)(row0 + 8 * wave) * D, RSTDC + row0 + 8 * wave, lane);
                biasrows<8>(WQKVG + (size_t)(wt0 + 16 * wave) * D, ADA, 2, 3, BIAS1 + wt0 + 16 * wave, lane);
                biasrows<8>(WQKVG + (size_t)(wt0 + 16 * wave + 8) * D, ADA, 2, 3, BIAS1 + wt0 + 16 * wave + 8, lane);
                asm volatile("s_waitcnt vmcnt(0)" ::: "memory");
                __syncthreads();
            }
            if (hasctx && wave < 4) {
                const int wr2 = wave >> 1, wc2 = wave & 1, fr = lane & 15, fq = lane >> 4;
                const bf16* ap = ACB + (size_t)(row0 + 32 * wr2 + fr) * D + 8 * fq; const bf16* bp = WQKVG + (size_t)(wt0 + 64 * wc2 + fr) * D + 8 * fq;
                f32x4 acc[2][4];
#pragma unroll
                for (int m = 0; m < 2; ++m)
#pragma unroll
                    for (int n = 0; n < 4; ++n) acc[m][n] = (f32x4){0.f, 0.f, 0.f, 0.f};
                for (int k4 = 0; k4 < 32; k4 += 4) {
                    bf16x8 af[4][2], bfg[4][4];
#pragma unroll
                    for (int ks = 0; ks < 4; ++ks) {
#pragma unroll
                        for (int m = 0; m < 2; ++m) af[ks][m] = *(const bf16x8*)(ap + (size_t)(16 * m) * D + 32 * (k4 + ks));
#pragma unroll
                        for (int n = 0; n < 4; ++n) bfg[ks][n] = *(const bf16x8*)(bp + (size_t)(16 * n) * D + 32 * (k4 + ks)); }
#pragma unroll
                    for (int ks = 0; ks < 4; ++ks)
#pragma unroll
                        for (int m = 0; m < 2; ++m)
#pragma unroll
                            for (int n = 0; n < 4; ++n) acc[m][n] = isv ? __builtin_amdgcn_mfma_f32_16x16x32_bf16(af[ks][m], bfg[ks][n], acc[m][n], 0, 0, 0) : __builtin_amdgcn_mfma_f32_16x16x32_bf16(bfg[ks][n], af[ks][m], acc[m][n], 0, 0, 0);
                }
                const int b = rb >> 2;
                if (!isv) {
#pragma unroll
                    for (int m = 0; m < 2; ++m) { const int r = row0 + 32 * wr2 + 16 * m + fr; const float rs = RSTDC[r];
#pragma unroll
                        for (int n = 0; n < 4; ++n) { const int c = col0 + 64 * wc2 + 16 * n + 4 * fq; const f32x4 o = (acc[m][n] * rs + *(const f32x4*)(BIAS1 + 2 * NQ + 1024 + c)) * 0.0625f;
                            u32x2 w; w.x = pk2(o[0], o[1]); w.y = pk2(o[2], o[3]); *(u32x2*)(KC + (size_t)r * D + c) = w; } }
                } else {
#pragma unroll
                    for (int m = 0; m < 2; ++m) { const int t0 = row0 + 32 * wr2 + 16 * m + 4 * fq; const f32x4 rs = *(const f32x4*)(RSTDC + t0);
#pragma unroll
                        for (int n = 0; n < 4; ++n) { const int c = col0 + 64 * wc2 + 16 * n + fr, h = c >> 9, e = c & 511; const f32x4 o = acc[m][n] * rs + BIAS1[2 * NQ + 4096 + c];
                            u32x2 w; w.x = pk2(o[0], o[1]); w.y = pk2(o[2], o[3]); *(u32x2*)(VCT + (size_t)((b * NH + h) * DV + e) * CTXL + (t0 & (CTXL - 1))) = w; } }
                }
            } else {
                const int wk = hasctx ? vcu * 4 + (wave - 4) : 768 + (vcu - 192) * 8 + wave, NWK = 192 * 4 + (G - 192) * 8;
                if (!(SSVAR == 11 && PROBE_DUP == 1 && rep == 1)) for (int r = 4 * wk; r < M; r += 4 * NWK) modrows<4>(x + (size_t)r * D, gain, ADA + (r >> 13) * NQ + D, XB + (size_t)r * D, RSTDX + r, lane);
            }
        } break;
        case 2: if (PHMASK & (1<<2)) {
            if (G1SEL & 1) { pg8::Gemm g{XB, WQKVG, M, 4096, D, 0}; pg8::StaticOrder S; S.init(M, 4096, G, bx);
              EpiQKG E{QB, KB, GB, RSTDX, BIAS1};
              pg8::gemm_phase<EpiQKG, pg8::StaticOrder, true, true, false>(lds, g, S, E, tid); }
            { pg8::Gemm g{XB, WQKVG + (size_t)4096 * D, M, 2048, D, 0}; pg8::StaticOrder S; S.init(M, 2048, G, bx);
              EpiVT E{VT, RSTDX, BIAS1 + 4096, SEQ, 32, -1};
              pg8::gemm_phase<EpiVT, pg8::StaticOrder, true, true, true>(lds, g, S, E, tid); }
        } break;
        case 3: if (PHMASK & (1<<3)) {
            constexpr int KP = 136, BUFB = (64 + 128) * KP * 2;
            for (int u = bx; u < 256; u += G) {
                const int dir = u & 1, bh = (u >> 1) & 7, dkt = (u >> 4) & 3, dvt = u >> 6, b = bh >> 2, h = bh & 3, dk0 = 64 * dkt, dv0 = 128 * dvt;
                const float lg = __builtin_amdgcn_logf(1.0f - __builtin_amdgcn_exp2f(-(dir ? 5.5f : 5.0f) - (float)h)), g128 = __builtin_amdgcn_exp2f(128.0f * lg);
                __syncthreads();
                if (wave >= 4) {
                    const int pt = tid - 256;
                    float wK[4];
#pragma unroll
                    for (int p = 0; p < 4; ++p) { const int t = 32 * p + (pt >> 3); wK[p] = __builtin_amdgcn_exp2f((float)(dir ? t : 127 - t) * lg); }
                    u32x4 kr0[4], vr0[8], kr1[4], vr1[8], kr2[4], vr2[8];
#define SSP_LOAD(step, kr, vr) do { const int s_ = (step); const bool ic_ = s_ < 2; const int c_ = ic_ ? (dir ? 1 - s_ : s_) : (dir ? 65 - s_ : s_ - 2); const int t_ = opaque(pt); \
                        const bf16* ks_ = (ic_ ? KC + (size_t)(b * CTXL + c_ * 128) * D : KB + (size_t)(b * SEQ + c_ * 128) * D) + h * DK + dk0; \
                        const int ld_ = ic_ ? CTXL : 128; const bf16* vs_ = ic_ ? VCT + (size_t)(bh * DV + dv0) * CTXL + c_ * 128 : VT + ((size_t)((bh * 64 + c_) * DV + dv0)) * 128; \
                        _Pragma("unroll") for (int p = 0; p < 4; ++p) kr[p] = *(const u32x4*)(ks_ + (unsigned)((32 * p + (t_ >> 3)) * D + 8 * (t_ & 7))); \
                        _Pragma("unroll") for (int q = 0; q < 8; ++q) vr[q] = *(const u32x4*)(vs_ + (unsigned)(((t_ >> 4) + 16 * q) * ld_ + 8 * (t_ & 15))); } while (0)
#define SSP_WRITE(bufi, kr, vr) do { LAS bf16* kt_ = (LAS bf16*)(lds + (bufi) * BUFB); LAS bf16* vt_ = kt_ + 64 * KP; const int t_ = opaque(pt); \
                        _Pragma("unroll") for (int p = 0; p < 4; ++p) { float f_[8]; unpack8(kr[p], f_); const int c8_ = t_ & 7, tt_ = 32 * p + (t_ >> 3), pos_ = (((tt_ >> 3) ^ c8_) << 3) | (tt_ & 7); \
                            _Pragma("unroll") for (int e = 0; e < 8; ++e) kt_[(8 * c8_ + e) * KP + pos_] = (bf16)f2bf(f_[e] * wK[p]); } \
                        _Pragma("unroll") for (int q = 0; q < 8; ++q) *(LAS u32x4*)(vt_ + ((t_ >> 4) + 16 * q) * KP + 8 * (t_ & 15)) = vr[q]; } while (0)
#define SSP_STEP(s, krN, vrN, krF, vrF) do { const int s__ = (s); if (s__ < 62) { if (s__ + 3 <= 61) SSP_LOAD(s__ + 3, krF, vrF); if (s__ + 1 <= 61) SSP_WRITE((s__ + 1) & 1, krN, vrN); __syncthreads(); } } while (0)
                    SSP_LOAD(0, kr0, vr0); SSP_LOAD(1, kr1, vr1); SSP_LOAD(2, kr2, vr2); SSP_WRITE(0, kr0, vr0); __syncthreads();
                    for (int s3 = 0; s3 < 63; s3 += 3) { SSP_STEP(s3, kr1, vr1, kr0, vr0); SSP_STEP(s3 + 1, kr2, vr2, kr1, vr1); SSP_STEP(s3 + 2, kr0, vr0, kr2, vr2); }
#undef SSP_LOAD
#undef SSP_WRITE
#undef SSP_STEP
                } else {
                    const int wr = wave >> 1, wc = wave & 1, fr = lane & 15, fq = lane >> 4;
                    f32x4 acc[2][4];
#pragma unroll
                    for (int i = 0; i < 2; ++i)
#pragma unroll
                        for (int j = 0; j < 4; ++j) acc[i][j] = (f32x4){0.f, 0.f, 0.f, 0.f};
                    __syncthreads();
                    for (int s = 0; s <= 62; ++s) {
                        const bool isctx = s < 2; const int c = isctx ? (dir ? 1 - s : s) : (dir ? 65 - s : s - 2);
                        if (!isctx && (dir ? ((c & 3) == 3) : ((c & 3) == 0))) {
                            bf16* dst = (dir ? SBB : SFB) + ((size_t)((bh * NSC + (c >> 2)) * DV + dv0 + 64 * wc + fr)) * DK + dk0 + 32 * wr + 4 * fq;
#pragma unroll
                            for (int i = 0; i < 2; ++i)
#pragma unroll
                                for (int j = 0; j < 4; ++j) { u32x2 w; w.x = pk2(acc[i][j][0], acc[i][j][1]); w.y = pk2(acc[i][j][2], acc[i][j][3]); *(u32x2*)(dst + (size_t)(16 * j) * DK + 16 * i) = w; }
                        }
                        if (s == 62) break;
#pragma unroll
                        for (int i = 0; i < 2; ++i)
#pragma unroll
                            for (int j = 0; j < 4; ++j) acc[i][j] *= g128;
                        { const LAS bf16* kt = (const LAS bf16*)(lds + (s & 1) * BUFB); const LAS bf16* vt = kt + 64 * KP;
#pragma unroll
                          for (int ks = 0; ks < 4; ++ks) { bf16x8 X[2], Y[4];
#pragma unroll
                              for (int i = 0; i < 2; ++i) X[i] = *(const LAS bf16x8*)(kt + (32 * wr + 16 * i + fr) * KP + (((4 * ks + fq) ^ (4 * wr + 2 * i + (fr >> 3))) & 7) * 8 + 64 * (ks >> 1));
#pragma unroll
                              for (int j = 0; j < 4; ++j) Y[j] = *(const LAS bf16x8*)(vt + (64 * wc + 16 * j + fr) * KP + 32 * ks + 8 * fq);
#pragma unroll
                              for (int i = 0; i < 2; ++i)
#pragma unroll
                                  for (int j = 0; j < 4; ++j) acc[i][j] = __builtin_amdgcn_mfma_f32_16x16x32_bf16(X[i], Y[j], acc[i][j], 0, 0, 0); } }
                        __syncthreads();
                    }
                }
            }
        } break;
        case 4: if (PHMASK & (1<<4)) {
            constexpr int SLOT = 40960, PBUF = 3 * SLOT, REDB = PBUF + 32768;
            static_assert(REDB + 2048 <= MISC_OFF, "B' LDS map");
            const int wr = wave >> 2, wc = wave & 3;
#define BP_WAITV(n) do { switch (n) { case 0: asm volatile("s_waitcnt vmcnt(0)" ::: "memory"); break; case 4: asm volatile("s_waitcnt vmcnt(4)" ::: "memory"); break; \
                    case 5: asm volatile("s_waitcnt vmcnt(5)" ::: "memory"); break; default: asm volatile("s_waitcnt vmcnt(0)" ::: "memory"); break; } } while (0)
#define BP_GLDS(srcp, dstoff) __builtin_amdgcn_global_load_lds((const unsigned*)(srcp), (LAS unsigned*)(lds + (dstoff)), 16, 0, 0)
            for (int unit = vcu; unit < 512; unit += G) {
                const int bh = unit >> 6, c = unit & 63, b = bh >> 2, h = bh & 3, sc = c >> 2, cq = c & 3;
                const float lgf = __builtin_amdgcn_logf(1.0f - __builtin_amdgcn_exp2f(-5.0f - (float)h)), lgb = __builtin_amdgcn_logf(1.0f - __builtin_amdgcn_exp2f(-5.5f - (float)h));
                const bf16* Qsrc = QB + (size_t)(b * SEQ + c * 128) * D + h * DK;
                const bf16* Ksrc = KB + (size_t)(b * SEQ + sc * SC) * D + h * DK;
                const bf16* SFsrc = SFB + (size_t)((bh * NSC + sc) * DV) * DK; const bf16* SBsrc = SBB + (size_t)((bh * NSC + sc) * DV) * DK;
                const bf16* Vsrc = VT + (size_t)((bh * 64 + sc * 4) * DV) * 128;
                f32x4 acc[4][8], sacc[4][2];
#pragma unroll
                for (int m = 0; m < 4; ++m)
#pragma unroll
                    for (int n = 0; n < 8; ++n) acc[m][n] = (f32x4){0.f, 0.f, 0.f, 0.f};
#define BP_ISSUE(idx) do { const int i_ = (idx); const int so_ = (i_ % 3) * SLOT; const int l_ = opaque(lane); \
                    if (i_ < 16) { const int s_ = i_ & 7; const bf16* bs_ = (i_ < 8 ? SFsrc : SBsrc) + 32 * s_; const int rr_ = l_ >> 2, ch_ = (l_ & 3) ^ ((l_ >> 4) & 3); \
                        BP_GLDS(Qsrc + (unsigned)((16 * wave + rr_) * D + 32 * s_ + 8 * ch_), so_ + wave * 1024); \
                        _Pragma("unroll") for (int q = 0; q < 4; ++q) BP_GLDS(bs_ + (unsigned)((16 * (wave + 8 * q) + rr_) * DK + 8 * ch_), so_ + 8192 + (wave + 8 * q) * 1024); } \
                    else { const int j_ = (i_ - 16) >> 3, r8_ = (i_ - 16) & 7; \
                        if (r8_ < 4) { const int rr_ = l_ >> 3, ch_ = (l_ & 7) ^ ((l_ >> 4) & 3) ^ (4 * (wave & 1)); \
                            _Pragma("unroll") for (int q = 0; q < 2; ++q) { const int row_ = 8 * (wave + 8 * q) + rr_; \
                                BP_GLDS(Qsrc + (unsigned)(row_ * D + 64 * r8_ + 8 * ch_), so_ + (wave + 8 * q) * 1024); \
                                BP_GLDS(Ksrc + (unsigned)((128 * j_ + row_) * D + 64 * r8_ + 8 * ch_), so_ + 16384 + (wave + 8 * q) * 1024); } } \
                        else { const int rr_ = l_ >> 2, ch_ = (l_ & 3) ^ ((l_ >> 4) & 3); const bf16* bs_ = Vsrc + (size_t)j_ * (DV * 128) + 32 * (r8_ - 4); \
                            _Pragma("unroll") for (int q = 0; q < 4; ++q) BP_GLDS(bs_ + (unsigned)((16 * (wave + 8 * q) + rr_) * 128 + 8 * ch_), so_ + 8192 + (wave + 8 * q) * 1024); } } } while (0)
#define BP_NLOADS(idx) (((idx) >= 48) ? 0 : ((idx) < 16 ? 5 : 4))
#define BP_TOP(idx) do { BP_WAITV(BP_NLOADS((idx) + 1)); asm volatile("s_waitcnt lgkmcnt(0)" ::: "memory"); __builtin_amdgcn_s_barrier(); asm volatile("" ::: "memory"); \
                    if ((idx) + 2 < 48) BP_ISSUE((idx) + 2); } while (0)
#define BP_MMA_FULL(AADDR, so) do { bf16x8 af_[4]; const int l_ = opaque(lane), fr = l_ & 15, fq = l_ >> 4; \
                    _Pragma("unroll") for (int m = 0; m < 4; ++m) af_[m] = *(const LAS bf16x8*)(lds + AADDR(64 * wr + 16 * m + fr, fr, fq)); \
                    _Pragma("unroll") for (int nh = 0; nh < 4; ++nh) { bf16x8 bf_[2]; \
                        _Pragma("unroll") for (int n = 0; n < 2; ++n) bf_[n] = *(const LAS bf16x8*)(lds + (so) + 8192 + (128 * wc + 32 * nh + 16 * n + fr) * 64 + ((fq ^ (fr >> 2)) & 3) * 16); \
                        _Pragma("unroll") for (int m = 0; m < 4; ++m) _Pragma("unroll") for (int n = 0; n < 2; ++n) \
                            acc[m][2 * nh + n] = __builtin_amdgcn_mfma_f32_16x16x32_bf16(bf_[n], af_[m], acc[m][2 * nh + n], 0, 0, 0); } } while (0)
                __builtin_amdgcn_s_barrier();
                BP_ISSUE(0); BP_ISSUE(1);
                for (int idx = 0; idx < 16; ++idx) {
                    BP_TOP(idx);
                    const int so = (idx % 3) * SLOT;
#define AADDR_X(row, fr, fq) (so + (row) * 64 + (((fq) ^ ((fr) >> 2)) & 3) * 16)
                    BP_MMA_FULL(AADDR_X, so);
#undef AADDR_X
                    if (idx == 7 || idx == 15) { const int fr = opaque(lane) & 15;
#pragma unroll
                        for (int m = 0; m < 4; ++m) { const int il = 128 * cq + 64 * wr + 16 * m + fr;
                            const float sc_ = (idx == 7) ? __builtin_amdgcn_exp2f((float)(il + 1) * lgf - (float)(SC - il) * lgb) : __builtin_amdgcn_exp2f((float)(SC - il) * lgb);
#pragma unroll
                            for (int n = 0; n < 8; ++n) acc[m][n] *= sc_; }
                    }
                }
                for (int j = 0; j < 4; ++j) {
#pragma unroll
                    for (int m = 0; m < 4; ++m) { sacc[m][0] = (f32x4){0.f, 0.f, 0.f, 0.f}; sacc[m][1] = (f32x4){0.f, 0.f, 0.f, 0.f}; }
                    for (int r = 0; r < 4; ++r) {
                        const int idx = 16 + 8 * j + r;
                        BP_TOP(idx);
                        const int so = (idx % 3) * SLOT;
                        { const int l_ = opaque(lane), fr = l_ & 15, fq = l_ >> 4;
#pragma unroll
                          for (int ks = 0; ks < 2; ++ks) { bf16x8 af_[4], kf_[2]; const int cx = ((4 * ks + fq) ^ (fr >> 1)) & 7;
#pragma unroll
                              for (int m = 0; m < 4; ++m) af_[m] = *(const LAS bf16x8*)(lds + so + (64 * wr + 16 * m + fr) * 128 + cx * 16);
#pragma unroll
                              for (int n = 0; n < 2; ++n) kf_[n] = *(const LAS bf16x8*)(lds + so + 16384 + (32 * wc + 16 * n + fr) * 128 + cx * 16);
#pragma unroll
                              for (int m = 0; m < 4; ++m)
#pragma unroll
                                  for (int n = 0; n < 2; ++n) sacc[m][n] = __builtin_amdgcn_mfma_f32_16x16x32_bf16(kf_[n], af_[m], sacc[m][n], 0, 0, 0); } }
                        if (r == 3) {
                            const int l_ = opaque(lane), fr = l_ & 15, fq = l_ >> 4;
#pragma unroll
                            for (int m = 0; m < 4; ++m)
#pragma unroll
                                for (int n = 0; n < 2; ++n) { const int il = 128 * cq + 64 * wr + 16 * m + fr, jl0 = 128 * j + 32 * wc + 16 * n + 4 * fq; float pv[4];
#pragma unroll
                                    for (int e = 0; e < 4; ++e) { const int dl = il - (jl0 + e);
                                        const float dec = dl > 0 ? __builtin_amdgcn_exp2f((float)dl * lgf) : (dl < 0 ? __builtin_amdgcn_exp2f((float)(-dl) * lgb) : 2.0f); pv[e] = sacc[m][n][e] * dec; }
                                    u32x2 w; w.x = pk2(pv[0], pv[1]); w.y = pk2(pv[2], pv[3]);
                                    *(LAS u32x2*)(lds + PBUF + (64 * wr + 16 * m + fr) * 256 + (((4 * wc + 2 * n + (fq >> 1)) ^ fr) & 15) * 16 + (fq & 1) * 8) = w; }
                        }
                    }
                    for (int r = 0; r < 4; ++r) {
                        const int idx = 16 + 8 * j + 4 + r;
                        BP_TOP(idx);
                        const int so = (idx % 3) * SLOT;
#define AADDR_P(row, fr, fq) (PBUF + (row) * 256 + (((4 * r + (fq)) ^ (fr)) & 15) * 16)
                        BP_MMA_FULL(AADDR_P, so);
#undef AADDR_P
                    }
                }
                asm volatile("s_waitcnt vmcnt(0) lgkmcnt(0)" ::: "memory"); __builtin_amdgcn_s_barrier(); asm volatile("" ::: "memory");
                { LAS float* red = (LAS float*)(lds + REDB); const int l_ = opaque(lane), fr = l_ & 15, fq = l_ >> 4;
#pragma unroll
                  for (int m = 0; m < 4; ++m) { float ss = 0.f;
#pragma unroll
                      for (int n = 0; n < 8; ++n) ss += (acc[m][n][0] * acc[m][n][0] + acc[m][n][1] * acc[m][n][1]) + (acc[m][n][2] * acc[m][n][2] + acc[m][n][3] * acc[m][n][3]);
                      ss += __shfl_xor(ss, 16); ss += __shfl_xor(ss, 32);
                      if (fq == 0) red[(64 * wr + 16 * m + fr) * 4 + wc] = ss; }
                  __syncthreads();
#pragma unroll
                  for (int m = 0; m < 4; ++m) { const int row = 64 * wr + 16 * m + fr; const f32x4 t4 = *(const LAS f32x4*)(red + row * 4);
                      const float rs = 1.0f / sqrtf(((t4[0] + t4[1]) + (t4[2] + t4[3])) * (1.0f / DV) + EPS);
                      bf16* gp = GB + (size_t)(b * SEQ + c * 128 + row) * 2048 + h * DV + 128 * wc + 4 * fq;
#pragma unroll
                      for (int n = 0; n < 8; ++n) { const u32x2 gw = *(const u32x2*)(gp + 16 * n);
                          const float o0 = siluf(bflo(gw.x)) * acc[m][n][0] * rs, o1 = siluf(bfhi(gw.x)) * acc[m][n][1] * rs, o2 = siluf(bflo(gw.y)) * acc[m][n][2] * rs, o3 = siluf(bfhi(gw.y)) * acc[m][n][3] * rs;
                          u32x2 w; w.x = pk2(o0, o1); w.y = pk2(o2, o3); if (!(PROBE_DUP == 4 && rep == 1)) *(u32x2*)(gp + 16 * n) = w; } }
                  __syncthreads();
                }
            }
#undef BP_WAITV
#undef BP_GLDS
#undef BP_ISSUE
#undef BP_NLOADS
#undef BP_TOP
#undef BP_MMA_FULL
        } break;
        case 5: case 7: case 10: case 12: if (PHMASK & (1<<5)) {
            const int l = (ph >= 10) ? 1 : 0; const float* adal = ADA + l * 3 * NQ;
            if (ph == 5) WPREP_JOBS(0, 1, gw, NGW);
            pg8::StaticOrder S; S.init(M, D, G, bx);
            if (ph == 12) {
                pg8::Gemm g{HID, (const bf16*)(ws + WS_W2_1), M, D, FF, 0};
                EpiResFinal E{XB, args.out, adal + 5 * D, args.in[IN_FN], (float*)(ws + MS_XPART), ctl, lds + RSTD_LDS};
                pg8::gemm_phase<EpiResFinal, pg8::StaticOrder, true, true, false>(lds, g, S, E, tid);
            } else {
                pg8::Gemm g; EpiRes E;
                if (ph == 5) { g = pg8::Gemm{GB, WO, M, D, 2048, 0}; E = EpiRes{x, nullptr, XB, adal + 2 * D, SSQ, 0}; }
                else if (ph == 7) { g = pg8::Gemm{HID, (const bf16*)(ws + WS_W2_0), M, D, FF, 0}; E = EpiRes{nullptr, XB, XB, adal + 5 * D, SSQ, 0}; }
                else { g = pg8::Gemm{ACV, WCO, M, D, D, 0}; E = EpiRes{nullptr, XB, XB, adal + 2 * D, SSQ, 0}; }
                E.dry = (PROBE_DUP == ph && rep == 1) ? 1 : 0;
                pg8::gemm_phase<EpiRes, pg8::StaticOrder, true, true, false>(lds, g, S, E, tid);
            }
        } break;
        case 6: case 11: if (PHMASK & (1<<6)) {
            const int l = (ph == 11) ? 1 : 0;
            pg8::Gemm g{XB, W13[l], M, 5632, D, (size_t)5632 * D * 2}; pg8::StaticOrder S; S.init(M, 5632, G, bx);
#define BS_FFN(u, t) bias_sum(BIAS3 + (l * 2 + ((u).pm >> 5)) * NKQ * 5632, 5632, (u).pn * 256 + (t))
            BUILD_TABS(S, RS_SSQ, BS_FFN);
#undef BS_FFN
            EpiSwiGLU E{HID, (const LAS float*)(lds + RSTD_LDS), (const LAS float*)(lds + BIAS_LDS), (PROBE_DUP == ph && rep == 1 && SSVAR == 21) ? 1 : 0};
            pg8::gemm_phase<EpiSwiGLU, pg8::StaticOrder, true, true, false>(lds, g, S, E, tid);
            if (ph == 6 && bx >= 128) WPREP_JOBS(1, 3, (bx - 128) * NWAVES + wave, (G - 128) * NWAVES);
        } break;
        case 8: if (PHMASK & (1<<8)) {
            pg8::Gemm g{XB, WCI, M, 3072, D, (size_t)3072 * D * 2}; pg8::StaticOrder S; S.init(M, 3072, G, bx);
#define BS_CI(u, t) bias_sum(BIAS5 + ((u).pm >> 5) * NKQ * 3072, 3072, (u).pn * 256 + (t))
            BUILD_TABS(S, RS_SSQ, BS_CI);
#undef BS_CI
            EpiConvIn E{CU, CB, (const LAS float*)(lds + RSTD_LDS), (const LAS float*)(lds + BIAS_LDS)};
            pg8::gemm_phase<EpiConvIn, pg8::StaticOrder, true, true, false>(lds, g, S, E, tid);
        } break;
        case 9: if (PHMASK & (1<<9)) {
            const float* cw = args.in[IN_CW];
            for (int it = bx * NTHR + tid; it < M * (D / 8); it += G * NTHR) {
                const int r = it >> 7, k = (it & 127) * 8, t = r & (SEQ - 1);
                float u0[8], um[8], up[8], bb[8];
                unpack8(*(const u32x4*)(CU + (size_t)r * D + k), u0); unpack8(*(const u32x4*)(CB + (size_t)r * D + k), bb);
                if (t > 0) unpack8(*(const u32x4*)(CU + (size_t)(r - 1) * D + k), um); else { for (int q = 0; q < 8; ++q) um[q] = 0.f; }
                if (t < SEQ - 1) unpack8(*(const u32x4*)(CU + (size_t)(r + 1) * D + k), up); else { for (int q = 0; q < 8; ++q) up[q] = 0.f; }
                float o[8];
#pragma unroll
                for (int q = 0; q < 8; ++q) o[q] = bb[q] * (cw[k + q] * um[q] + cw[D + k + q] * u0[q] + cw[2 * D + k + q] * up[q]);
                u32x4 w; w.x = pk2(o[0], o[1]); w.y = pk2(o[2], o[3]); w.z = pk2(o[4], o[5]); w.w = pk2(o[6], o[7]);
                *(u32x4*)(ACV + (size_t)r * D + k) = w;
            }
        } break;
        case 13: if (PHMASK & (1<<13)) {
            const float* fn = args.in[IN_FN];
            for (int it = bx * NTHR + tid; it < M * (D / 4); it += G * NTHR) {
                const int r = it >> 8, k = (it & 255) * 4; const float rs = rstd_from_ssq(SSQ, r);
                const u32x2 hw = *(const u32x2*)(XB + (size_t)r * D + k); const f32x4 hv = {bflo(hw.x), bfhi(hw.x), bflo(hw.y), bfhi(hw.y)};
                *(f32x4*)(args.out + (size_t)r * D + k) = hv * rs * *(const f32x4*)(fn + k);
            }
        } break;
        default: break;
        }
        if (ph0 < args.ph_hi) xcd_barrier(bar);
        if (SSVAR == 6 && ph == 6) { for (int e_ = 0; e_ < 10; ++e_) xcd_barrier(bar); }
    }
}

#ifndef MK_PER_PHASE
#define MK_PER_PHASE 0
#endif
extern "C" void kernel_launch(void* const* d_in, const int* in_sizes, int n_in, void* d_out, int out_size, void* d_ws, size_t ws_size, hipStream_t stream) {
    static int grid = 0;
    if (grid == 0) {
        if (n_in != N_IN || out_size != M * D || ws_size < WS_END) { fprintf(stderr, "kernel_launch: unexpected shapes (n_in %d, out %d, ws %zu); nothing launched\n", n_in, out_size, ws_size); grid = -1; return; }
        int dev = 0, cus = 0, per_cu = 0;
        if (hipGetDevice(&dev) != hipSuccess || hipDeviceGetAttribute(&cus, hipDeviceAttributeMultiprocessorCount, dev) != hipSuccess) { grid = -1; return; }
        if (hipFuncSetAttribute((const void*)fwd_kernel, hipFuncAttributeMaxDynamicSharedMemorySize, LDS_BYTES) != hipSuccess) { fprintf(stderr, "kernel_launch: hipFuncSetAttribute failed\n"); grid = -1; return; }
        if (hipOccupancyMaxActiveBlocksPerMultiprocessor(&per_cu, (const void*)fwd_kernel, NTHR, LDS_BYTES) != hipSuccess || per_cu < 1) { fprintf(stderr, "kernel_launch: occupancy query says %d blocks per CU\n", per_cu); }
        (void)hipGetLastError();
        grid = cus;
    }
    if (grid < 0) return;
    (void)hipMemsetAsync((char*)d_ws + WS_CTL, 0, CTL_ZERO_BYTES, stream);
    Args a{};
    for (int i = 0; i < N_IN; ++i) a.in[i] = (const float*)d_in[i];
    a.out = (float*)d_out; a.ws = (unsigned char*)d_ws;
#if MK_PER_PHASE
    for (int p = 0; p < NPH; ++p) { a.ph_lo = p; a.ph_hi = p + 1; hipLaunchKernelGGL(fwd_kernel, dim3(grid), dim3(NTHR), LDS_BYTES, stream, a); }
#else
    a.ph_lo = 0; a.ph_hi = NPH; hipLaunchKernelGGL(fwd_kernel, dim3(grid), dim3(NTHR), LDS_BYTES, stream, a);
#if SSVAR == 7
    (void)hipMemsetAsync((char*)d_ws + WS_CTL, 0, CTL_ZERO_BYTES, stream); hipLaunchKernelGGL(fwd_kernel, dim3(grid), dim3(NTHR), LDS_BYTES, stream, a);
#endif
#endif
}
```

```cpp
#include <hip/hip_runtime.h>
#include <cstdio>
#include <cstdint>

#define LAS __attribute__((address_space(3)))
#define GAS __attribute__((address_space(1)))
typedef unsigned short bf16;
typedef short bf16x8 __attribute__((ext_vector_type(8)));
typedef float f32x4 __attribute__((ext_vector_type(4)));
typedef float f32x2 __attribute__((ext_vector_type(2)));
typedef unsigned u32x4 __attribute__((ext_vector_type(4)));
typedef unsigned u32x2 __attribute__((ext_vector_type(2)));

__device__ __forceinline__ int opaque(int v) { asm volatile("" : "+v"(v)); return v; }
constexpr int D = 1024, BATCH = 2, SEQ = 8192, M = BATCH * SEQ, CTXL = 256, MC = BATCH * CTXL, NH = 4, DK = 256, DV = 512, FF = 2816, NQ = 6 * D;
constexpr int SC = 512, NSC = SEQ / SC;
constexpr float EPS = 1e-6f;
constexpr int NWAVES = 8, NTHR = 512;

constexpr size_t MiB = 1u << 20, HMiB = 1u << 19;
constexpr size_t WS_CTL = 0, CTL_ZERO_BYTES = 1 * MiB;
constexpr size_t CTL_ADA = 65536;
constexpr size_t WS_MISC = 1 * MiB;
constexpr size_t MS_ROPE = WS_MISC;
constexpr size_t MS_RSTDX = MS_ROPE + 65536;
constexpr size_t MS_RSTDC = MS_RSTDX + 65536;
constexpr size_t MS_BIAS1 = MS_RSTDC + 4096;
constexpr int NKQ = 8;
constexpr size_t MS_BIAS3 = 262144;
constexpr size_t MS_BIAS5 = MS_BIAS1 + 3 * 6144 * 4;
static_assert(MS_BIAS3 + 4 * NKQ * 5632 * 4 <= 1 * MiB && MS_BIAS5 + 2 * NKQ * 3072 * 4 <= 1 * MiB + 512 * 1024, "misc region");
constexpr size_t MS_XPART = 1 * MiB + 512 * 1024;
constexpr size_t WS_SSQ = 2 * MiB;
constexpr size_t WS_WQKVG = 3 * MiB;
constexpr size_t WS_WO = 15 * MiB;
constexpr size_t WS_W2_0 = 19 * MiB;
constexpr size_t WS_W2_1 = 24 * MiB + HMiB;
constexpr size_t WS_WCO = 30 * MiB;
constexpr size_t WS_ACB = 60 * MiB;
constexpr size_t WS_XB = 61 * MiB;
constexpr size_t WS_Q = 93 * MiB;
constexpr size_t WS_K = 125 * MiB;
constexpr size_t WS_VT = 157 * MiB;
constexpr size_t WS_SB = 221 * MiB;
constexpr size_t WS_KC = 253 * MiB;
constexpr size_t WS_VCT = 254 * MiB;
constexpr size_t WS_SF = WS_XB;
constexpr size_t WS_HID = 93 * MiB;
constexpr size_t WS_CU = 93 * MiB, WS_CB = 125 * MiB, WS_ACV = 157 * MiB;
constexpr size_t WS_W13_0 = 181 * MiB;
constexpr size_t WS_WCI = 203 * MiB;
constexpr size_t WS_W13_1 = 215 * MiB;
constexpr size_t WS_END = 256 * MiB;

namespace pg8 {
typedef unsigned short bf16_t;
constexpr int BM = 256, BK = 64, HALF = 128, HTB = HALF * BK * 2, STAGE_BYTES = 8 * HTB, NXCD = 8, WGM = 8;
__host__ __device__ __forceinline__ int lds_byte(int r, int c) { const int st = (r >> 4) * 2 + (c >> 5), rr = r & 15, cc = c & 31, ob = rr * 64 + cc * 2; return st * 1024 + (ob ^ (((ob >> 9) & 1) << 5)); }
__host__ __device__ __forceinline__ void stage_rc(int b, int& R, int& C) { const int st = b / 1024, sb = b % 1024, swz = sb ^ (((sb >> 9) & 1) << 5); R = (st >> 1) * 16 + swz / 64; C = (st & 1) * 32 + (swz % 64) / 2; }
__host__ __device__ __forceinline__ int perm32(int rho) { const int n = rho >> 4, i = rho & 15; return 8 * (i >> 2) + 4 * n + (i & 3); }
struct Unit { int pm, pn; };
struct Gemm { const bf16_t* A; const bf16_t* Bt; int M, N, K; size_t bstride; };
struct StaticOrder {
    int nM, nN, nwg, G, c;
    __host__ __device__ void init(int M_, int N_, int G_, int c_) { nM = M_ / BM; nN = N_ / BM; nwg = nM * nN; G = G_; c = c_; }
    __host__ __device__ bool next(int i, Unit& u) const {
        const long L = (long)i * G + c; if (L >= nwg) return false;
        int wgid = (int)L; { const int q = nwg / NXCD, r = nwg % NXCD, xcd = wgid % NXCD, off = wgid / NXCD; wgid = (xcd < r ? xcd * (q + 1) : r * (q + 1) + (xcd - r) * q) + off; }
        const int nig = WGM * nN, gid = wgid / nig, fm = gid * WGM, gsz = (nM - fm) < WGM ? (nM - fm) : WGM;
        u.pm = fm + ((wgid % nig) % gsz); u.pn = (wgid % nig) / gsz; return true;
    }
    __device__ __forceinline__ void a_ready(const Unit&) const {}
    __device__ __forceinline__ void done(const Unit&) const {}
};
struct OneUnit { int pm, pn; bool have;
    __device__ __forceinline__ bool next(int i, Unit& u) const { if (i != 0 || !have) return false; u.pm = pm; u.pn = pn; return true; }
    __device__ __forceinline__ void a_ready(const Unit&) const {}
    __device__ __forceinline__ void done(const Unit&) const {}
};
template <class Epi, class Sched, bool ALIGN_EPI, bool SP2, bool SWAP>
__device__ __forceinline__ void gemm_phase(LAS unsigned char* lds, const Gemm g, const Sched& S, const Epi& E, const int tid) {
    const int wid = __builtin_amdgcn_readfirstlane(tid >> 6), lane = tid & 63, wr = wid >> 2, wc = wid & 3, fr = lane & 15, fq = lane >> 4;
    const int K = g.K, nt = K / BK;
    unsigned voffA[2], voffB[2];
#pragma unroll
    for (int i = 0; i < 2; ++i) { int R, C; stage_rc(tid * 16 + i * 8192, R, C); const int Rp = (R & ~31) + perm32(R & 31);
        voffA[i] = (unsigned)((SWAP ? Rp : R) * K + C) * 2u; voffB[i] = (unsigned)((SWAP ? R : Rp) * K + C) * 2u; }
    const size_t kstep = (size_t)(BK * 2);
    const size_t hstep = (size_t)HALF * K * 2;
    const size_t tstep = 2 * hstep;
    const unsigned ldsw = (unsigned)wid * 1024u;
    const int aoff = lds_byte(wr * 64 + fr, fq * 8), boff = lds_byte(wc * 32 + fr, fq * 8);
#define PG8_SA(b, h) (((b) * 2 + (h)) * HTB)
#define PG8_SB(b, h) ((4 + (b) * 2 + (h)) * HTB)
#define PG8_STAGE(bufoff, gbase, voff) do { _Pragma("unroll") for (int _i = 0; _i < 2; ++_i) \
        __builtin_amdgcn_global_load_lds((const unsigned*)((const char*)(gbase) + (voff)[_i]), (LAS unsigned*)(lds + (bufoff) + ldsw + _i * 8192), 16, 0, 0); } while (0)
#define PG8_LDA(dst, b, h) do { _Pragma("unroll") for (int m = 0; m < 4; ++m) _Pragma("unroll") for (int k = 0; k < 2; ++k) dst[m][k] = *(const LAS bf16x8*)(lds + PG8_SA(b, h) + aoff + m * 2048 + k * 1024); } while (0)
#define PG8_LDB(dst, b, h) do { _Pragma("unroll") for (int n = 0; n < 2; ++n) _Pragma("unroll") for (int k = 0; k < 2; ++k) dst[n][k] = *(const LAS bf16x8*)(lds + PG8_SB(b, h) + boff + n * 2048 + k * 1024); } while (0)
#define PG8_MMA(ai, bj, At, Bt) do { __builtin_amdgcn_s_setprio(1); _Pragma("unroll") for (int m = 0; m < 4; ++m) _Pragma("unroll") for (int n = 0; n < 2; ++n) _Pragma("unroll") for (int k = 0; k < 2; ++k) \
        acc[ai][bj][m][n] = SWAP ? __builtin_amdgcn_mfma_f32_16x16x32_bf16(At[m][k], Bt[n][k], acc[ai][bj][m][n], 0, 0, 0) \
                                 : __builtin_amdgcn_mfma_f32_16x16x32_bf16(Bt[n][k], At[m][k], acc[ai][bj][m][n], 0, 0, 0); __builtin_amdgcn_s_setprio(0); } while (0)
#define PG8_WAIT_V(n) asm volatile("s_waitcnt vmcnt(" #n ")" ::: "memory")
#define PG8_WAIT_L(n) asm volatile("s_waitcnt lgkmcnt(" #n ")" ::: "memory")
#define PG8_BAR __builtin_amdgcn_s_barrier()
#define PG8_SCHED __builtin_amdgcn_sched_barrier(0)
    Unit cur, nxt; int ui = 0;
    if (!S.next(0, cur)) return;
    f32x4 acc[2][2][4][2];
#pragma unroll
    for (int a = 0; a < 2; ++a)
#pragma unroll
        for (int b = 0; b < 2; ++b)
#pragma unroll
            for (int m = 0; m < 4; ++m)
#pragma unroll
                for (int n = 0; n < 2; ++n) acc[a][b][m][n] = (f32x4){0.f, 0.f, 0.f, 0.f};
    bf16x8 At[4][2], B0[2][2], B1[2][2];
    const char* cA = (const char*)g.A + (size_t)cur.pm * tstep; const char* cB = (const char*)g.Bt + (size_t)cur.pn * tstep + (cur.pm >= 32 ? g.bstride : 0);
    S.a_ready(cur);
    if constexpr (SP2) {
        PG8_STAGE(PG8_SB(0, 0), cB, voffB); PG8_STAGE(PG8_SB(0, 1), cB + hstep, voffB); PG8_STAGE(PG8_SA(0, 0), cA, voffA); PG8_STAGE(PG8_SA(0, 1), cA + hstep, voffA);
        if (wr == 1) PG8_BAR;
        PG8_WAIT_V(2); PG8_BAR;
        PG8_STAGE(PG8_SB(1, 0), cB + kstep, voffB); PG8_STAGE(PG8_SA(1, 0), cA + kstep, voffA); PG8_STAGE(PG8_SB(1, 1), cB + hstep + kstep, voffB);
        PG8_WAIT_V(6); PG8_BAR;
    } else {
        PG8_STAGE(PG8_SB(0, 0), cB, voffB); PG8_STAGE(PG8_SA(0, 0), cA, voffA); PG8_STAGE(PG8_SB(0, 1), cB + hstep, voffB); PG8_STAGE(PG8_SA(0, 1), cA + hstep, voffA);
        if (wr == 1) PG8_BAR;
        PG8_WAIT_V(4); PG8_BAR;
        PG8_STAGE(PG8_SB(1, 0), cB + kstep, voffB); PG8_STAGE(PG8_SA(1, 0), cA + kstep, voffA); PG8_STAGE(PG8_SB(1, 1), cB + hstep + kstep, voffB);
        PG8_WAIT_V(6); PG8_BAR;
    }
    for (;;) {
        const bool has_next = S.next(ui + 1, nxt);
        const char* nA = has_next ? (const char*)g.A + (size_t)nxt.pm * tstep : cA; const char* nB = has_next ? (const char*)g.Bt + (size_t)nxt.pn * tstep + (nxt.pm >= 32 ? g.bstride : 0) : cB;
        for (int t = 0; t < nt; t += 2) {
            const bool last = (t == nt - 2);
            const char* a1 = cA + (size_t)(t + 1) * kstep;
            const char* a2 = last ? nA : cA + (size_t)(t + 2) * kstep; const char* b2 = last ? nB : cB + (size_t)(t + 2) * kstep;
            const char* a3 = a2 + kstep; const char* b3 = b2 + kstep;
            if (last && has_next) S.a_ready(nxt);
            if constexpr (SP2) {
            PG8_LDB(B0, 0, 0); PG8_LDB(B1, 0, 1); PG8_SCHED; PG8_LDA(At, 0, 0); PG8_STAGE(PG8_SA(1, 1), a1 + hstep, voffA);
            PG8_WAIT_V(8); PG8_WAIT_L(0); PG8_BAR; PG8_MMA(0, 0, At, B0); PG8_MMA(0, 1, At, B1); PG8_BAR; PG8_SCHED;
            PG8_LDA(At, 0, 1); PG8_STAGE(PG8_SB(0, 0), b2, voffB); PG8_STAGE(PG8_SB(0, 1), b2 + hstep, voffB); PG8_STAGE(PG8_SA(0, 0), a2, voffA);
            PG8_WAIT_V(8); PG8_WAIT_L(0); PG8_BAR; PG8_MMA(1, 0, At, B0); PG8_MMA(1, 1, At, B1); PG8_BAR; PG8_SCHED;
            PG8_LDB(B0, 1, 0); PG8_LDB(B1, 1, 1); PG8_SCHED; PG8_LDA(At, 1, 0); PG8_STAGE(PG8_SA(0, 1), a2 + hstep, voffA);
            PG8_WAIT_V(8); PG8_WAIT_L(0); PG8_BAR; PG8_MMA(0, 0, At, B0); PG8_MMA(0, 1, At, B1); PG8_BAR; PG8_SCHED;
            PG8_LDA(At, 1, 1); PG8_STAGE(PG8_SB(1, 0), b3, voffB); PG8_STAGE(PG8_SB(1, 1), b3 + hstep, voffB); PG8_STAGE(PG8_SA(1, 0), a3, voffA);
            PG8_WAIT_V(8); PG8_WAIT_L(0); PG8_BAR; PG8_MMA(1, 0, At, B0); PG8_MMA(1, 1, At, B1); PG8_BAR; PG8_SCHED;
            } else {
            PG8_LDB(B0, 0, 0); PG8_SCHED; PG8_LDA(At, 0, 0); PG8_STAGE(PG8_SA(1, 1), a1 + hstep, voffA);
            PG8_WAIT_L(8); PG8_BAR; PG8_WAIT_L(0); PG8_MMA(0, 0, At, B0); PG8_BAR; PG8_SCHED;
            PG8_LDB(B1, 0, 1); PG8_STAGE(PG8_SB(0, 0), b2, voffB);
            PG8_BAR; PG8_WAIT_L(0); PG8_MMA(0, 1, At, B1); PG8_BAR;
            PG8_LDA(At, 0, 1); PG8_STAGE(PG8_SA(0, 0), a2, voffA);
            PG8_BAR; PG8_WAIT_L(0); PG8_MMA(1, 0, At, B0); PG8_BAR; PG8_SCHED;
            PG8_STAGE(PG8_SB(0, 1), b2 + hstep, voffB);
            PG8_WAIT_V(6); PG8_BAR; PG8_MMA(1, 1, At, B1); PG8_BAR;
            PG8_LDB(B0, 1, 0); PG8_SCHED; PG8_LDA(At, 1, 0); PG8_STAGE(PG8_SA(0, 1), a2 + hstep, voffA);
            PG8_WAIT_L(8); PG8_BAR; PG8_WAIT_L(0); PG8_MMA(0, 0, At, B0); PG8_BAR; PG8_SCHED;
            PG8_LDB(B1, 1, 1); PG8_STAGE(PG8_SB(1, 0), b3, voffB);
            PG8_BAR; PG8_WAIT_L(0); PG8_MMA(0, 1, At, B1); PG8_BAR;
            PG8_LDA(At, 1, 1); PG8_STAGE(PG8_SA(1, 0), a3, voffA);
            PG8_BAR; PG8_WAIT_L(0); PG8_MMA(1, 0, At, B0); PG8_BAR; PG8_SCHED;
            PG8_STAGE(PG8_SB(1, 1), b3 + hstep, voffB);
            PG8_WAIT_V(6); PG8_BAR; PG8_MMA(1, 1, At, B1); PG8_BAR;
            }
        }
        if constexpr (ALIGN_EPI) { if (wr == 0) PG8_BAR; }
        E(acc, cur, wr, wc, fr, fq, ui); S.done(cur);
        if (!has_next) break;
#pragma unroll
        for (int a = 0; a < 2; ++a)
#pragma unroll
            for (int b = 0; b < 2; ++b)
#pragma unroll
                for (int m = 0; m < 4; ++m)
#pragma unroll
                    for (int n = 0; n < 2; ++n) acc[a][b][m][n] = (f32x4){0.f, 0.f, 0.f, 0.f};
        cur = nxt; cA = nA; cB = nB; ++ui;
        if constexpr (ALIGN_EPI) { if (wr == 1) PG8_BAR; }
    }
    PG8_WAIT_V(0);
    if constexpr (!ALIGN_EPI) { if (wr == 0) PG8_BAR; }
    PG8_BAR;
#undef PG8_SA
#undef PG8_SB
#undef PG8_STAGE
#undef PG8_LDA
#undef PG8_LDB
#undef PG8_MMA
#undef PG8_WAIT_V
#undef PG8_WAIT_L
#undef PG8_BAR
#undef PG8_SCHED
}
}

#define RLX_AGENT __ATOMIC_RELAXED, __HIP_MEMORY_SCOPE_AGENT
#define LDS_WAIT() asm volatile("s_waitcnt lgkmcnt(0)" ::: "memory")
typedef __bf16 hbf16x2 __attribute__((ext_vector_type(2)));
__device__ __forceinline__ unsigned pk2(float lo, float hi) { const f32x2 v = {lo, hi}; return __builtin_bit_cast(unsigned, __builtin_convertvector(v, hbf16x2)); }
__device__ __forceinline__ unsigned f2bf(float f) { return pk2(f, 0.f) & 0xffffu; }
__device__ __forceinline__ float bf2f(unsigned h) { return __builtin_bit_cast(float, h << 16); }
__device__ __forceinline__ float bflo(unsigned w) { return __builtin_bit_cast(float, w << 16); }
__device__ __forceinline__ float bfhi(unsigned w) { return __builtin_bit_cast(float, w & 0xffff0000u); }
__device__ __forceinline__ float siluf(float x) { return x * __builtin_amdgcn_rcpf(1.0f + __builtin_amdgcn_exp2f(-1.44269504089f * x)); }
__device__ __forceinline__ float wave_sum(float v) {
#pragma unroll
    for (int o = 1; o < 64; o <<= 1) v += __shfl_xor(v, o);
    return v;
}
__device__ __forceinline__ u32x4 pack8(const f32x4 a, const f32x4 b) { u32x4 w; w.x = pk2(a[0], a[1]); w.y = pk2(a[2], a[3]); w.z = pk2(b[0], b[1]); w.w = pk2(b[2], b[3]); return w; }

using pg8::Unit;
typedef f32x4 Acc[2][2][4][2];
struct EpiQKG {
    bf16* Q; bf16* K; bf16* G; const float* rstd; const float* bias;
    __device__ __forceinline__ void operator()(const Acc& acc, const Unit& u, int wr, int wc, int fr_, int fq_, int ui) const {
        const int fr = opaque(fr_), fq = opaque(fq_);
        const int b = u.pm >> 5; const float* bb = bias + b * NQ + u.pn * 256 + wc * 32 + 8 * fq;
        const int row0 = u.pm * 256 + wr * 64 + fr;
        f32x4 bv[2][2]; float rs[2][4];
#pragma unroll
        for (int ai = 0; ai < 2; ++ai)
#pragma unroll
            for (int m = 0; m < 4; ++m) rs[ai][m] = rstd[row0 + ai * 128 + m * 16];
#pragma unroll
        for (int bj = 0; bj < 2; ++bj)
#pragma unroll
            for (int n = 0; n < 2; ++n) bv[bj][n] = *(const f32x4*)(bb + bj * 128 + 4 * n);
        if (u.pn < 8) {
            const bool isk = u.pn >= 4; bf16* O = isk ? K : Q; const float osc = isk ? 0.0625f : 1.0f;
            const int a = wc >> 1, i0 = (wc & 1) * 32 + 8 * fq, colo = (u.pn & 3) * 256 + wc * 32 + 8 * fq;
            f32x4 frv[2];
#pragma unroll
            for (int n = 0; n < 2; ++n)
#pragma unroll
                for (int j = 0; j < 4; ++j) frv[n][j] = __builtin_amdgcn_exp2f(-(float)(i0 + 4 * n + j) * (13.287712379549449f / 64.0f)) * 0.15915494309189535f;
#pragma unroll
            for (int ai = 0; ai < 2; ++ai)
#pragma unroll
                for (int m = 0; m < 4; ++m) {
                    const int r = row0 + ai * 128 + m * 16; const float rsv = rs[ai][m]; const int t = r & (SEQ - 1); const float pos = (float)(a ? (t & 63) : (t >> 6));
                    f32x4 o1[2], o2[2];
#pragma unroll
                    for (int n = 0; n < 2; ++n) {
                        f32x4 cs, sn;
#pragma unroll
                        for (int j = 0; j < 4; ++j) { const float rv = __builtin_amdgcn_fractf(pos * frv[n][j]); cs[j] = __builtin_amdgcn_cosf(rv); sn[j] = __builtin_amdgcn_sinf(rv); }
                        const f32x4 x1 = acc[ai][0][m][n] * rsv + bv[0][n], x2 = acc[ai][1][m][n] * rsv + bv[1][n];
                        o1[n] = (x1 * cs - x2 * sn) * osc; o2[n] = (x1 * sn + x2 * cs) * osc;
                    }
                    bf16* rowp = O + (size_t)r * D + colo;
                    *(u32x4*)(rowp) = pack8(o1[0], o1[1]); *(u32x4*)(rowp + 128) = pack8(o2[0], o2[1]);
                }
        } else {
            const int colo = (u.pn - 8) * 256 + wc * 32 + 8 * fq;
#pragma unroll
            for (int ai = 0; ai < 2; ++ai)
#pragma unroll
                for (int m = 0; m < 4; ++m) {
                    const int r = row0 + ai * 128 + m * 16; const float rsv = rs[ai][m]; bf16* rowp = G + (size_t)r * 2048 + colo;
#pragma unroll
                    for (int bj = 0; bj < 2; ++bj) *(u32x4*)(rowp + bj * 128) = pack8(acc[ai][bj][m][0] * rsv + bv[bj][0], acc[ai][bj][m][1] * rsv + bv[bj][1]);
                }
        }
    }
};
struct EpiVT {
    bf16* VT; const float* rstd; const float* bias; int ldt; int tiles_per_b; int bias_row;
    __device__ __forceinline__ void operator()(const Acc& acc, const Unit& u, int wr, int wc, int fr_, int fq_, int ui) const {
        const int fr = opaque(fr_), fq = opaque(fq_);
        const int b = u.pm / tiles_per_b, t00 = (u.pm % tiles_per_b) * 256 + wr * 64 + 8 * fq, h = u.pn >> 1, e0 = (u.pn & 1) * 256 + wc * 32 + fr;
        const float* bb = bias + (bias_row < 0 ? b : bias_row) * NQ;
        float bs[2][2];
#pragma unroll
        for (int bj = 0; bj < 2; ++bj)
#pragma unroll
            for (int n = 0; n < 2; ++n) bs[bj][n] = bb[u.pn * 256 + bj * 128 + wc * 32 + n * 16 + fr];
        f32x4 rsv[2][2][2];
#pragma unroll
        for (int ai = 0; ai < 2; ++ai)
#pragma unroll
            for (int mp = 0; mp < 2; ++mp) { const float* rp = rstd + b * ldt + t00 + ai * 128 + mp * 32; rsv[ai][mp][0] = *(const f32x4*)rp; rsv[ai][mp][1] = *(const f32x4*)(rp + 4); }
#pragma unroll
        for (int ai = 0; ai < 2; ++ai)
#pragma unroll
            for (int mp = 0; mp < 2; ++mp) {
                const int tl = t00 + ai * 128 + mp * 32;
                const f32x4 r0 = rsv[ai][mp][0], r1 = rsv[ai][mp][1];
#pragma unroll
                for (int bj = 0; bj < 2; ++bj)
#pragma unroll
                    for (int n = 0; n < 2; ++n) {
                        const f32x4 v0 = acc[ai][bj][2 * mp][n] * r0 + bs[bj][n], v1 = acc[ai][bj][2 * mp + 1][n] * r1 + bs[bj][n];
                        bf16* p = VT + ((size_t)(((b * NH + h) * (ldt >> 7) + (tl >> 7)) * DV + e0 + bj * 128 + n * 16)) * 128 + (tl & 127);
                        *(u32x4*)p = pack8(v0, v1);
                    }
            }
    }
};
struct EpiRes {
    const float* res32; const bf16* res16; bf16* hx; const float* gate; float* ssq; int dry;
    __device__ __forceinline__ void operator()(const Acc& acc, const Unit& u, int wr, int wc, int fr_, int fq_, int ui) const {
        const int fr = opaque(fr_), fq = opaque(fq_);
        const int b = u.pm >> 5, col0 = u.pn * 256 + wc * 32 + 8 * fq, row0 = u.pm * 256 + wr * 64 + fr;
        f32x4 gv[2][2];
#pragma unroll
        for (int bj = 0; bj < 2; ++bj)
#pragma unroll
            for (int n = 0; n < 2; ++n) gv[bj][n] = *(const f32x4*)(gate + b * NQ + col0 + bj * 128 + 4 * n);
#pragma unroll
        for (int am = 0; am < 8; am += 2) {
            f32x4 rv[2][2][2];
            if (res32) {
#pragma unroll
                for (int q = 0; q < 2; ++q)
#pragma unroll
                    for (int bj = 0; bj < 2; ++bj) { const float* p = res32 + (size_t)(row0 + ((am + q) >> 2) * 128 + ((am + q) & 3) * 16) * D + col0 + bj * 128; rv[q][bj][0] = *(const f32x4*)p; rv[q][bj][1] = *(const f32x4*)(p + 4); }
            } else {
                u32x4 rw[2][2];
#pragma unroll
                for (int q = 0; q < 2; ++q)
#pragma unroll
                    for (int bj = 0; bj < 2; ++bj) rw[q][bj] = *(const u32x4*)(res16 + (size_t)(row0 + ((am + q) >> 2) * 128 + ((am + q) & 3) * 16) * D + col0 + bj * 128);
#pragma unroll
                for (int q = 0; q < 2; ++q)
#pragma unroll
                    for (int bj = 0; bj < 2; ++bj) { const u32x4 w = rw[q][bj]; rv[q][bj][0] = (f32x4){bflo(w.x), bfhi(w.x), bflo(w.y), bfhi(w.y)}; rv[q][bj][1] = (f32x4){bflo(w.z), bfhi(w.z), bflo(w.w), bfhi(w.w)}; }
            }
#pragma unroll
            for (int q = 0; q < 2; ++q) {
                const int ai = (am + q) >> 2, m = (am + q) & 3;
                const int r = row0 + ai * 128 + m * 16; const size_t off = (size_t)r * D + col0; float ss = 0.f;
#pragma unroll
                for (int bj = 0; bj < 2; ++bj) {
                    const f32x4 o0 = rv[q][bj][0] + gv[bj][0] * acc[ai][bj][m][0], o1 = rv[q][bj][1] + gv[bj][1] * acc[ai][bj][m][1];
                    ss += (o0[0] * o0[0] + o0[1] * o0[1]) + (o0[2] * o0[2] + o0[3] * o0[3]) + (o1[0] * o1[0] + o1[1] * o1[1]) + (o1[2] * o1[2] + o1[3] * o1[3]);
                    if (!dry) *(u32x4*)(hx + off + bj * 128) = pack8(o0, o1);
                }
                ss += __shfl_xor(ss, 16); ss += __shfl_xor(ss, 32);
                if (fq == 0) ssq[(size_t)r * 16 + u.pn * 4 + wc] = ss;
            }
        }
    }
};
constexpr int CW_PANEL = 8192;
struct EpiResFinal {
    const bf16* res16; float* out; const float* gate; const float* fn; float* xpart; unsigned* cnt; LAS unsigned char* ldsb;
    __device__ __forceinline__ void operator()(Acc& acc, const Unit& u, int wr, int wc, int fr_, int fq_, int ui) const {
        const int fr = opaque(fr_), fq = opaque(fq_), tid = opaque((int)threadIdx.x);
        const int b = u.pm >> 5, col0 = u.pn * 256 + wc * 32 + 8 * fq, row0 = u.pm * 256 + wr * 64 + fr;
        LAS float* part = (LAS float*)ldsb;
        LAS float* rtab = (LAS float*)(ldsb + 4096);
        f32x4 gv[2][2];
#pragma unroll
        for (int bj = 0; bj < 2; ++bj)
#pragma unroll
            for (int n = 0; n < 2; ++n) gv[bj][n] = *(const f32x4*)(gate + b * NQ + col0 + bj * 128 + 4 * n);
#pragma unroll
        for (int am = 0; am < 8; am += 2) {
            u32x4 rw[2][2];
#pragma unroll
            for (int q = 0; q < 2; ++q)
#pragma unroll
                for (int bj = 0; bj < 2; ++bj) rw[q][bj] = *(const u32x4*)(res16 + (size_t)(row0 + ((am + q) >> 2) * 128 + ((am + q) & 3) * 16) * D + col0 + bj * 128);
#pragma unroll
            for (int q = 0; q < 2; ++q) { const int ai = (am + q) >> 2, m = (am + q) & 3; float ss = 0.f;
#pragma unroll
                for (int bj = 0; bj < 2; ++bj) { const u32x4 w = rw[q][bj];
                    const f32x4 o0 = (f32x4){bflo(w.x), bfhi(w.x), bflo(w.y), bfhi(w.y)} + gv[bj][0] * acc[ai][bj][m][0], o1 = (f32x4){bflo(w.z), bfhi(w.z), bflo(w.w), bfhi(w.w)} + gv[bj][1] * acc[ai][bj][m][1];
                    ss += (o0[0] * o0[0] + o0[1] * o0[1]) + (o0[2] * o0[2] + o0[3] * o0[3]) + (o1[0] * o1[0] + o1[1] * o1[1]) + (o1[2] * o1[2] + o1[3] * o1[3]);
                    acc[ai][bj][m][0] = o0; acc[ai][bj][m][1] = o1; }
                ss += __shfl_xor(ss, 16); ss += __shfl_xor(ss, 32);
                if (fq == 0) part[(ai * 128 + wr * 64 + m * 16 + fr) * 4 + wc] = ss; }
        }
        asm volatile("s_waitcnt lgkmcnt(0)" ::: "memory"); __builtin_amdgcn_s_barrier(); asm volatile("" ::: "memory");
        if (tid < 256) { const f32x4 p4 = *(const LAS f32x4*)(part + tid * 4);
            __hip_atomic_store(xpart + (size_t)(u.pm * 256 + tid) * 4 + u.pn, (p4[0] + p4[1]) + (p4[2] + p4[3]), __ATOMIC_RELAXED, __HIP_MEMORY_SCOPE_AGENT); }
        asm volatile("s_waitcnt vmcnt(0)" ::: "memory"); __builtin_amdgcn_s_barrier(); asm volatile("" ::: "memory");
        if (tid == 0) { __hip_atomic_fetch_add(cnt + CW_PANEL + 64 * u.pm, 1u, __ATOMIC_RELAXED, __HIP_MEMORY_SCOPE_AGENT);
            unsigned sp = 0; while (__hip_atomic_load(cnt + CW_PANEL + 64 * u.pm, __ATOMIC_RELAXED, __HIP_MEMORY_SCOPE_AGENT) < 4u) { __builtin_amdgcn_s_sleep(2); if (++sp > (1u << 22)) break; } }
        asm volatile("s_waitcnt vmcnt(0) lgkmcnt(0)" ::: "memory"); __builtin_amdgcn_s_barrier(); asm volatile("" ::: "memory");
        if (tid < 256) { const float* xp = xpart + (size_t)(u.pm * 256 + tid) * 4; float t = 0.f;
#pragma unroll
            for (int q = 0; q < 4; ++q) t += __hip_atomic_load(xp + q, __ATOMIC_RELAXED, __HIP_MEMORY_SCOPE_AGENT);
            rtab[tid] = 1.0f / sqrtf(t * (1.0f / D) + EPS); }
        asm volatile("s_waitcnt vmcnt(0) lgkmcnt(0)" ::: "memory"); __builtin_amdgcn_s_barrier(); asm volatile("" ::: "memory");
        f32x4 fv[2][2];
#pragma unroll
        for (int bj = 0; bj < 2; ++bj)
#pragma unroll
            for (int n = 0; n < 2; ++n) fv[bj][n] = *(const f32x4*)(fn + col0 + bj * 128 + 4 * n);
#pragma unroll
        for (int ai = 0; ai < 2; ++ai)
#pragma unroll
            for (int m = 0; m < 4; ++m) { const float rs = rtab[ai * 128 + wr * 64 + m * 16 + fr]; float* op = out + (size_t)(row0 + ai * 128 + m * 16) * D + col0;
#pragma unroll
                for (int bj = 0; bj < 2; ++bj) { *(f32x4*)(op + bj * 128) = acc[ai][bj][m][0] * rs * fv[bj][0]; *(f32x4*)(op + bj * 128 + 4) = acc[ai][bj][m][1] * rs * fv[bj][1]; } }
    }
};
__device__ __forceinline__ float rstd_from_ssq(const float* ssq, int r) {
    const f32x4* p = (const f32x4*)(ssq + (size_t)r * 16); const f32x4 a = p[0], b = p[1], c = p[2], d = p[3];
    const float s = ((a[0] + a[1]) + (a[2] + a[3])) + ((b[0] + b[1]) + (b[2] + b[3])) + ((c[0] + c[1]) + (c[2] + c[3])) + ((d[0] + d[1]) + (d[2] + d[3]));
    return 1.0f / sqrtf(s * (1.0f / D) + EPS);
}
constexpr int RSTD_LDS = 131072, BIAS_LDS = 131072 + 8192;
struct EpiSwiGLU {
    bf16* HID; const LAS float* rtab; const LAS float* btab; int dry;
    __device__ __forceinline__ void operator()(const Acc& acc, const Unit& u, int wr, int wc, int fr_, int fq_, int ui) const {
        const int fr = opaque(fr_), fq = opaque(fq_); if (dry) return;
        f32x4 bv[2][2]; float rs[2][4];
#pragma unroll
        for (int ai = 0; ai < 2; ++ai)
#pragma unroll
            for (int m = 0; m < 4; ++m) rs[ai][m] = rtab[ui * 256 + ai * 128 + wr * 64 + m * 16 + fr];
#pragma unroll
        for (int bj = 0; bj < 2; ++bj)
#pragma unroll
            for (int n = 0; n < 2; ++n) bv[bj][n] = *(const LAS f32x4*)(btab + ui * 256 + bj * 128 + wc * 32 + 8 * fq + 4 * n);
        const int row0 = u.pm * 256 + wr * 64 + fr, colo = u.pn * 128 + wc * 32 + 8 * fq;
#pragma unroll
        for (int ai = 0; ai < 2; ++ai)
#pragma unroll
            for (int m = 0; m < 4; ++m) {
                const int r = row0 + ai * 128 + m * 16;
                f32x4 hv[2];
#pragma unroll
                for (int n = 0; n < 2; ++n) { const f32x4 a1 = acc[ai][0][m][n] * rs[ai][m] + bv[0][n], a3 = acc[ai][1][m][n] * rs[ai][m] + bv[1][n];
#pragma unroll
                    for (int j = 0; j < 4; ++j) hv[n][j] = siluf(a1[j]) * a3[j]; }
                *(u32x4*)(HID + (size_t)r * FF + colo) = pack8(hv[0], hv[1]);
            }
    }
};
struct EpiConvIn {
    bf16* CU; bf16* CB; const LAS float* rtab; const LAS float* btab;
    __device__ __forceinline__ void operator()(const Acc& acc, const Unit& u, int wr, int wc, int fr_, int fq_, int ui) const {
        const int fr = opaque(fr_), fq = opaque(fq_);
        f32x4 bv[2][2]; float rs[2][4];
#pragma unroll
        for (int ai = 0; ai < 2; ++ai)
#pragma unroll
            for (int m = 0; m < 4; ++m) rs[ai][m] = rtab[ui * 256 + ai * 128 + wr * 64 + m * 16 + fr];
#pragma unroll
        for (int bj = 0; bj < 2; ++bj)
#pragma unroll
            for (int n = 0; n < 2; ++n) bv[bj][n] = *(const LAS f32x4*)(btab + ui * 256 + bj * 128 + wc * 32 + 8 * fq + 4 * n);
        const int row0 = u.pm * 256 + wr * 64 + fr;
#pragma unroll
        for (int ai = 0; ai < 2; ++ai)
#pragma unroll
            for (int m = 0; m < 4; ++m) {
                const int r = row0 + ai * 128 + m * 16; const float rs_ = rs[ai][m];
                if (u.pn < 8) {
                    const f32x4 u0 = (acc[ai][0][m][0] * rs_ + bv[0][0]) * (acc[ai][1][m][0] * rs_ + bv[1][0]), u1 = (acc[ai][0][m][1] * rs_ + bv[0][1]) * (acc[ai][1][m][1] * rs_ + bv[1][1]);
                    *(u32x4*)(CU + (size_t)r * D + u.pn * 128 + wc * 32 + 8 * fq) = pack8(u0, u1);
                } else {
#pragma unroll
                    for (int bj = 0; bj < 2; ++bj) *(u32x4*)(CB + (size_t)r * D + (u.pn - 8) * 256 + bj * 128 + wc * 32 + 8 * fq) = pack8(acc[ai][bj][m][0] * rs_ + bv[bj][0], acc[ai][bj][m][1] * rs_ + bv[bj][1]);
                }
            }
    }
};

#define XB_TMO      128
#define XB_XCNT(j)  (256  + 64 * (j))
#define XB_XSUB(j)  (1280 + 64 * (j))
#define XB_XGEN(j)  (2304 + 64 * (j))
#define XB_TOP      3328
#define XB_TOPGEN   3392
#define XCD_BAR_WORDS 3456
#define XB_SPIN_CAP (1u << 20)
__device__ __forceinline__ unsigned xb_ld(unsigned* p)              { return __hip_atomic_load(p, __ATOMIC_RELAXED, __HIP_MEMORY_SCOPE_AGENT); }
__device__ __forceinline__ unsigned xb_add(unsigned* p, unsigned v) { return __hip_atomic_fetch_add(p, v, __ATOMIC_RELAXED, __HIP_MEMORY_SCOPE_AGENT); }
__device__ __forceinline__ unsigned xb_xcc_id() { return (unsigned)__builtin_amdgcn_s_getreg((3 << 11) | 20) & 0xFu; }
#define XB_SPIN(cond, bar) do { unsigned _sp = 0; while (cond) { __builtin_amdgcn_s_sleep(1); \
    if ((++_sp & 255u) == 0u) { if (xb_ld(&(bar)[XB_TMO])) break; if (_sp > XB_SPIN_CAP) { atomicAdd(&(bar)[XB_TMO], 1u); break; } } } } while (0)
struct XcdBarrier { unsigned* bar; unsigned x; volatile LAS unsigned* st; };
__device__ __forceinline__ XcdBarrier xcd_barrier_post(unsigned* bar, volatile LAS unsigned* st) {
    XcdBarrier b; b.bar = bar; b.x = xb_xcc_id(); b.st = st;
    if (threadIdx.x == 0) (void)xb_add(&bar[XB_XCNT(b.x)], 1u);
    return b;
}
__device__ __forceinline__ void xcd_barrier_complete(unsigned* bar, unsigned x, unsigned& nloc, unsigned& nx) {
    const unsigned G = gridDim.x * gridDim.y * gridDim.z;
    unsigned sum, cnt, mine, sp = 0u;
    for (;;) {
        sum = 0u; cnt = 0u; mine = 0u;
#pragma unroll
        for (unsigned j = 0; j < 16; ++j) { const unsigned c = xb_ld(&bar[XB_XCNT(j)]); sum += c; cnt += (c > 0u) ? 1u : 0u; mine = (j == x) ? c : mine; }
        if (sum == G) break;
        __builtin_amdgcn_s_sleep(1);
        if ((++sp & 255u) == 0u) { if (xb_ld(&bar[XB_TMO])) break; if (sp > XB_SPIN_CAP) { atomicAdd(&bar[XB_TMO], 1u); break; } }
    }
    nloc = mine > 0u ? mine : 1u; nx = cnt > 0u ? cnt : 1u;
}
__device__ __forceinline__ void xcd_barrier(const XcdBarrier& b) {
    asm volatile("s_waitcnt vmcnt(0)" ::: "memory");
    __syncthreads();
    if (threadIdx.x == 0) {
        unsigned* bar = b.bar;
        __builtin_amdgcn_s_waitcnt(0);
        unsigned nloc = b.st[0], nx = b.st[1];
        if (nloc == 0u) { xcd_barrier_complete(bar, b.x, nloc, nx); b.st[0] = nloc; b.st[1] = nx; }
        const unsigned old = xb_add(&bar[XB_XSUB(b.x)], 1u);
        const unsigned gen = old / nloc;
        if (old + 1u == (gen + 1u) * nloc) {
            __builtin_amdgcn_fence(__ATOMIC_RELEASE, "agent");
            asm volatile("s_waitcnt vmcnt(0)" ::: "memory");
            const unsigned og = xb_add(&bar[XB_TOP], 1u);
            const unsigned tg = og / nx;
            if (og + 1u == (tg + 1u) * nx) xb_add(&bar[XB_TOPGEN], 1u);
            else XB_SPIN(xb_ld(&bar[XB_TOPGEN]) == tg, bar);
            __builtin_amdgcn_fence(__ATOMIC_ACQUIRE, "agent");
            xb_add(&bar[XB_XGEN(b.x)], 1u);
            asm volatile("s_waitcnt vmcnt(0)" ::: "memory");
        } else {
            XB_SPIN(xb_ld(&bar[XB_XGEN(b.x)]) == gen, bar);
            __builtin_amdgcn_fence(__ATOMIC_ACQUIRE, "agent");
            asm volatile("s_waitcnt vmcnt(0)" ::: "memory");
        }
    }
    __syncthreads();
}

enum { IN_X = 0, IN_C, IN_CTX, IN_CCTX, IN_ADAW, IN_ADAB, IN_NMIX, IN_NFFN, IN_WQKVG, IN_WO, IN_WCI, IN_CW, IN_WCO, IN_W1, IN_W3, IN_W2, IN_FN, N_IN };
struct Args { const float* in[N_IN]; float* out; unsigned char* ws; int ph_lo, ph_hi; };
constexpr int CW_BAR = 4096;
constexpr int LDS_BYTES = 163840, MISC_OFF = 163712;
constexpr int NPH = 13;
#ifndef G1SEL
#define G1SEL 7
#endif
#ifndef PHMASK
#define PHMASK 0xFFFF
#endif

__device__ __forceinline__ void transpose_item(const float* W, int Nsrc, int K, bf16* WT, int k0, int n_src0, int dst_row0, LAS float* scr, int lane) {
#pragma unroll
    for (int i = 0; i < 32; ++i) { const int kk = 2 * i + (lane >> 5); scr[kk * 33 + (lane & 31)] = W[(size_t)(k0 + kk) * Nsrc + n_src0 + (lane & 31)]; }
    LDS_WAIT(); asm volatile("" ::: "memory");
    const int c = lane & 7;
#pragma unroll
    for (int j = 0; j < 4; ++j) { const int n = (lane >> 3) + 8 * j; const LAS float* s = scr + (8 * c) * 33 + n;
        u32x4 o; o.x = pk2(s[0 * 33], s[1 * 33]); o.y = pk2(s[2 * 33], s[3 * 33]); o.z = pk2(s[4 * 33], s[5 * 33]); o.w = pk2(s[6 * 33], s[7 * 33]);
        *(u32x4*)(WT + (size_t)(dst_row0 + n) * K + k0 + 8 * c) = o; }
    LDS_WAIT(); asm volatile("" ::: "memory");
}
__device__ __forceinline__ void transpose_item_scaled(const float* W, int Nsrc, bf16* WT0, bf16* WT1, int k0, int n_src0, int dst_row0, LAS float* scr, const LAS float* tab, float& a0, float& a1, int lane) {
    LAS float* s0 = scr; LAS float* s1 = scr + 64 * 33;
#pragma unroll
    for (int i = 0; i < 32; ++i) { const int kk = 2 * i + (lane >> 5); const float w = W[(size_t)(k0 + kk) * Nsrc + n_src0 + (lane & 31)];
        s0[kk * 33 + (lane & 31)] = w * tab[k0 + kk]; s1[kk * 33 + (lane & 31)] = w * tab[1024 + k0 + kk]; a0 += w * tab[2048 + k0 + kk]; a1 += w * tab[3072 + k0 + kk]; }
    LDS_WAIT(); asm volatile("" ::: "memory");
    const int c = lane & 7;
#pragma unroll
    for (int j = 0; j < 4; ++j) { const int n = (lane >> 3) + 8 * j; const LAS float* p0 = s0 + (8 * c) * 33 + n; const LAS float* p1 = s1 + (8 * c) * 33 + n;
        u32x4 o; o.x = pk2(p0[0 * 33], p0[1 * 33]); o.y = pk2(p0[2 * 33], p0[3 * 33]); o.z = pk2(p0[4 * 33], p0[5 * 33]); o.w = pk2(p0[6 * 33], p0[7 * 33]);
        *(u32x4*)(WT0 + (size_t)(dst_row0 + n) * D + k0 + 8 * c) = o;
        o.x = pk2(p1[0 * 33], p1[1 * 33]); o.y = pk2(p1[2 * 33], p1[3 * 33]); o.z = pk2(p1[4 * 33], p1[5 * 33]); o.w = pk2(p1[6 * 33], p1[7 * 33]);
        *(u32x4*)(WT1 + (size_t)(dst_row0 + n) * D + k0 + 8 * c) = o; }
    LDS_WAIT(); asm volatile("" ::: "memory");
}
template <bool SCALED>
__device__ __forceinline__ void tr64(const float* W, int Nsrc, int K, bf16* WT0, bf16* WT1, int k0, int n_src0, int dst_row0, const LAS float* tab, f32x4& a0, f32x4& a1, int lane) {
    const int n4 = lane & 15, kr = lane >> 4;
    const float* src = W + (size_t)(k0 + 16 * kr) * Nsrc + n_src0 + 4 * n4;
    f32x4 v[16];
#pragma unroll
    for (int i = 0; i < 16; ++i) v[i] = *(const f32x4*)(src + (size_t)i * Nsrc);
    if constexpr (!SCALED) {
#pragma unroll
        for (int j = 0; j < 4; ++j) { bf16* drow = WT0 + (size_t)(dst_row0 + 4 * n4 + j) * K + k0 + 16 * kr;
#pragma unroll
            for (int h = 0; h < 2; ++h) { u32x4 o; o.x = pk2(v[8 * h][j], v[8 * h + 1][j]); o.y = pk2(v[8 * h + 2][j], v[8 * h + 3][j]); o.z = pk2(v[8 * h + 4][j], v[8 * h + 5][j]); o.w = pk2(v[8 * h + 6][j], v[8 * h + 7][j]);
                *(u32x4*)(drow + 8 * h) = o; } }
    } else {
        float s0[16], s1[16];
#pragma unroll
        for (int i = 0; i < 16; ++i) { const int k = k0 + 16 * kr + i; s0[i] = tab[k]; s1[i] = tab[1024 + k]; a0 += v[i] * tab[2048 + k]; a1 += v[i] * tab[3072 + k]; }
#pragma unroll
        for (int j = 0; j < 4; ++j) { bf16* d0 = WT0 + (size_t)(dst_row0 + 4 * n4 + j) * K + k0 + 16 * kr; bf16* d1 = WT1 + (size_t)(dst_row0 + 4 * n4 + j) * K + k0 + 16 * kr;
#pragma unroll
            for (int h = 0; h < 2; ++h) { u32x4 o;
                o.x = pk2(v[8 * h][j] * s0[8 * h], v[8 * h + 1][j] * s0[8 * h + 1]); o.y = pk2(v[8 * h + 2][j] * s0[8 * h + 2], v[8 * h + 3][j] * s0[8 * h + 3]);
                o.z = pk2(v[8 * h + 4][j] * s0[8 * h + 4], v[8 * h + 5][j] * s0[8 * h + 5]); o.w = pk2(v[8 * h + 6][j] * s0[8 * h + 6], v[8 * h + 7][j] * s0[8 * h + 7]);
                *(u32x4*)(d0 + 8 * h) = o;
                o.x = pk2(v[8 * h][j] * s1[8 * h], v[8 * h + 1][j] * s1[8 * h + 1]); o.y = pk2(v[8 * h + 2][j] * s1[8 * h + 2], v[8 * h + 3][j] * s1[8 * h + 3]);
                o.z = pk2(v[8 * h + 4][j] * s1[8 * h + 4], v[8 * h + 5][j] * s1[8 * h + 5]); o.w = pk2(v[8 * h + 6][j] * s1[8 * h + 6], v[8 * h + 7][j] * s1[8 * h + 7]);
                *(u32x4*)(d1 + 8 * h) = o; } }
    }
}
__device__ __forceinline__ int map_qkvg(int np) {
    if (np < 2048) { const int qk = np >> 10, h = (np >> 8) & 3, cp = np & 255; const int d = 128 * ((cp >> 6) & 1) + 64 * (cp >> 7) + (cp & 63); return qk * 1024 + h * 256 + d; }
    if (np < 4096) return 4096 + (np - 2048);
    return 2048 + (np - 4096);
}
__device__ __forceinline__ int map_wci(int np) { const int tile = np >> 8, cp = np & 255; if (tile < 8) return (cp < 128) ? (1024 + 128 * tile + cp) : (2048 + 128 * tile + cp - 128); return 256 * (tile - 8) + cp; }
__device__ __forceinline__ void unpack8(const u32x4 w, float (&f)[8]) { f[0] = bflo(w.x); f[1] = bfhi(w.x); f[2] = bflo(w.y); f[3] = bfhi(w.y); f[4] = bflo(w.z); f[5] = bfhi(w.z); f[6] = bflo(w.w); f[7] = bfhi(w.w); }

template <int RB>
__device__ __forceinline__ void modrows(const float* xrow0, const float* gain, const float* scale, bf16* orow0, float* rstd0, int lane) {
    f32x4 v[RB][4]; float ss[RB];
#pragma unroll
    for (int r = 0; r < RB; ++r)
#pragma unroll
        for (int j = 0; j < 4; ++j) v[r][j] = ((const f32x4*)(xrow0 + (size_t)r * D) + lane)[64 * j];
    f32x4 w[4];
#pragma unroll
    for (int j = 0; j < 4; ++j) w[j] = ((const f32x4*)gain + lane)[64 * j] * (((const f32x4*)scale + lane)[64 * j] + 1.0f);
#pragma unroll
    for (int r = 0; r < RB; ++r) { float s_ = 0.f;
#pragma unroll
        for (int j = 0; j < 4; ++j) s_ += (v[r][j][0] * v[r][j][0] + v[r][j][1] * v[r][j][1]) + (v[r][j][2] * v[r][j][2] + v[r][j][3] * v[r][j][3]);
        ss[r] = wave_sum(s_); }
#pragma unroll
    for (int r = 0; r < RB; ++r) { if (lane == 0) rstd0[r] = 1.0f / sqrtf(ss[r] * (1.0f / D) + EPS);
        unsigned long long* o8 = (unsigned long long*)(orow0 + (size_t)r * D) + lane;
#pragma unroll
        for (int j = 0; j < 4; ++j) { const f32x4 o = v[r][j] * w[j]; o8[64 * j] = (unsigned long long)pk2(o[0], o[1]) | ((unsigned long long)pk2(o[2], o[3]) << 32); } }
}
template <int RB>
__device__ __forceinline__ void biasrows(const bf16* wrow0, const float* sh, int q_lo, int q_hi, float* out0, int lane) {
    u32x4 wv[RB][2];
#pragma unroll
    for (int r = 0; r < RB; ++r)
#pragma unroll
        for (int j = 0; j < 2; ++j) wv[r][j] = *(const u32x4*)(wrow0 + (size_t)r * D + j * 512 + lane * 8);
#pragma unroll
    for (int q = 0; q < 3; ++q) if (q >= q_lo && q < q_hi) {
        float a[RB];
#pragma unroll
        for (int r = 0; r < RB; ++r) a[r] = 0.f;
#pragma unroll
        for (int j = 0; j < 2; ++j) { const float* s_ = sh + q * NQ + j * 512 + lane * 8; const f32x4 s0 = *(const f32x4*)s_, s1 = *(const f32x4*)(s_ + 4);
#pragma unroll
            for (int r = 0; r < RB; ++r) { float wf[8]; unpack8(wv[r][j], wf);
                a[r] += (wf[0] * s0[0] + wf[1] * s0[1]) + (wf[2] * s0[2] + wf[3] * s0[3]) + (wf[4] * s1[0] + wf[5] * s1[1]) + (wf[6] * s1[2] + wf[7] * s1[3]); } }
#pragma unroll
        for (int r = 0; r < RB; ++r) { const float t = wave_sum(a[r]); if (lane == 0) out0[q * NQ + r] = t; }
    }
}

#define BUILD_TABS(S_, RS_, BS_) do { LAS float* rt_ = (LAS float*)(lds + RSTD_LDS); LAS float* bt_ = (LAS float*)(lds + BIAS_LDS); pg8::Unit u_; \
        for (int i_ = (tid >> 8); S_.next(i_, u_); i_ += 2) { const int t_ = tid & 255; rt_[i_ * 256 + t_] = RS_(u_.pm * 256 + t_); bt_[i_ * 256 + t_] = BS_(u_, t_); } \
        __syncthreads(); } while (0)
__device__ __forceinline__ float bias_sum(const float* slab, int ncol, int col) { float t = slab[col];
#pragma unroll
    for (int q = 1; q < NKQ; ++q) t += slab[q * ncol + col];
    return t; }
#define RS_SSQ(r) rstd_from_ssq(SSQ, (r))
#define RS_X(r) RSTDX[(r)]

#define WPREP_JOBS(job_lo, job_hi, gwq, ngwq) do { LAS float* tab = (LAS float*)lds; \
                for (int job = (job_lo); job < (job_hi); ++job) { \
                    const int jl = (job == 0) ? 0 : 1; const bool isci = (job == 1); \
                    const float* gain_ = (isci ? args.in[IN_NMIX] : args.in[IN_NFFN]) + jl * D; const float* ad = ADA + jl * 3 * NQ + (isci ? 0 : 3 * D); \
                    __syncthreads(); \
                    for (int i = tid; i < 2 * D; i += NTHR) { const int b_ = i >> 10, k = i & (D - 1); tab[i] = gain_[k] * (1.0f + ad[b_ * NQ + D + k]); tab[2 * D + i] = ad[b_ * NQ + k]; } \
                    __syncthreads(); \
                    const int nnb = isci ? 48 : 88, ncol = isci ? 3072 : 5632; \
                    float* bslab = isci ? BIAS5 : BIAS3 + jl * 2 * NKQ * 5632; \
                    for (int it = (gwq); it < nnb * NKQ; it += (ngwq)) { const int nb = it / NKQ, kq = it % NKQ, np = nb * 64; f32x4 a0 = {0.f, 0.f, 0.f, 0.f}, a1 = a0; \
                        for (int kb = kq * (16 / NKQ); kb < (kq + 1) * (16 / NKQ); ++kb) { \
                            if (isci) tr64<true>(args.in[IN_WCI], 3072, D, WCI, WCI + (size_t)3072 * D, kb * 64, map_wci(np), np, tab, a0, a1, lane); \
                            else { const int tile = np >> 8, cp = np & 255; const float* src = (cp < 128 ? args.in[IN_W1] : args.in[IN_W3]) + (size_t)jl * D * FF; \
                                tr64<true>(src, FF, D, W13[jl], W13[jl] + (size_t)5632 * D, kb * 64, 128 * tile + (cp & 127), np, tab, a0, a1, lane); } } \
                        _Pragma("unroll") for (int e = 0; e < 4; ++e) { a0[e] += __shfl_xor(a0[e], 16); a0[e] += __shfl_xor(a0[e], 32); a1[e] += __shfl_xor(a1[e], 16); a1[e] += __shfl_xor(a1[e], 32); } \
                        if (lane < 16) { *(f32x4*)(bslab + (0 * NKQ + kq) * ncol + np + 4 * lane) = a0; *(f32x4*)(bslab + (1 * NKQ + kq) * ncol + np + 4 * lane) = a1; } \
                    } } \
                __syncthreads(); } while (0)

__global__ void __launch_bounds__(NTHR, 2) fwd_kernel(Args args) {
    extern __shared__ __attribute__((aligned(16))) unsigned char lds_raw[];
    LAS unsigned char* lds = (LAS unsigned char*)lds_raw;
    volatile LAS unsigned* MISC = (volatile LAS unsigned*)(lds + MISC_OFF);
    const int tid0 = threadIdx.x, wave = __builtin_amdgcn_readfirstlane(tid0 >> 6);
    const int G = gridDim.x, bx = blockIdx.x;
    const int vcu = (G % 8 == 0) ? (bx % 8) * (G / 8) + bx / 8 : bx;
    const int gw = vcu * NWAVES + wave, NGW = G * NWAVES;
    unsigned char* ws = args.ws;
    unsigned* ctl = (unsigned*)(ws + WS_CTL);
    float* ADA = (float*)(ws + CTL_ADA);
    float* ROPE = (float*)(ws + MS_ROPE); float* RSTDX = (float*)(ws + MS_RSTDX); float* RSTDC = (float*)(ws + MS_RSTDC);
    float* BIAS1 = (float*)(ws + MS_BIAS1); float* BIAS3 = (float*)(ws + MS_BIAS3); float* BIAS5 = (float*)(ws + MS_BIAS5);
    float* SSQ = (float*)(ws + WS_SSQ);
    bf16* WQKVG = (bf16*)(ws + WS_WQKVG); bf16* WO = (bf16*)(ws + WS_WO); bf16* WCI = (bf16*)(ws + WS_WCI); bf16* WCO = (bf16*)(ws + WS_WCO);
    bf16* W13[2] = {(bf16*)(ws + WS_W13_0), (bf16*)(ws + WS_W13_1)};
    bf16* XB = (bf16*)(ws + WS_XB); bf16* QB = (bf16*)(ws + WS_Q); bf16* KB = (bf16*)(ws + WS_K); bf16* VT = (bf16*)(ws + WS_VT);
    bf16* SFB = (bf16*)(ws + WS_SF); bf16* SBB = (bf16*)(ws + WS_SB); bf16* KC = (bf16*)(ws + WS_KC); bf16* VCT = (bf16*)(ws + WS_VCT); bf16* ACB = (bf16*)(ws + WS_ACB);
    bf16* HID = (bf16*)(ws + WS_HID); bf16* CU = (bf16*)(ws + WS_CU); bf16* CB = (bf16*)(ws + WS_CB); bf16* ACV = (bf16*)(ws + WS_ACV);
    bf16* GB = (bf16*)args.out;
    const float* x = args.in[IN_X];

    for (int u = tid0; u < (LDS_BYTES - 131072) / 4; u += NTHR) ((LAS unsigned*)(lds + 131072))[u] = 0u;
    __syncthreads();
    const bool multi = (args.ph_hi - args.ph_lo) > 1;
    XcdBarrier bar; bar.bar = ctl + CW_BAR; bar.x = 0; bar.st = nullptr;
    if (multi) bar = xcd_barrier_post(ctl + CW_BAR, MISC + 8);

#ifndef PROBE_DUP
#define PROBE_DUP -1
#endif
#ifndef SSVAR
#define SSVAR 0
#endif
    for (int ph0 = args.ph_lo, rep = 0; ph0 < args.ph_hi; ) {
        const int ph = ph0; if (ph == PROBE_DUP && rep == 0) { rep = 1; } else { rep = 0; ++ph0; }
        const int tid = opaque((int)threadIdx.x), lane = tid & 63;
        switch (ph) {
        case 0: if (PHMASK & (1<<0)) {
            { LAS float* sl = (LAS float*)(lds + 131072); LAS f32x4* red = (LAS f32x4*)lds;
              for (int i = tid; i < 3 * D; i += NTHR) { const int r = i >> 10, k = i & (D - 1); sl[i] = siluf(r < 2 ? args.in[IN_C][r * D + k] : args.in[IN_CCTX][k]); }
              __syncthreads();
              for (int it = bx; it < 256; it += G) {
                  const int l = it >> 7, c0 = (it & 127) * 48, cg = tid % 12, kg = tid / 12;
                  if (tid < 504) {
                      const float* W = args.in[IN_ADAW] + (size_t)l * D * NQ + c0 + 4 * cg;
                      f32x4 a0 = {0.f, 0.f, 0.f, 0.f}, a1 = a0, a2 = a0;
#pragma unroll 5
                      for (int k = kg; k < D; k += 42) { const f32x4 w = *(const f32x4*)(W + (size_t)k * NQ); a0 += w * sl[k]; a1 += w * sl[D + k]; a2 += w * sl[2 * D + k]; }
                      red[(kg * 12 + cg) * 3 + 0] = a0; red[(kg * 12 + cg) * 3 + 1] = a1; red[(kg * 12 + cg) * 3 + 2] = a2;
                  }
                  __syncthreads();
                  if (tid < 36) { const int cg2 = tid / 3, r = tid % 3; f32x4 t = *(const f32x4*)(args.in[IN_ADAB] + l * NQ + c0 + 4 * cg2);
                      for (int q = 0; q < 42; ++q) t += red[(q * 12 + cg2) * 3 + r];
                      *(f32x4*)(ADA + (l * 3 + r) * NQ + c0 + 4 * cg2) = t; }
                  __syncthreads();
              }
            }
            { constexpr int I_QKVG = 16 * 96, I_WO = 32 * 16, I_W2 = 44 * 16, I_WCO = 16 * 16;
              constexpr int NIT = I_QKVG + I_WO + 2 * I_W2 + I_WCO;
              f32x4 d0, d1;
              for (int it = gw; it < NIT; it += NGW) {
                  int r = it;
                  if (r < I_QKVG) { const int kb = r / 96, nb = r % 96; tr64<false>(args.in[IN_WQKVG], NQ, D, WQKVG, nullptr, kb * 64, map_qkvg(nb * 64), nb * 64, nullptr, d0, d1, lane); continue; } r -= I_QKVG;
                  if (r < I_WO) { const int kb = r / 16, nb = r % 16; tr64<false>(args.in[IN_WO], D, 2048, WO, nullptr, kb * 64, nb * 64, nb * 64, nullptr, d0, d1, lane); continue; } r -= I_WO;
                  if (r < 2 * I_W2) { const int l = r / I_W2; r %= I_W2; const int kb = r / 16, nb = r % 16;
                      tr64<false>(args.in[IN_W2] + (size_t)l * FF * D, D, FF, (bf16*)(ws + (l ? WS_W2_1 : WS_W2_0)), nullptr, kb * 64, nb * 64, nb * 64, nullptr, d0, d1, lane); continue; } r -= 2 * I_W2;
                  { const int kb = r / 16, nb = r % 16; tr64<false>(args.in[IN_WCO], D, D, WCO, nullptr, kb * 64, nb * 64, nb * 64, nullptr, d0, d1, lane); }
              }
            }
        } break;
        case 1: if (PHMASK & (1<<1)) {
            const float* gain = args.in[IN_NMIX];
            for (int it = 4 * gw; it < 6144; it += 4 * NGW) biasrows<4>(WQKVG + (size_t)it * D, ADA, 0, 2, BIAS1 + it, lane);
            const bool hasctx = vcu < 192;
            const bool isv = vcu >= 64; const int tl = isv ? vcu - 64 : vcu, rb = tl & 7, cbk = tl >> 3, row0 = 64 * rb, col0 = 128 * cbk;
            const int wt0 = (isv ? 4096 : 1024) + col0;
            if (hasctx) {
                modrows<8>(args.in[IN_CTX] + (size_t)(row0 + 8 * wave) * D, gain, ADA + 2 * NQ + D, ACB + (size_t)(row0 + 8 * wave) * D, RSTDC + row0 + 8 * wave, lane);
                biasrows<8>(WQKVG + (size_t)(wt0 + 16 * wave) * D, ADA, 2, 3, BIAS1 + wt0 + 16 * wave, lane);
                biasrows<8>(WQKVG + (size_t)(wt0 + 16 * wave + 8) * D, ADA, 2, 3, BIAS1 + wt0 + 16 * wave + 8, lane);
                asm volatile("s_waitcnt vmcnt(0)" ::: "memory");
                __syncthreads();
            }
            if (hasctx && wave < 4) {
                const int wr2 = wave >> 1, wc2 = wave & 1, fr = lane & 15, fq = lane >> 4;
                const bf16* ap = ACB + (size_t)(row0 + 32 * wr2 + fr) * D + 8 * fq; const bf16* bp = WQKVG + (size_t)(wt0 + 64 * wc2 + fr) * D + 8 * fq;
                f32x4 acc[2][4];
#pragma unroll
                for (int m = 0; m < 2; ++m)
#pragma unroll
                    for (int n = 0; n < 4; ++n) acc[m][n] = (f32x4){0.f, 0.f, 0.f, 0.f};
                for (int k4 = 0; k4 < 32; k4 += 4) {
                    bf16x8 af[4][2], bfg[4][4];
#pragma unroll
                    for (int ks = 0; ks < 4; ++ks) {
#pragma unroll
                        for (int m = 0; m < 2; ++m) af[ks][m] = *(const bf16x8*)(ap + (size_t)(16 * m) * D + 32 * (k4 + ks));
#pragma unroll
                        for (int n = 0; n < 4; ++n) bfg[ks][n] = *(const bf16x8*)(bp + (size_t)(16 * n) * D + 32 * (k4 + ks)); }
#pragma unroll
                    for (int ks = 0; ks < 4; ++ks)
#pragma unroll
                        for (int m = 0; m < 2; ++m)
#pragma unroll
                            for (int n = 0; n < 4; ++n) acc[m][n] = isv ? __builtin_amdgcn_mfma_f32_16x16x32_bf16(af[ks][m], bfg[ks][n], acc[m][n], 0, 0, 0) : __builtin_amdgcn_mfma_f32_16x16x32_bf16(bfg[ks][n], af[ks][m], acc[m][n], 0, 0, 0);
                }
                const int b = rb >> 2;
                if (!isv) {
#pragma unroll
                    for (int m = 0; m < 2; ++m) { const int r = row0 + 32 * wr2 + 16 * m + fr; const float rs = RSTDC[r];
#pragma unroll
                        for (int n = 0; n < 4; ++n) { const int c = col0 + 64 * wc2 + 16 * n + 4 * fq; const f32x4 o = (acc[m][n] * rs + *(const f32x4*)(BIAS1 + 2 * NQ + 1024 + c)) * 0.0625f;
                            u32x2 w; w.x = pk2(o[0], o[1]); w.y = pk2(o[2], o[3]); *(u32x2*)(KC + (size_t)r * D + c) = w; } }
                } else {
#pragma unroll
                    for (int m = 0; m < 2; ++m) { const int t0 = row0 + 32 * wr2 + 16 * m + 4 * fq; const f32x4 rs = *(const f32x4*)(RSTDC + t0);
#pragma unroll
                        for (int n = 0; n < 4; ++n) { const int c = col0 + 64 * wc2 + 16 * n + fr, h = c >> 9, e = c & 511; const f32x4 o = acc[m][n] * rs + BIAS1[2 * NQ + 4096 + c];
                            u32x2 w; w.x = pk2(o[0], o[1]); w.y = pk2(o[2], o[3]); *(u32x2*)(VCT + (size_t)((b * NH + h) * DV + e) * CTXL + (t0 & (CTXL - 1))) = w; } }
                }
            } else {
                const int wk = hasctx ? vcu * 4 + (wave - 4) : 768 + (vcu - 192) * 8 + wave, NWK = 192 * 4 + (G - 192) * 8;
                if (!(SSVAR == 11 && PROBE_DUP == 1 && rep == 1)) for (int r = 4 * wk; r < M; r += 4 * NWK) modrows<4>(x + (size_t)r * D, gain, ADA + (r >> 13) * NQ + D, XB + (size_t)r * D, RSTDX + r, lane);
            }
        } break;
        case 2: if (PHMASK & (1<<2)) {
            if (G1SEL & 1) { pg8::Gemm g{XB, WQKVG, M, 4096, D, 0}; pg8::StaticOrder S; S.init(M, 4096, G, bx);
              EpiQKG E{QB, KB, GB, RSTDX, BIAS1};
              pg8::gemm_phase<EpiQKG, pg8::StaticOrder, true, true, false>(lds, g, S, E, tid); }
            { pg8::Gemm g{XB, WQKVG + (size_t)4096 * D, M, 2048, D, 0}; pg8::StaticOrder S; S.init(M, 2048, G, bx);
              EpiVT E{VT, RSTDX, BIAS1 + 4096, SEQ, 32, -1};
              pg8::gemm_phase<EpiVT, pg8::StaticOrder, true, true, true>(lds, g, S, E, tid); }
        } break;
        case 3: if (PHMASK & (1<<3)) {
            constexpr int KP = 136, BUFB = (64 + 128) * KP * 2;
            for (int u = bx; u < 256; u += G) {
                const int dir = u & 1, bh = (u >> 1) & 7, dkt = (u >> 4) & 3, dvt = u >> 6, b = bh >> 2, h = bh & 3, dk0 = 64 * dkt, dv0 = 128 * dvt;
                const float lg = __builtin_amdgcn_logf(1.0f - __builtin_amdgcn_exp2f(-(dir ? 5.5f : 5.0f) - (float)h)), g128 = __builtin_amdgcn_exp2f(128.0f * lg);
                __syncthreads();
                if (wave >= 4) {
                    const int pt = tid - 256;
                    float wK[4];
#pragma unroll
                    for (int p = 0; p < 4; ++p) { const int t = 32 * p + (pt >> 3); wK[p] = __builtin_amdgcn_exp2f((float)(dir ? t : 127 - t) * lg); }
                    u32x4 kr0[4], vr0[8], kr1[4], vr1[8], kr2[4], vr2[8];
#define SSP_LOAD(step, kr, vr) do { const int s_ = (step); const bool ic_ = s_ < 2; const int c_ = ic_ ? (dir ? 1 - s_ : s_) : (dir ? 65 - s_ : s_ - 2); const int t_ = opaque(pt); \
                        const bf16* ks_ = (ic_ ? KC + (size_t)(b * CTXL + c_ * 128) * D : KB + (size_t)(b * SEQ + c_ * 128) * D) + h * DK + dk0; \
                        const int ld_ = ic_ ? CTXL : 128; const bf16* vs_ = ic_ ? VCT + (size_t)(bh * DV + dv0) * CTXL + c_ * 128 : VT + ((size_t)((bh * 64 + c_) * DV + dv0)) * 128; \
                        _Pragma("unroll") for (int p = 0; p < 4; ++p) kr[p] = *(const u32x4*)(ks_ + (unsigned)((32 * p + (t_ >> 3)) * D + 8 * (t_ & 7))); \
                        _Pragma("unroll") for (int q = 0; q < 8; ++q) vr[q] = *(const u32x4*)(vs_ + (unsigned)(((t_ >> 4) + 16 * q) * ld_ + 8 * (t_ & 15))); } while (0)
#define SSP_WRITE(bufi, kr, vr) do { LAS bf16* kt_ = (LAS bf16*)(lds + (bufi) * BUFB); LAS bf16* vt_ = kt_ + 64 * KP; const int t_ = opaque(pt); \
                        _Pragma("unroll") for (int p = 0; p < 4; ++p) { float f_[8]; unpack8(kr[p], f_); const int c8_ = t_ & 7, tt_ = 32 * p + (t_ >> 3), pos_ = (((tt_ >> 3) ^ c8_) << 3) | (tt_ & 7); \
                            _Pragma("unroll") for (int e = 0; e < 8; ++e) kt_[(8 * c8_ + e) * KP + pos_] = (bf16)f2bf(f_[e] * wK[p]); } \
                        _Pragma("unroll") for (int q = 0; q < 8; ++q) *(LAS u32x4*)(vt_ + ((t_ >> 4) + 16 * q) * KP + 8 * (t_ & 15)) = vr[q]; } while (0)
#define SSP_STEP(s, krN, vrN, krF, vrF) do { const int s__ = (s); if (s__ < 62) { if (s__ + 3 <= 61) SSP_LOAD(s__ + 3, krF, vrF); if (s__ + 1 <= 61) SSP_WRITE((s__ + 1) & 1, krN, vrN); __syncthreads(); } } while (0)
                    SSP_LOAD(0, kr0, vr0); SSP_LOAD(1, kr1, vr1); SSP_LOAD(2, kr2, vr2); SSP_WRITE(0, kr0, vr0); __syncthreads();
                    for (int s3 = 0; s3 < 63; s3 += 3) { SSP_STEP(s3, kr1, vr1, kr0, vr0); SSP_STEP(s3 + 1, kr2, vr2, kr1, vr1); SSP_STEP(s3 + 2, kr0, vr0, kr2, vr2); }
#undef SSP_LOAD
#undef SSP_WRITE
#undef SSP_STEP
                } else {
                    const int wr = wave >> 1, wc = wave & 1, fr = lane & 15, fq = lane >> 4;
                    f32x4 acc[2][4];
#pragma unroll
                    for (int i = 0; i < 2; ++i)
#pragma unroll
                        for (int j = 0; j < 4; ++j) acc[i][j] = (f32x4){0.f, 0.f, 0.f, 0.f};
                    __syncthreads();
                    for (int s = 0; s <= 62; ++s) {
                        const bool isctx = s < 2; const int c = isctx ? (dir ? 1 - s : s) : (dir ? 65 - s : s - 2);
                        if (!isctx && (dir ? ((c & 3) == 3) : ((c & 3) == 0))) {
                            bf16* dst = (dir ? SBB : SFB) + ((size_t)((bh * NSC + (c >> 2)) * DV + dv0 + 64 * wc + fr)) * DK + dk0 + 32 * wr + 4 * fq;
#pragma unroll
                            for (int i = 0; i < 2; ++i)
#pragma unroll
                                for (int j = 0; j < 4; ++j) { u32x2 w; w.x = pk2(acc[i][j][0], acc[i][j][1]); w.y = pk2(acc[i][j][2], acc[i][j][3]); *(u32x2*)(dst + (size_t)(16 * j) * DK + 16 * i) = w; }
                        }
                        if (s == 62) break;
#pragma unroll
                        for (int i = 0; i < 2; ++i)
#pragma unroll
                            for (int j = 0; j < 4; ++j) acc[i][j] *= g128;
                        { const LAS bf16* kt = (const LAS bf16*)(lds + (s & 1) * BUFB); const LAS bf16* vt = kt + 64 * KP;
#pragma unroll
                          for (int ks = 0; ks < 4; ++ks) { bf16x8 X[2], Y[4];
#pragma unroll
                              for (int i = 0; i < 2; ++i) X[i] = *(const LAS bf16x8*)(kt + (32 * wr + 16 * i + fr) * KP + (((4 * ks + fq) ^ (4 * wr + 2 * i + (fr >> 3))) & 7) * 8 + 64 * (ks >> 1));
#pragma unroll
                              for (int j = 0; j < 4; ++j) Y[j] = *(const LAS bf16x8*)(vt + (64 * wc + 16 * j + fr) * KP + 32 * ks + 8 * fq);
#pragma unroll
                              for (int i = 0; i < 2; ++i)
#pragma unroll
                                  for (int j = 0; j < 4; ++j) acc[i][j] = __builtin_amdgcn_mfma_f32_16x16x32_bf16(X[i], Y[j], acc[i][j], 0, 0, 0); } }
                        __syncthreads();
                    }
                }
            }
        } break;
        case 4: if (PHMASK & (1<<4)) {
            constexpr int SLOT = 40960, PBUF = 3 * SLOT, REDB = PBUF + 32768;
            static_assert(REDB + 2048 <= MISC_OFF, "B' LDS map");
            const int wr = wave >> 2, wc = wave & 3;
#define BP_WAITV(n) do { switch (n) { case 0: asm volatile("s_waitcnt vmcnt(0)" ::: "memory"); break; case 4: asm volatile("s_waitcnt vmcnt(4)" ::: "memory"); break; \
                    case 5: asm volatile("s_waitcnt vmcnt(5)" ::: "memory"); break; default: asm volatile("s_waitcnt vmcnt(0)" ::: "memory"); break; } } while (0)
#define BP_GLDS(srcp, dstoff) __builtin_amdgcn_global_load_lds((const unsigned*)(srcp), (LAS unsigned*)(lds + (dstoff)), 16, 0, 0)
            for (int unit = vcu; unit < 512; unit += G) {
                const int bh = unit >> 6, c = unit & 63, b = bh >> 2, h = bh & 3, sc = c >> 2, cq = c & 3;
                const float lgf = __builtin_amdgcn_logf(1.0f - __builtin_amdgcn_exp2f(-5.0f - (float)h)), lgb = __builtin_amdgcn_logf(1.0f - __builtin_amdgcn_exp2f(-5.5f - (float)h));
                const bf16* Qsrc = QB + (size_t)(b * SEQ + c * 128) * D + h * DK;
                const bf16* Ksrc = KB + (size_t)(b * SEQ + sc * SC) * D + h * DK;
                const bf16* SFsrc = SFB + (size_t)((bh * NSC + sc) * DV) * DK; const bf16* SBsrc = SBB + (size_t)((bh * NSC + sc) * DV) * DK;
                const bf16* Vsrc = VT + (size_t)((bh * 64 + sc * 4) * DV) * 128;
                f32x4 acc[4][8], sacc[4][2];
#pragma unroll
                for (int m = 0; m < 4; ++m)
#pragma unroll
                    for (int n = 0; n < 8; ++n) acc[m][n] = (f32x4){0.f, 0.f, 0.f, 0.f};
#define BP_ISSUE(idx) do { const int i_ = (idx); const int so_ = (i_ % 3) * SLOT; const int l_ = opaque(lane); \
                    if (i_ < 16) { const int s_ = i_ & 7; const bf16* bs_ = (i_ < 8 ? SFsrc : SBsrc) + 32 * s_; const int rr_ = l_ >> 2, ch_ = (l_ & 3) ^ ((l_ >> 4) & 3); \
                        BP_GLDS(Qsrc + (unsigned)((16 * wave + rr_) * D + 32 * s_ + 8 * ch_), so_ + wave * 1024); \
                        _Pragma("unroll") for (int q = 0; q < 4; ++q) BP_GLDS(bs_ + (unsigned)((16 * (wave + 8 * q) + rr_) * DK + 8 * ch_), so_ + 8192 + (wave + 8 * q) * 1024); } \
                    else { const int j_ = (i_ - 16) >> 3, r8_ = (i_ - 16) & 7; \
                        if (r8_ < 4) { const int rr_ = l_ >> 3, ch_ = (l_ & 7) ^ ((l_ >> 4) & 3) ^ (4 * (wave & 1)); \
                            _Pragma("unroll") for (int q = 0; q < 2; ++q) { const int row_ = 8 * (wave + 8 * q) + rr_; \
                                BP_GLDS(Qsrc + (unsigned)(row_ * D + 64 * r8_ + 8 * ch_), so_ + (wave + 8 * q) * 1024); \
                                BP_GLDS(Ksrc + (unsigned)((128 * j_ + row_) * D + 64 * r8_ + 8 * ch_), so_ + 16384 + (wave + 8 * q) * 1024); } } \
                        else { const int rr_ = l_ >> 2, ch_ = (l_ & 3) ^ ((l_ >> 4) & 3); const bf16* bs_ = Vsrc + (size_t)j_ * (DV * 128) + 32 * (r8_ - 4); \
                            _Pragma("unroll") for (int q = 0; q < 4; ++q) BP_GLDS(bs_ + (unsigned)((16 * (wave + 8 * q) + rr_) * 128 + 8 * ch_), so_ + 8192 + (wave + 8 * q) * 1024); } } } while (0)
#define BP_NLOADS(idx) (((idx) >= 48) ? 0 : ((idx) < 16 ? 5 : 4))
#define BP_TOP(idx) do { BP_WAITV(BP_NLOADS((idx) + 1)); asm volatile("s_waitcnt lgkmcnt(0)" ::: "memory"); __builtin_amdgcn_s_barrier(); asm volatile("" ::: "memory"); \
                    if ((idx) + 2 < 48) BP_ISSUE((idx) + 2); } while (0)
#define BP_MMA_FULL(AADDR, so) do { bf16x8 af_[4]; const int l_ = opaque(lane), fr = l_ & 15, fq = l_ >> 4; \
                    _Pragma("unroll") for (int m = 0; m < 4; ++m) af_[m] = *(const LAS bf16x8*)(lds + AADDR(64 * wr + 16 * m + fr, fr, fq)); \
                    _Pragma("unroll") for (int nh = 0; nh < 4; ++nh) { bf16x8 bf_[2]; \
                        _Pragma("unroll") for (int n = 0; n < 2; ++n) bf_[n] = *(const LAS bf16x8*)(lds + (so) + 8192 + (128 * wc + 32 * nh + 16 * n + fr) * 64 + ((fq ^ (fr >> 2)) & 3) * 16); \
                        _Pragma("unroll") for (int m = 0; m < 4; ++m) _Pragma("unroll") for (int n = 0; n < 2; ++n) \
                            acc[m][2 * nh + n] = __builtin_amdgcn_mfma_f32_16x16x32_bf16(bf_[n], af_[m], acc[m][2 * nh + n], 0, 0, 0); } } while (0)
                __builtin_amdgcn_s_barrier();
                BP_ISSUE(0); BP_ISSUE(1);
                for (int idx = 0; idx < 16; ++idx) {
                    BP_TOP(idx);
                    const int so = (idx % 3) * SLOT;
#define AADDR_X(row, fr, fq) (so + (row) * 64 + (((fq) ^ ((fr) >> 2)) & 3) * 16)
                    BP_MMA_FULL(AADDR_X, so);
#undef AADDR_X
                    if (idx == 7 || idx == 15) { const int fr = opaque(lane) & 15;
#pragma unroll
                        for (int m = 0; m < 4; ++m) { const int il = 128 * cq + 64 * wr + 16 * m + fr;
                            const float sc_ = (idx == 7) ? __builtin_amdgcn_exp2f((float)(il + 1) * lgf - (float)(SC - il) * lgb) : __builtin_amdgcn_exp2f((float)(SC - il) * lgb);
#pragma unroll
                            for (int n = 0; n < 8; ++n) acc[m][n] *= sc_; }
                    }
                }
                for (int j = 0; j < 4; ++j) {
#pragma unroll
                    for (int m = 0; m < 4; ++m) { sacc[m][0] = (f32x4){0.f, 0.f, 0.f, 0.f}; sacc[m][1] = (f32x4){0.f, 0.f, 0.f, 0.f}; }
                    for (int r = 0; r < 4; ++r) {
                        const int idx = 16 + 8 * j + r;
                        BP_TOP(idx);
                        const int so = (idx % 3) * SLOT;
                        { const int l_ = opaque(lane), fr = l_ & 15, fq = l_ >> 4;
#pragma unroll
                          for (int ks = 0; ks < 2; ++ks) { bf16x8 af_[4], kf_[2]; const int cx = ((4 * ks + fq) ^ (fr >> 1)) & 7;
#pragma unroll
                              for (int m = 0; m < 4; ++m) af_[m] = *(const LAS bf16x8*)(lds + so + (64 * wr + 16 * m + fr) * 128 + cx * 16);
#pragma unroll
                              for (int n = 0; n < 2; ++n) kf_[n] = *(const LAS bf16x8*)(lds + so + 16384 + (32 * wc + 16 * n + fr) * 128 + cx * 16);
#pragma unroll
                              for (int m = 0; m < 4; ++m)
#pragma unroll
                                  for (int n = 0; n < 2; ++n) sacc[m][n] = __builtin_amdgcn_mfma_f32_16x16x32_bf16(kf_[n], af_[m], sacc[m][n], 0, 0, 0); } }
                        if (r == 3) {
                            const int l_ = opaque(lane), fr = l_ & 15, fq = l_ >> 4;
#pragma unroll
                            for (int m = 0; m < 4; ++m)
#pragma unroll
                                for (int n = 0; n < 2; ++n) { const int il = 128 * cq + 64 * wr + 16 * m + fr, jl0 = 128 * j + 32 * wc + 16 * n + 4 * fq; float pv[4];
#pragma unroll
                                    for (int e = 0; e < 4; ++e) { const int dl = il - (jl0 + e);
                                        const float dec = dl > 0 ? __builtin_amdgcn_exp2f((float)dl * lgf) : (dl < 0 ? __builtin_amdgcn_exp2f((float)(-dl) * lgb) : 2.0f); pv[e] = sacc[m][n][e] * dec; }
                                    u32x2 w; w.x = pk2(pv[0], pv[1]); w.y = pk2(pv[2], pv[3]);
                                    *(LAS u32x2*)(lds + PBUF + (64 * wr + 16 * m + fr) * 256 + (((4 * wc + 2 * n + (fq >> 1)) ^ fr) & 15) * 16 + (fq & 1) * 8) = w; }
                        }
                    }
                    for (int r = 0; r < 4; ++r) {
                        const int idx = 16 + 8 * j + 4 + r;
                        BP_TOP(idx);
                        const int so = (idx % 3) * SLOT;
#define AADDR_P(row, fr, fq) (PBUF + (row) * 256 + (((4 * r + (fq)) ^ (fr)) & 15) * 16)
                        BP_MMA_FULL(AADDR_P, so);
#undef AADDR_P
                    }
                }
                asm volatile("s_waitcnt vmcnt(0) lgkmcnt(0)" ::: "memory"); __builtin_amdgcn_s_barrier(); asm volatile("" ::: "memory");
                { LAS float* red = (LAS float*)(lds + REDB); const int l_ = opaque(lane), fr = l_ & 15, fq = l_ >> 4;
#pragma unroll
                  for (int m = 0; m < 4; ++m) { float ss = 0.f;
#pragma unroll
                      for (int n = 0; n < 8; ++n) ss += (acc[m][n][0] * acc[m][n][0] + acc[m][n][1] * acc[m][n][1]) + (acc[m][n][2] * acc[m][n][2] + acc[m][n][3] * acc[m][n][3]);
                      ss += __shfl_xor(ss, 16); ss += __shfl_xor(ss, 32);
                      if (fq == 0) red[(64 * wr + 16 * m + fr) * 4 + wc] = ss; }
                  __syncthreads();
                  bf16* gp0 = GB + (size_t)(b * SEQ + c * 128 + 64 * wr + fr) * 2048 + h * DV + 128 * wc + 4 * fq;
#pragma unroll
                  for (int mh = 0; mh < 4; mh += 2) {
                      u32x2 gw[2][8];
#pragma unroll
                      for (int q = 0; q < 2; ++q)
#pragma unroll
                          for (int n = 0; n < 8; ++n) gw[q][n] = *(const u32x2*)(gp0 + (size_t)(16 * (mh + q)) * 2048 + 16 * n);
#pragma unroll
                      for (int q = 0; q < 2; ++q) { const int m = mh + q, row = 64 * wr + 16 * m + fr; const f32x4 t4 = *(const LAS f32x4*)(red + row * 4);
                          const float rs = 1.0f / sqrtf(((t4[0] + t4[1]) + (t4[2] + t4[3])) * (1.0f / DV) + EPS);
                          bf16* gp = gp0 + (size_t)(16 * m) * 2048;
#pragma unroll
                          for (int n = 0; n < 8; ++n) {
                              const float o0 = siluf(bflo(gw[q][n].x)) * acc[m][n][0] * rs, o1 = siluf(bfhi(gw[q][n].x)) * acc[m][n][1] * rs, o2 = siluf(bflo(gw[q][n].y)) * acc[m][n][2] * rs, o3 = siluf(bfhi(gw[q][n].y)) * acc[m][n][3] * rs;
                              u32x2 w; w.x = pk2(o0, o1); w.y = pk2(o2, o3); if (!(PROBE_DUP == 4 && rep == 1)) *(u32x2*)(gp + 16 * n) = w; } } }
                  __syncthreads();
                }
            }
#undef BP_WAITV
#undef BP_GLDS
#undef BP_ISSUE
#undef BP_NLOADS
#undef BP_TOP
#undef BP_MMA_FULL
        } break;
        case 5: case 7: case 10: case 12: if (PHMASK & (1<<5)) {
            const int l = (ph >= 10) ? 1 : 0; const float* adal = ADA + l * 3 * NQ;
            if (ph == 5) WPREP_JOBS(0, 1, gw, NGW);
            pg8::StaticOrder S; S.init(M, D, G, bx);
            if (ph == 12) {
                pg8::Gemm g{HID, (const bf16*)(ws + WS_W2_1), M, D, FF, 0};
                EpiResFinal E{XB, args.out, adal + 5 * D, args.in[IN_FN], (float*)(ws + MS_XPART), ctl, lds + RSTD_LDS};
                pg8::gemm_phase<EpiResFinal, pg8::StaticOrder, true, true, false>(lds, g, S, E, tid);
            } else {
                pg8::Gemm g; EpiRes E;
                if (ph == 5) { g = pg8::Gemm{GB, WO, M, D, 2048, 0}; E = EpiRes{x, nullptr, XB, adal + 2 * D, SSQ, 0}; }
                else if (ph == 7) { g = pg8::Gemm{HID, (const bf16*)(ws + WS_W2_0), M, D, FF, 0}; E = EpiRes{nullptr, XB, XB, adal + 5 * D, SSQ, 0}; }
                else { g = pg8::Gemm{ACV, WCO, M, D, D, 0}; E = EpiRes{nullptr, XB, XB, adal + 2 * D, SSQ, 0}; }
                E.dry = (PROBE_DUP == ph && rep == 1) ? 1 : 0;
                pg8::gemm_phase<EpiRes, pg8::StaticOrder, true, true, false>(lds, g, S, E, tid);
            }
        } break;
        case 6: case 11: if (PHMASK & (1<<6)) {
            const int l = (ph == 11) ? 1 : 0;
            pg8::Gemm g{XB, W13[l], M, 5632, D, (size_t)5632 * D * 2}; pg8::StaticOrder S; S.init(M, 5632, G, bx);
#define BS_FFN(u, t) bias_sum(BIAS3 + (l * 2 + ((u).pm >> 5)) * NKQ * 5632, 5632, (u).pn * 256 + (t))
            BUILD_TABS(S, RS_SSQ, BS_FFN);
#undef BS_FFN
            EpiSwiGLU E{HID, (const LAS float*)(lds + RSTD_LDS), (const LAS float*)(lds + BIAS_LDS), (PROBE_DUP == ph && rep == 1 && SSVAR == 21) ? 1 : 0};
            pg8::gemm_phase<EpiSwiGLU, pg8::StaticOrder, true, true, false>(lds, g, S, E, tid);
            if (ph == 6 && bx >= 128) WPREP_JOBS(1, 3, (bx - 128) * NWAVES + wave, (G - 128) * NWAVES);
        } break;
        case 8: if (PHMASK & (1<<8)) {
            pg8::Gemm g{XB, WCI, M, 3072, D, (size_t)3072 * D * 2}; pg8::StaticOrder S; S.init(M, 3072, G, bx);
#define BS_CI(u, t) bias_sum(BIAS5 + ((u).pm >> 5) * NKQ * 3072, 3072, (u).pn * 256 + (t))
            BUILD_TABS(S, RS_SSQ, BS_CI);
#undef BS_CI
            EpiConvIn E{CU, CB, (const LAS float*)(lds + RSTD_LDS), (const LAS float*)(lds + BIAS_LDS)};
            pg8::gemm_phase<EpiConvIn, pg8::StaticOrder, true, true, false>(lds, g, S, E, tid);
        } break;
        case 9: if (PHMASK & (1<<9)) {
            const float* cw = args.in[IN_CW];
            for (int it = bx * NTHR + tid; it < M * (D / 8); it += G * NTHR) {
                const int r = it >> 7, k = (it & 127) * 8, t = r & (SEQ - 1);
                float u0[8], um[8], up[8], bb[8];
                unpack8(*(const u32x4*)(CU + (size_t)r * D + k), u0); unpack8(*(const u32x4*)(CB + (size_t)r * D + k), bb);
                if (t > 0) unpack8(*(const u32x4*)(CU + (size_t)(r - 1) * D + k), um); else { for (int q = 0; q < 8; ++q) um[q] = 0.f; }
                if (t < SEQ - 1) unpack8(*(const u32x4*)(CU + (size_t)(r + 1) * D + k), up); else { for (int q = 0; q < 8; ++q) up[q] = 0.f; }
                float o[8];
#pragma unroll
                for (int q = 0; q < 8; ++q) o[q] = bb[q] * (cw[k + q] * um[q] + cw[D + k + q] * u0[q] + cw[2 * D + k + q] * up[q]);
                u32x4 w; w.x = pk2(o[0], o[1]); w.y = pk2(o[2], o[3]); w.z = pk2(o[4], o[5]); w.w = pk2(o[6], o[7]);
                *(u32x4*)(ACV + (size_t)r * D + k) = w;
            }
        } break;
        case 13: if (PHMASK & (1<<13)) {
            const float* fn = args.in[IN_FN];
            for (int it = bx * NTHR + tid; it < M * (D / 4); it += G * NTHR) {
                const int r = it >> 8, k = (it & 255) * 4; const float rs = rstd_from_ssq(SSQ, r);
                const u32x2 hw = *(const u32x2*)(XB + (size_t)r * D + k); const f32x4 hv = {bflo(hw.x), bfhi(hw.x), bflo(hw.y), bfhi(hw.y)};
                *(f32x4*)(args.out + (size_t)r * D + k) = hv * rs * *(const f32x4*)(fn + k);
            }
        } break;
        default: break;
        }
        if (ph0 < args.ph_hi) xcd_barrier(bar);
        if (SSVAR == 6 && ph == 6) { for (int e_ = 0; e_ < 10; ++e_) xcd_barrier(bar); }
    }
}

#ifndef MK_PER_PHASE
#define MK_PER_PHASE 0
#endif
extern "C" void kernel_launch(void* const* d_in, const int* in_sizes, int n_in, void* d_out, int out_size, void* d_ws, size_t ws_size, hipStream_t stream) {
    static int grid = 0;
    if (grid == 0) {
        if (n_in != N_IN || out_size != M * D || ws_size < WS_END) { fprintf(stderr, "kernel_launch: unexpected shapes (n_in %d, out %d, ws %zu); nothing launched\n", n_in, out_size, ws_size); grid = -1; return; }
        int dev = 0, cus = 0, per_cu = 0;
        if (hipGetDevice(&dev) != hipSuccess || hipDeviceGetAttribute(&cus, hipDeviceAttributeMultiprocessorCount, dev) != hipSuccess) { grid = -1; return; }
        if (hipFuncSetAttribute((const void*)fwd_kernel, hipFuncAttributeMaxDynamicSharedMemorySize, LDS_BYTES) != hipSuccess) { fprintf(stderr, "kernel_launch: hipFuncSetAttribute failed\n"); grid = -1; return; }
        if (hipOccupancyMaxActiveBlocksPerMultiprocessor(&per_cu, (const void*)fwd_kernel, NTHR, LDS_BYTES) != hipSuccess || per_cu < 1) { fprintf(stderr, "kernel_launch: occupancy query says %d blocks per CU\n", per_cu); }
        (void)hipGetLastError();
        grid = cus;
    }
    if (grid < 0) return;
    (void)hipMemsetAsync((char*)d_ws + WS_CTL, 0, CTL_ZERO_BYTES, stream);
    Args a{};
    for (int i = 0; i < N_IN; ++i) a.in[i] = (const float*)d_in[i];
    a.out = (float*)d_out; a.ws = (unsigned char*)d_ws;
#if MK_PER_PHASE
    for (int p = 0; p < NPH; ++p) { a.ph_lo = p; a.ph_hi = p + 1; hipLaunchKernelGGL(fwd_kernel, dim3(grid), dim3(NTHR), LDS_BYTES, stream, a); }
#else
    a.ph_lo = 0; a.ph_hi = NPH; hipLaunchKernelGGL(fwd_kernel, dim3(grid), dim3(NTHR), LDS_BYTES, stream, a);
#if SSVAR == 7
    (void)hipMemsetAsync((char*)d_ws + WS_CTL, 0, CTL_ZERO_BYTES, stream); hipLaunchKernelGGL(fwd_kernel, dim3(grid), dim3(NTHR), LDS_BYTES, stream, a);
#endif
#endif
}
```

```cpp
#include <hip/hip_runtime.h>
#include <cstdio>
#include <cstdint>

#define LAS __attribute__((address_space(3)))
#define GAS __attribute__((address_space(1)))
typedef unsigned short bf16;
typedef short bf16x8 __attribute__((ext_vector_type(8)));
typedef float f32x4 __attribute__((ext_vector_type(4)));
typedef float f32x2 __attribute__((ext_vector_type(2)));
typedef unsigned u32x4 __attribute__((ext_vector_type(4)));
typedef unsigned u32x2 __attribute__((ext_vector_type(2)));

__device__ __forceinline__ int opaque(int v) { asm volatile("" : "+v"(v)); return v; }
constexpr int D = 1024, BATCH = 2, SEQ = 8192, M = BATCH * SEQ, CTXL = 256, MC = BATCH * CTXL, NH = 4, DK = 256, DV = 512, FF = 2816, NQ = 6 * D;
constexpr int SC = 512, NSC = SEQ / SC;
constexpr float EPS = 1e-6f;
constexpr int NWAVES = 8, NTHR = 512;

constexpr size_t MiB = 1u << 20, HMiB = 1u << 19;
constexpr size_t WS_CTL = 0, CTL_ZERO_BYTES = 1 * MiB;
constexpr size_t CTL_ADA = 65536;
constexpr size_t WS_MISC = 1 * MiB;
constexpr size_t MS_ROPE = WS_MISC;
constexpr size_t MS_RSTDX = MS_ROPE + 65536;
constexpr size_t MS_RSTDC = MS_RSTDX + 65536;
constexpr size_t MS_BIAS1 = MS_RSTDC + 4096;
constexpr int NKQ = 8;
constexpr size_t MS_BIAS3 = 262144;
constexpr size_t MS_BIAS5 = MS_BIAS1 + 3 * 6144 * 4;
static_assert(MS_BIAS3 + 4 * NKQ * 5632 * 4 <= 1 * MiB && MS_BIAS5 + 2 * NKQ * 3072 * 4 <= 1 * MiB + 512 * 1024, "misc region");
constexpr size_t MS_XPART = 1 * MiB + 512 * 1024;
constexpr size_t WS_SSQ = 2 * MiB;
constexpr size_t WS_WQKVG = 3 * MiB;
constexpr size_t WS_WO = 15 * MiB;
constexpr size_t WS_W2_0 = 19 * MiB;
constexpr size_t WS_W2_1 = 24 * MiB + HMiB;
constexpr size_t WS_WCO = 30 * MiB;
constexpr size_t WS_ACB = 60 * MiB;
constexpr size_t WS_XB = 61 * MiB;
constexpr size_t WS_Q = 93 * MiB;
constexpr size_t WS_K = 125 * MiB;
constexpr size_t WS_VT = 157 * MiB;
constexpr size_t WS_SB = 221 * MiB;
constexpr size_t WS_KC = 253 * MiB;
constexpr size_t WS_VCT = 254 * MiB;
constexpr size_t WS_SF = WS_XB;
constexpr size_t WS_HID = 93 * MiB;
constexpr size_t WS_CU = 93 * MiB, WS_CB = 125 * MiB, WS_ACV = 157 * MiB;
constexpr size_t WS_W13_0 = 181 * MiB;
constexpr size_t WS_WCI = 203 * MiB;
constexpr size_t WS_W13_1 = 215 * MiB;
constexpr size_t WS_END = 256 * MiB;

namespace pg8 {
typedef unsigned short bf16_t;
constexpr int BM = 256, BK = 64, HALF = 128, HTB = HALF * BK * 2, STAGE_BYTES = 8 * HTB, NXCD = 8, WGM = 8;
__host__ __device__ __forceinline__ int lds_byte(int r, int c) { const int st = (r >> 4) * 2 + (c >> 5), rr = r & 15, cc = c & 31, ob = rr * 64 + cc * 2; return st * 1024 + (ob ^ (((ob >> 9) & 1) << 5)); }
__host__ __device__ __forceinline__ void stage_rc(int b, int& R, int& C) { const int st = b / 1024, sb = b % 1024, swz = sb ^ (((sb >> 9) & 1) << 5); R = (st >> 1) * 16 + swz / 64; C = (st & 1) * 32 + (swz % 64) / 2; }
__host__ __device__ __forceinline__ int perm32(int rho) { const int n = rho >> 4, i = rho & 15; return 8 * (i >> 2) + 4 * n + (i & 3); }
struct Unit { int pm, pn; };
struct Gemm { const bf16_t* A; const bf16_t* Bt; int M, N, K; size_t bstride; };
struct StaticOrder {
    int nM, nN, nwg, G, c;
    __host__ __device__ void init(int M_, int N_, int G_, int c_) { nM = M_ / BM; nN = N_ / BM; nwg = nM * nN; G = G_; c = c_; }
    __host__ __device__ bool next(int i, Unit& u) const {
        const long L = (long)i * G + c; if (L >= nwg) return false;
        int wgid = (int)L; { const int q = nwg / NXCD, r = nwg % NXCD, xcd = wgid % NXCD, off = wgid / NXCD; wgid = (xcd < r ? xcd * (q + 1) : r * (q + 1) + (xcd - r) * q) + off; }
        const int nig = WGM * nN, gid = wgid / nig, fm = gid * WGM, gsz = (nM - fm) < WGM ? (nM - fm) : WGM;
        u.pm = fm + ((wgid % nig) % gsz); u.pn = (wgid % nig) / gsz; return true;
    }
    __device__ __forceinline__ void a_ready(const Unit&) const {}
    __device__ __forceinline__ void done(const Unit&) const {}
};
struct OneUnit { int pm, pn; bool have;
    __device__ __forceinline__ bool next(int i, Unit& u) const { if (i != 0 || !have) return false; u.pm = pm; u.pn = pn; return true; }
    __device__ __forceinline__ void a_ready(const Unit&) const {}
    __device__ __forceinline__ void done(const Unit&) const {}
};
template <class Epi, class Sched, bool ALIGN_EPI, bool SP2, bool SWAP>
__device__ __forceinline__ void gemm_phase(LAS unsigned char* lds, const Gemm g, const Sched& S, const Epi& E, const int tid) {
    const int wid = __builtin_amdgcn_readfirstlane(tid >> 6), wr = wid >> 2, wc = wid & 3;
    int lane = tid & 63, fr = lane & 15, fq = lane >> 4;
    const int K = g.K, nt = K / BK;
    unsigned voffA[2], voffB[2]; int aoff, boff;
#define PG8_SETUP() do { const int t_ = opaque(tid); lane = t_ & 63; fr = lane & 15; fq = lane >> 4; \
        _Pragma("unroll") for (int i = 0; i < 2; ++i) { int R, C; stage_rc(t_ * 16 + i * 8192, R, C); const int Rp = (R & ~31) + perm32(R & 31); \
            voffA[i] = (unsigned)((SWAP ? Rp : R) * K + C) * 2u; voffB[i] = (unsigned)((SWAP ? R : Rp) * K + C) * 2u; } \
        aoff = lds_byte(wr * 64 + fr, fq * 8); boff = lds_byte(wc * 32 + fr, fq * 8); } while (0)
    PG8_SETUP();
    const size_t kstep = (size_t)(BK * 2);
    const size_t hstep = (size_t)HALF * K * 2;
    const size_t tstep = 2 * hstep;
    const unsigned ldsw = (unsigned)wid * 1024u;
#define PG8_SA(b, h) (((b) * 2 + (h)) * HTB)
#define PG8_SB(b, h) ((4 + (b) * 2 + (h)) * HTB)
#define PG8_STAGE(bufoff, gbase, voff) do { _Pragma("unroll") for (int _i = 0; _i < 2; ++_i) \
        __builtin_amdgcn_global_load_lds((const unsigned*)((const char*)(gbase) + (voff)[_i]), (LAS unsigned*)(lds + (bufoff) + ldsw + _i * 8192), 16, 0, 0); } while (0)
#define PG8_LDA(dst, b, h) do { _Pragma("unroll") for (int m = 0; m < 4; ++m) _Pragma("unroll") for (int k = 0; k < 2; ++k) dst[m][k] = *(const LAS bf16x8*)(lds + PG8_SA(b, h) + aoff + m * 2048 + k * 1024); } while (0)
#define PG8_LDB(dst, b, h) do { _Pragma("unroll") for (int n = 0; n < 2; ++n) _Pragma("unroll") for (int k = 0; k < 2; ++k) dst[n][k] = *(const LAS bf16x8*)(lds + PG8_SB(b, h) + boff + n * 2048 + k * 1024); } while (0)
#define PG8_MMA(ai, bj, At, Bt) do { __builtin_amdgcn_s_setprio(1); _Pragma("unroll") for (int m = 0; m < 4; ++m) _Pragma("unroll") for (int n = 0; n < 2; ++n) _Pragma("unroll") for (int k = 0; k < 2; ++k) \
        acc[ai][bj][m][n] = SWAP ? __builtin_amdgcn_mfma_f32_16x16x32_bf16(At[m][k], Bt[n][k], acc[ai][bj][m][n], 0, 0, 0) \
                                 : __builtin_amdgcn_mfma_f32_16x16x32_bf16(Bt[n][k], At[m][k], acc[ai][bj][m][n], 0, 0, 0); __builtin_amdgcn_s_setprio(0); } while (0)
#define PG8_WAIT_V(n) asm volatile("s_waitcnt vmcnt(" #n ")" ::: "memory")
#define PG8_WAIT_L(n) asm volatile("s_waitcnt lgkmcnt(" #n ")" ::: "memory")
#define PG8_BAR __builtin_amdgcn_s_barrier()
#define PG8_SCHED __builtin_amdgcn_sched_barrier(0)
    Unit cur, nxt; int ui = 0;
    if (!S.next(0, cur)) return;
    f32x4 acc[2][2][4][2];
#pragma unroll
    for (int a = 0; a < 2; ++a)
#pragma unroll
        for (int b = 0; b < 2; ++b)
#pragma unroll
            for (int m = 0; m < 4; ++m)
#pragma unroll
                for (int n = 0; n < 2; ++n) acc[a][b][m][n] = (f32x4){0.f, 0.f, 0.f, 0.f};
    bf16x8 At[4][2], B0[2][2], B1[2][2];
    const char* cA = (const char*)g.A + (size_t)cur.pm * tstep; const char* cB = (const char*)g.Bt + (size_t)cur.pn * tstep + (cur.pm >= 32 ? g.bstride : 0);
    S.a_ready(cur);
    if constexpr (SP2) {
        PG8_STAGE(PG8_SB(0, 0), cB, voffB); PG8_STAGE(PG8_SB(0, 1), cB + hstep, voffB); PG8_STAGE(PG8_SA(0, 0), cA, voffA); PG8_STAGE(PG8_SA(0, 1), cA + hstep, voffA);
        if (wr == 1) PG8_BAR;
        PG8_WAIT_V(2); PG8_BAR;
        PG8_STAGE(PG8_SB(1, 0), cB + kstep, voffB); PG8_STAGE(PG8_SA(1, 0), cA + kstep, voffA); PG8_STAGE(PG8_SB(1, 1), cB + hstep + kstep, voffB);
        PG8_WAIT_V(6); PG8_BAR;
    } else {
        PG8_STAGE(PG8_SB(0, 0), cB, voffB); PG8_STAGE(PG8_SA(0, 0), cA, voffA); PG8_STAGE(PG8_SB(0, 1), cB + hstep, voffB); PG8_STAGE(PG8_SA(0, 1), cA + hstep, voffA);
        if (wr == 1) PG8_BAR;
        PG8_WAIT_V(4); PG8_BAR;
        PG8_STAGE(PG8_SB(1, 0), cB + kstep, voffB); PG8_STAGE(PG8_SA(1, 0), cA + kstep, voffA); PG8_STAGE(PG8_SB(1, 1), cB + hstep + kstep, voffB);
        PG8_WAIT_V(6); PG8_BAR;
    }
    for (;;) {
        const bool has_next = S.next(ui + 1, nxt);
        const char* nA = has_next ? (const char*)g.A + (size_t)nxt.pm * tstep : cA; const char* nB = has_next ? (const char*)g.Bt + (size_t)nxt.pn * tstep + (nxt.pm >= 32 ? g.bstride : 0) : cB;
        for (int t = 0; t < nt; t += 2) {
            const bool last = (t == nt - 2);
            const char* a1 = cA + (size_t)(t + 1) * kstep;
            const char* a2 = last ? nA : cA + (size_t)(t + 2) * kstep; const char* b2 = last ? nB : cB + (size_t)(t + 2) * kstep;
            const char* a3 = a2 + kstep; const char* b3 = b2 + kstep;
            if (last && has_next) S.a_ready(nxt);
            if constexpr (SP2) {
            PG8_LDB(B0, 0, 0); PG8_LDB(B1, 0, 1); PG8_SCHED; PG8_LDA(At, 0, 0); PG8_STAGE(PG8_SA(1, 1), a1 + hstep, voffA);
            PG8_WAIT_V(8); PG8_WAIT_L(0); PG8_BAR; PG8_MMA(0, 0, At, B0); PG8_MMA(0, 1, At, B1); PG8_BAR; PG8_SCHED;
            PG8_LDA(At, 0, 1); PG8_STAGE(PG8_SB(0, 0), b2, voffB); PG8_STAGE(PG8_SB(0, 1), b2 + hstep, voffB); PG8_STAGE(PG8_SA(0, 0), a2, voffA);
            PG8_WAIT_V(8); PG8_WAIT_L(0); PG8_BAR; PG8_MMA(1, 0, At, B0); PG8_MMA(1, 1, At, B1); PG8_BAR; PG8_SCHED;
            PG8_LDB(B0, 1, 0); PG8_LDB(B1, 1, 1); PG8_SCHED; PG8_LDA(At, 1, 0); PG8_STAGE(PG8_SA(0, 1), a2 + hstep, voffA);
            PG8_WAIT_V(8); PG8_WAIT_L(0); PG8_BAR; PG8_MMA(0, 0, At, B0); PG8_MMA(0, 1, At, B1); PG8_BAR; PG8_SCHED;
            PG8_LDA(At, 1, 1); PG8_STAGE(PG8_SB(1, 0), b3, voffB); PG8_STAGE(PG8_SB(1, 1), b3 + hstep, voffB); PG8_STAGE(PG8_SA(1, 0), a3, voffA);
            PG8_WAIT_V(8); PG8_WAIT_L(0); PG8_BAR; PG8_MMA(1, 0, At, B0); PG8_MMA(1, 1, At, B1); PG8_BAR; PG8_SCHED;
            } else {
            PG8_LDB(B0, 0, 0); PG8_SCHED; PG8_LDA(At, 0, 0); PG8_STAGE(PG8_SA(1, 1), a1 + hstep, voffA);
            PG8_WAIT_L(8); PG8_BAR; PG8_WAIT_L(0); PG8_MMA(0, 0, At, B0); PG8_BAR; PG8_SCHED;
            PG8_LDB(B1, 0, 1); PG8_STAGE(PG8_SB(0, 0), b2, voffB);
            PG8_BAR; PG8_WAIT_L(0); PG8_MMA(0, 1, At, B1); PG8_BAR;
            PG8_LDA(At, 0, 1); PG8_STAGE(PG8_SA(0, 0), a2, voffA);
            PG8_BAR; PG8_WAIT_L(0); PG8_MMA(1, 0, At, B0); PG8_BAR; PG8_SCHED;
            PG8_STAGE(PG8_SB(0, 1), b2 + hstep, voffB);
            PG8_WAIT_V(6); PG8_BAR; PG8_MMA(1, 1, At, B1); PG8_BAR;
            PG8_LDB(B0, 1, 0); PG8_SCHED; PG8_LDA(At, 1, 0); PG8_STAGE(PG8_SA(0, 1), a2 + hstep, voffA);
            PG8_WAIT_L(8); PG8_BAR; PG8_WAIT_L(0); PG8_MMA(0, 0, At, B0); PG8_BAR; PG8_SCHED;
            PG8_LDB(B1, 1, 1); PG8_STAGE(PG8_SB(1, 0), b3, voffB);
            PG8_BAR; PG8_WAIT_L(0); PG8_MMA(0, 1, At, B1); PG8_BAR;
            PG8_LDA(At, 1, 1); PG8_STAGE(PG8_SA(1, 0), a3, voffA);
            PG8_BAR; PG8_WAIT_L(0); PG8_MMA(1, 0, At, B0); PG8_BAR; PG8_SCHED;
            PG8_STAGE(PG8_SB(1, 1), b3 + hstep, voffB);
            PG8_WAIT_V(6); PG8_BAR; PG8_MMA(1, 1, At, B1); PG8_BAR;
            }
        }
        if constexpr (ALIGN_EPI) { if (wr == 0) PG8_BAR; }
        E(acc, cur, wr, wc, fr, fq, ui); S.done(cur);
        PG8_SETUP();
        if (!has_next) break;
#pragma unroll
        for (int a = 0; a < 2; ++a)
#pragma unroll
            for (int b = 0; b < 2; ++b)
#pragma unroll
                for (int m = 0; m < 4; ++m)
#pragma unroll
                    for (int n = 0; n < 2; ++n) acc[a][b][m][n] = (f32x4){0.f, 0.f, 0.f, 0.f};
        cur = nxt; cA = nA; cB = nB; ++ui;
        if constexpr (ALIGN_EPI) { if (wr == 1) PG8_BAR; }
    }
    PG8_WAIT_V(0);
    if constexpr (!ALIGN_EPI) { if (wr == 0) PG8_BAR; }
    PG8_BAR;
#undef PG8_SETUP
#undef PG8_SA
#undef PG8_SB
#undef PG8_STAGE
#undef PG8_LDA
#undef PG8_LDB
#undef PG8_MMA
#undef PG8_WAIT_V
#undef PG8_WAIT_L
#undef PG8_BAR
#undef PG8_SCHED
}
}

#define RLX_AGENT __ATOMIC_RELAXED, __HIP_MEMORY_SCOPE_AGENT
#define LDS_WAIT() asm volatile("s_waitcnt lgkmcnt(0)" ::: "memory")
typedef __bf16 hbf16x2 __attribute__((ext_vector_type(2)));
__device__ __forceinline__ unsigned pk2(float lo, float hi) { const f32x2 v = {lo, hi}; return __builtin_bit_cast(unsigned, __builtin_convertvector(v, hbf16x2)); }
__device__ __forceinline__ unsigned f2bf(float f) { return pk2(f, 0.f) & 0xffffu; }
__device__ __forceinline__ float bf2f(unsigned h) { return __builtin_bit_cast(float, h << 16); }
__device__ __forceinline__ float bflo(unsigned w) { return __builtin_bit_cast(float, w << 16); }
__device__ __forceinline__ float bfhi(unsigned w) { return __builtin_bit_cast(float, w & 0xffff0000u); }
__device__ __forceinline__ float siluf(float x) { return x * __builtin_amdgcn_rcpf(1.0f + __builtin_amdgcn_exp2f(-1.44269504089f * x)); }
__device__ __forceinline__ float wave_sum(float v) {
#pragma unroll
    for (int o = 1; o < 64; o <<= 1) v += __shfl_xor(v, o);
    return v;
}
__device__ __forceinline__ u32x4 pack8(const f32x4 a, const f32x4 b) { u32x4 w; w.x = pk2(a[0], a[1]); w.y = pk2(a[2], a[3]); w.z = pk2(b[0], b[1]); w.w = pk2(b[2], b[3]); return w; }

using pg8::Unit;
typedef f32x4 Acc[2][2][4][2];
struct EpiQKG {
    bf16* Q; bf16* K; bf16* G; const float* rstd; const float* bias;
    __device__ __forceinline__ void operator()(const Acc& acc, const Unit& u, int wr, int wc, int fr_, int fq_, int ui) const {
        const int fr = opaque(fr_), fq = opaque(fq_);
        const int b = u.pm >> 5; const float* bb = bias + b * NQ + u.pn * 256 + wc * 32 + 8 * fq;
        const int row0 = u.pm * 256 + wr * 64 + fr;
        f32x4 bv[2][2]; float rs[2][4];
#pragma unroll
        for (int ai = 0; ai < 2; ++ai)
#pragma unroll
            for (int m = 0; m < 4; ++m) rs[ai][m] = rstd[row0 + ai * 128 + m * 16];
#pragma unroll
        for (int bj = 0; bj < 2; ++bj)
#pragma unroll
            for (int n = 0; n < 2; ++n) bv[bj][n] = *(const f32x4*)(bb + bj * 128 + 4 * n);
        if (u.pn < 8) {
            const bool isk = u.pn >= 4; bf16* O = isk ? K : Q; const float osc = isk ? 0.0625f : 1.0f;
            const int a = wc >> 1, i0 = (wc & 1) * 32 + 8 * fq, colo = (u.pn & 3) * 256 + wc * 32 + 8 * fq;
            f32x4 frv[2];
#pragma unroll
            for (int n = 0; n < 2; ++n)
#pragma unroll
                for (int j = 0; j < 4; ++j) frv[n][j] = __builtin_amdgcn_exp2f(-(float)(i0 + 4 * n + j) * (13.287712379549449f / 64.0f)) * 0.15915494309189535f;
#pragma unroll
            for (int ai = 0; ai < 2; ++ai)
#pragma unroll
                for (int m = 0; m < 4; ++m) {
                    const int r = row0 + ai * 128 + m * 16; const float rsv = rs[ai][m]; const int t = r & (SEQ - 1); const float pos = (float)(a ? (t & 63) : (t >> 6));
                    f32x4 o1[2], o2[2];
#pragma unroll
                    for (int n = 0; n < 2; ++n) {
                        f32x4 cs, sn;
#pragma unroll
                        for (int j = 0; j < 4; ++j) { const float rv = __builtin_amdgcn_fractf(pos * frv[n][j]); cs[j] = __builtin_amdgcn_cosf(rv); sn[j] = __builtin_amdgcn_sinf(rv); }
                        const f32x4 x1 = acc[ai][0][m][n] * rsv + bv[0][n], x2 = acc[ai][1][m][n] * rsv + bv[1][n];
                        o1[n] = (x1 * cs - x2 * sn) * osc; o2[n] = (x1 * sn + x2 * cs) * osc;
                    }
                    bf16* rowp = O + (size_t)r * D + colo;
                    *(u32x4*)(rowp) = pack8(o1[0], o1[1]); *(u32x4*)(rowp + 128) = pack8(o2[0], o2[1]);
                }
        } else {
            const int colo = (u.pn - 8) * 256 + wc * 32 + 8 * fq;
#pragma unroll
            for (int ai = 0; ai < 2; ++ai)
#pragma unroll
                for (int m = 0; m < 4; ++m) {
                    const int r = row0 + ai * 128 + m * 16; const float rsv = rs[ai][m]; bf16* rowp = G + (size_t)r * 2048 + colo;
#pragma unroll
                    for (int bj = 0; bj < 2; ++bj) *(u32x4*)(rowp + bj * 128) = pack8(acc[ai][bj][m][0] * rsv + bv[bj][0], acc[ai][bj][m][1] * rsv + bv[bj][1]);
                }
        }
    }
};
struct EpiVT {
    bf16* VT; const float* rstd; const float* bias; int ldt; int tiles_per_b; int bias_row;
    __device__ __forceinline__ void operator()(const Acc& acc, const Unit& u, int wr, int wc, int fr_, int fq_, int ui) const {
        const int fr = opaque(fr_), fq = opaque(fq_);
        const int b = u.pm / tiles_per_b, t00 = (u.pm % tiles_per_b) * 256 + wr * 64 + 8 * fq, h = u.pn >> 1, e0 = (u.pn & 1) * 256 + wc * 32 + fr;
        const float* bb = bias + (bias_row < 0 ? b : bias_row) * NQ;
        float bs[2][2];
#pragma unroll
        for (int bj = 0; bj < 2; ++bj)
#pragma unroll
            for (int n = 0; n < 2; ++n) bs[bj][n] = bb[u.pn * 256 + bj * 128 + wc * 32 + n * 16 + fr];
        f32x4 rsv[2][2][2];
#pragma unroll
        for (int ai = 0; ai < 2; ++ai)
#pragma unroll
            for (int mp = 0; mp < 2; ++mp) { const float* rp = rstd + b * ldt + t00 + ai * 128 + mp * 32; rsv[ai][mp][0] = *(const f32x4*)rp; rsv[ai][mp][1] = *(const f32x4*)(rp + 4); }
#pragma unroll
        for (int ai = 0; ai < 2; ++ai)
#pragma unroll
            for (int mp = 0; mp < 2; ++mp) {
                const int tl = t00 + ai * 128 + mp * 32;
                const f32x4 r0 = rsv[ai][mp][0], r1 = rsv[ai][mp][1];
#pragma unroll
                for (int bj = 0; bj < 2; ++bj)
#pragma unroll
                    for (int n = 0; n < 2; ++n) {
                        const f32x4 v0 = acc[ai][bj][2 * mp][n] * r0 + bs[bj][n], v1 = acc[ai][bj][2 * mp + 1][n] * r1 + bs[bj][n];
                        bf16* p = VT + ((size_t)(((b * NH + h) * (ldt >> 7) + (tl >> 7)) * DV + e0 + bj * 128 + n * 16)) * 128 + (tl & 127);
                        *(u32x4*)p = pack8(v0, v1);
                    }
            }
    }
};
struct EpiRes {
    const float* res32; const bf16* res16; bf16* hx; const float* gate; float* ssq; int dry;
    __device__ __forceinline__ void operator()(const Acc& acc, const Unit& u, int wr, int wc, int fr_, int fq_, int ui) const {
        const int fr = opaque(fr_), fq = opaque(fq_);
        const int b = u.pm >> 5, col0 = u.pn * 256 + wc * 32 + 8 * fq, row0 = u.pm * 256 + wr * 64 + fr;
        f32x4 gv[2][2];
#pragma unroll
        for (int bj = 0; bj < 2; ++bj)
#pragma unroll
            for (int n = 0; n < 2; ++n) gv[bj][n] = *(const f32x4*)(gate + b * NQ + col0 + bj * 128 + 4 * n);
#pragma unroll
        for (int am = 0; am < 8; am += 2) {
            f32x4 rv[2][2][2];
            if (res32) {
#pragma unroll
                for (int q = 0; q < 2; ++q)
#pragma unroll
                    for (int bj = 0; bj < 2; ++bj) { const float* p = res32 + (size_t)(row0 + ((am + q) >> 2) * 128 + ((am + q) & 3) * 16) * D + col0 + bj * 128; rv[q][bj][0] = *(const f32x4*)p; rv[q][bj][1] = *(const f32x4*)(p + 4); }
            } else {
                u32x4 rw[2][2];
#pragma unroll
                for (int q = 0; q < 2; ++q)
#pragma unroll
                    for (int bj = 0; bj < 2; ++bj) rw[q][bj] = *(const u32x4*)(res16 + (size_t)(row0 + ((am + q) >> 2) * 128 + ((am + q) & 3) * 16) * D + col0 + bj * 128);
#pragma unroll
                for (int q = 0; q < 2; ++q)
#pragma unroll
                    for (int bj = 0; bj < 2; ++bj) { const u32x4 w = rw[q][bj]; rv[q][bj][0] = (f32x4){bflo(w.x), bfhi(w.x), bflo(w.y), bfhi(w.y)}; rv[q][bj][1] = (f32x4){bflo(w.z), bfhi(w.z), bflo(w.w), bfhi(w.w)}; }
            }
#pragma unroll
            for (int q = 0; q < 2; ++q) {
                const int ai = (am + q) >> 2, m = (am + q) & 3;
                const int r = row0 + ai * 128 + m * 16; const size_t off = (size_t)r * D + col0; float ss = 0.f;
#pragma unroll
                for (int bj = 0; bj < 2; ++bj) {
                    const f32x4 o0 = rv[q][bj][0] + gv[bj][0] * acc[ai][bj][m][0], o1 = rv[q][bj][1] + gv[bj][1] * acc[ai][bj][m][1];
                    ss += (o0[0] * o0[0] + o0[1] * o0[1]) + (o0[2] * o0[2] + o0[3] * o0[3]) + (o1[0] * o1[0] + o1[1] * o1[1]) + (o1[2] * o1[2] + o1[3] * o1[3]);
                    if (!dry) *(u32x4*)(hx + off + bj * 128) = pack8(o0, o1);
                }
                ss += __shfl_xor(ss, 16); ss += __shfl_xor(ss, 32);
                if (fq == 0) ssq[(size_t)r * 16 + u.pn * 4 + wc] = ss;
            }
        }
    }
};
constexpr int CW_PANEL = 8192;
struct EpiResFinal {
    const bf16* res16; float* out; const float* gate; const float* fn; float* xpart; unsigned* cnt; LAS unsigned char* ldsb;
    __device__ __forceinline__ void operator()(Acc& acc, const Unit& u, int wr, int wc, int fr_, int fq_, int ui) const {
        const int fr = opaque(fr_), fq = opaque(fq_), tid = opaque((int)threadIdx.x);
        const int b = u.pm >> 5, col0 = u.pn * 256 + wc * 32 + 8 * fq, row0 = u.pm * 256 + wr * 64 + fr;
        LAS float* part = (LAS float*)ldsb;
        LAS float* rtab = (LAS float*)(ldsb + 4096);
        f32x4 gv[2][2];
#pragma unroll
        for (int bj = 0; bj < 2; ++bj)
#pragma unroll
            for (int n = 0; n < 2; ++n) gv[bj][n] = *(const f32x4*)(gate + b * NQ + col0 + bj * 128 + 4 * n);
#pragma unroll
        for (int am = 0; am < 8; am += 2) {
            u32x4 rw[2][2];
#pragma unroll
            for (int q = 0; q < 2; ++q)
#pragma unroll
                for (int bj = 0; bj < 2; ++bj) rw[q][bj] = *(const u32x4*)(res16 + (size_t)(row0 + ((am + q) >> 2) * 128 + ((am + q) & 3) * 16) * D + col0 + bj * 128);
#pragma unroll
            for (int q = 0; q < 2; ++q) { const int ai = (am + q) >> 2, m = (am + q) & 3; float ss = 0.f;
#pragma unroll
                for (int bj = 0; bj < 2; ++bj) { const u32x4 w = rw[q][bj];
                    const f32x4 o0 = (f32x4){bflo(w.x), bfhi(w.x), bflo(w.y), bfhi(w.y)} + gv[bj][0] * acc[ai][bj][m][0], o1 = (f32x4){bflo(w.z), bfhi(w.z), bflo(w.w), bfhi(w.w)} + gv[bj][1] * acc[ai][bj][m][1];
                    ss += (o0[0] * o0[0] + o0[1] * o0[1]) + (o0[2] * o0[2] + o0[3] * o0[3]) + (o1[0] * o1[0] + o1[1] * o1[1]) + (o1[2] * o1[2] + o1[3] * o1[3]);
                    acc[ai][bj][m][0] = o0; acc[ai][bj][m][1] = o1; }
                ss += __shfl_xor(ss, 16); ss += __shfl_xor(ss, 32);
                if (fq == 0) part[(ai * 128 + wr * 64 + m * 16 + fr) * 4 + wc] = ss; }
        }
        asm volatile("s_waitcnt lgkmcnt(0)" ::: "memory"); __builtin_amdgcn_s_barrier(); asm volatile("" ::: "memory");
        if (tid < 256) { const f32x4 p4 = *(const LAS f32x4*)(part + tid * 4);
            __hip_atomic_store(xpart + (size_t)(u.pm * 256 + tid) * 4 + u.pn, (p4[0] + p4[1]) + (p4[2] + p4[3]), __ATOMIC_RELAXED, __HIP_MEMORY_SCOPE_AGENT); }
        asm volatile("s_waitcnt vmcnt(0)" ::: "memory"); __builtin_amdgcn_s_barrier(); asm volatile("" ::: "memory");
        if (tid == 0) { __hip_atomic_fetch_add(cnt + CW_PANEL + 64 * u.pm, 1u, __ATOMIC_RELAXED, __HIP_MEMORY_SCOPE_AGENT);
            unsigned sp = 0; while (__hip_atomic_load(cnt + CW_PANEL + 64 * u.pm, __ATOMIC_RELAXED, __HIP_MEMORY_SCOPE_AGENT) < 4u) { __builtin_amdgcn_s_sleep(2); if (++sp > (1u << 22)) break; } }
        asm volatile("s_waitcnt vmcnt(0) lgkmcnt(0)" ::: "memory"); __builtin_amdgcn_s_barrier(); asm volatile("" ::: "memory");
        if (tid < 256) { const float* xp = xpart + (size_t)(u.pm * 256 + tid) * 4; float t = 0.f;
#pragma unroll
            for (int q = 0; q < 4; ++q) t += __hip_atomic_load(xp + q, __ATOMIC_RELAXED, __HIP_MEMORY_SCOPE_AGENT);
            rtab[tid] = 1.0f / sqrtf(t * (1.0f / D) + EPS); }
        asm volatile("s_waitcnt vmcnt(0) lgkmcnt(0)" ::: "memory"); __builtin_amdgcn_s_barrier(); asm volatile("" ::: "memory");
        f32x4 fv[2][2];
#pragma unroll
        for (int bj = 0; bj < 2; ++bj)
#pragma unroll
            for (int n = 0; n < 2; ++n) fv[bj][n] = *(const f32x4*)(fn + col0 + bj * 128 + 4 * n);
#pragma unroll
        for (int ai = 0; ai < 2; ++ai)
#pragma unroll
            for (int m = 0; m < 4; ++m) { const float rs = rtab[ai * 128 + wr * 64 + m * 16 + fr]; float* op = out + (size_t)(row0 + ai * 128 + m * 16) * D + col0;
#pragma unroll
                for (int bj = 0; bj < 2; ++bj) { *(f32x4*)(op + bj * 128) = acc[ai][bj][m][0] * rs * fv[bj][0]; *(f32x4*)(op + bj * 128 + 4) = acc[ai][bj][m][1] * rs * fv[bj][1]; } }
    }
};
__device__ __forceinline__ float rstd_from_ssq(const float* ssq, int r) {
    const f32x4* p = (const f32x4*)(ssq + (size_t)r * 16); const f32x4 a = p[0], b = p[1], c = p[2], d = p[3];
    const float s = ((a[0] + a[1]) + (a[2] + a[3])) + ((b[0] + b[1]) + (b[2] + b[3])) + ((c[0] + c[1]) + (c[2] + c[3])) + ((d[0] + d[1]) + (d[2] + d[3]));
    return 1.0f / sqrtf(s * (1.0f / D) + EPS);
}
constexpr int RSTD_LDS = 131072, BIAS_LDS = 131072 + 8192;
struct EpiSwiGLU {
    bf16* HID; const LAS float* rtab; const LAS float* btab; int dry;
    __device__ __forceinline__ void operator()(const Acc& acc, const Unit& u, int wr, int wc, int fr_, int fq_, int ui) const {
        const int fr = opaque(fr_), fq = opaque(fq_); if (dry) return;
        f32x4 bv[2][2]; float rs[2][4];
#pragma unroll
        for (int ai = 0; ai < 2; ++ai)
#pragma unroll
            for (int m = 0; m < 4; ++m) rs[ai][m] = rtab[ui * 256 + ai * 128 + wr * 64 + m * 16 + fr];
#pragma unroll
        for (int bj = 0; bj < 2; ++bj)
#pragma unroll
            for (int n = 0; n < 2; ++n) bv[bj][n] = *(const LAS f32x4*)(btab + ui * 256 + bj * 128 + wc * 32 + 8 * fq + 4 * n);
        const int row0 = u.pm * 256 + wr * 64 + fr, colo = u.pn * 128 + wc * 32 + 8 * fq;
#pragma unroll
        for (int ai = 0; ai < 2; ++ai)
#pragma unroll
            for (int m = 0; m < 4; ++m) {
                const int r = row0 + ai * 128 + m * 16;
                f32x4 hv[2];
#pragma unroll
                for (int n = 0; n < 2; ++n) { const f32x4 a1 = acc[ai][0][m][n] * rs[ai][m] + bv[0][n], a3 = acc[ai][1][m][n] * rs[ai][m] + bv[1][n];
#pragma unroll
                    for (int j = 0; j < 4; ++j) hv[n][j] = siluf(a1[j]) * a3[j]; }
                *(u32x4*)(HID + (size_t)r * FF + colo) = pack8(hv[0], hv[1]);
            }
    }
};
struct EpiConvIn {
    bf16* CU; bf16* CB; const LAS float* rtab; const LAS float* btab;
    __device__ __forceinline__ void operator()(const Acc& acc, const Unit& u, int wr, int wc, int fr_, int fq_, int ui) const {
        const int fr = opaque(fr_), fq = opaque(fq_);
        f32x4 bv[2][2]; float rs[2][4];
#pragma unroll
        for (int ai = 0; ai < 2; ++ai)
#pragma unroll
            for (int m = 0; m < 4; ++m) rs[ai][m] = rtab[ui * 256 + ai * 128 + wr * 64 + m * 16 + fr];
#pragma unroll
        for (int bj = 0; bj < 2; ++bj)
#pragma unroll
            for (int n = 0; n < 2; ++n) bv[bj][n] = *(const LAS f32x4*)(btab + ui * 256 + bj * 128 + wc * 32 + 8 * fq + 4 * n);
        const int row0 = u.pm * 256 + wr * 64 + fr;
#pragma unroll
        for (int ai = 0; ai < 2; ++ai)
#pragma unroll
            for (int m = 0; m < 4; ++m) {
                const int r = row0 + ai * 128 + m * 16; const float rs_ = rs[ai][m];
                if (u.pn < 8) {
                    const f32x4 u0 = (acc[ai][0][m][0] * rs_ + bv[0][0]) * (acc[ai][1][m][0] * rs_ + bv[1][0]), u1 = (acc[ai][0][m][1] * rs_ + bv[0][1]) * (acc[ai][1][m][1] * rs_ + bv[1][1]);
                    *(u32x4*)(CU + (size_t)r * D + u.pn * 128 + wc * 32 + 8 * fq) = pack8(u0, u1);
                } else {
#pragma unroll
                    for (int bj = 0; bj < 2; ++bj) *(u32x4*)(CB + (size_t)r * D + (u.pn - 8) * 256 + bj * 128 + wc * 32 + 8 * fq) = pack8(acc[ai][bj][m][0] * rs_ + bv[bj][0], acc[ai][bj][m][1] * rs_ + bv[bj][1]);
                }
            }
    }
};

#define XB_TMO      128
#define XB_XCNT(j)  (256  + 64 * (j))
#define XB_XSUB(j)  (1280 + 64 * (j))
#define XB_XGEN(j)  (2304 + 64 * (j))
#define XB_TOP      3328
#define XB_TOPGEN   3392
#define XCD_BAR_WORDS 3456
#define XB_SPIN_CAP (1u << 20)
__device__ __forceinline__ unsigned xb_ld(unsigned* p)              { return __hip_atomic_load(p, __ATOMIC_RELAXED, __HIP_MEMORY_SCOPE_AGENT); }
__device__ __forceinline__ unsigned xb_add(unsigned* p, unsigned v) { return __hip_atomic_fetch_add(p, v, __ATOMIC_RELAXED, __HIP_MEMORY_SCOPE_AGENT); }
__device__ __forceinline__ unsigned xb_xcc_id() { return (unsigned)__builtin_amdgcn_s_getreg((3 << 11) | 20) & 0xFu; }
#define XB_SPIN(cond, bar) do { unsigned _sp = 0; while (cond) { __builtin_amdgcn_s_sleep(1); \
    if ((++_sp & 255u) == 0u) { if (xb_ld(&(bar)[XB_TMO])) break; if (_sp > XB_SPIN_CAP) { atomicAdd(&(bar)[XB_TMO], 1u); break; } } } } while (0)
struct XcdBarrier { unsigned* bar; unsigned x; volatile LAS unsigned* st; };
__device__ __forceinline__ XcdBarrier xcd_barrier_post(unsigned* bar, volatile LAS unsigned* st) {
    XcdBarrier b; b.bar = bar; b.x = xb_xcc_id(); b.st = st;
    if (threadIdx.x == 0) (void)xb_add(&bar[XB_XCNT(b.x)], 1u);
    return b;
}
__device__ __forceinline__ void xcd_barrier_complete(unsigned* bar, unsigned x, unsigned& nloc, unsigned& nx) {
    const unsigned G = gridDim.x * gridDim.y * gridDim.z;
    unsigned sum, cnt, mine, sp = 0u;
    for (;;) {
        sum = 0u; cnt = 0u; mine = 0u;
#pragma unroll
        for (unsigned j = 0; j < 16; ++j) { const unsigned c = xb_ld(&bar[XB_XCNT(j)]); sum += c; cnt += (c > 0u) ? 1u : 0u; mine = (j == x) ? c : mine; }
        if (sum == G) break;
        __builtin_amdgcn_s_sleep(1);
        if ((++sp & 255u) == 0u) { if (xb_ld(&bar[XB_TMO])) break; if (sp > XB_SPIN_CAP) { atomicAdd(&bar[XB_TMO], 1u); break; } }
    }
    nloc = mine > 0u ? mine : 1u; nx = cnt > 0u ? cnt : 1u;
}
__device__ __forceinline__ void xcd_barrier(const XcdBarrier& b) {
    asm volatile("s_waitcnt vmcnt(0)" ::: "memory");
    __syncthreads();
    if (threadIdx.x == 0) {
        unsigned* bar = b.bar;
        __builtin_amdgcn_s_waitcnt(0);
        unsigned nloc = b.st[0], nx = b.st[1];
        if (nloc == 0u) { xcd_barrier_complete(bar, b.x, nloc, nx); b.st[0] = nloc; b.st[1] = nx; }
        const unsigned old = xb_add(&bar[XB_XSUB(b.x)], 1u);
        const unsigned gen = old / nloc;
        if (old + 1u == (gen + 1u) * nloc) {
            __builtin_amdgcn_fence(__ATOMIC_RELEASE, "agent");
            asm volatile("s_waitcnt vmcnt(0)" ::: "memory");
            const unsigned og = xb_add(&bar[XB_TOP], 1u);
            const unsigned tg = og / nx;
            if (og + 1u == (tg + 1u) * nx) xb_add(&bar[XB_TOPGEN], 1u);
            else XB_SPIN(xb_ld(&bar[XB_TOPGEN]) == tg, bar);
            __builtin_amdgcn_fence(__ATOMIC_ACQUIRE, "agent");
            xb_add(&bar[XB_XGEN(b.x)], 1u);
            asm volatile("s_waitcnt vmcnt(0)" ::: "memory");
        } else {
            XB_SPIN(xb_ld(&bar[XB_XGEN(b.x)]) == gen, bar);
            __builtin_amdgcn_fence(__ATOMIC_ACQUIRE, "agent");
            asm volatile("s_waitcnt vmcnt(0)" ::: "memory");
        }
    }
    __syncthreads();
}

enum { IN_X = 0, IN_C, IN_CTX, IN_CCTX, IN_ADAW, IN_ADAB, IN_NMIX, IN_NFFN, IN_WQKVG, IN_WO, IN_WCI, IN_CW, IN_WCO, IN_W1, IN_W3, IN_W2, IN_FN, N_IN };
struct Args { const float* in[N_IN]; float* out; unsigned char* ws; int ph_lo, ph_hi; };
constexpr int CW_BAR = 4096;
constexpr int LDS_BYTES = 163840, MISC_OFF = 163712;
constexpr int NPH = 13;
#ifndef P1_RW
#define P1_RW 5
#endif
#define P1_R1 (16384 - 2048 * P1_RW)
#ifndef G1SEL
#define G1SEL 7
#endif
#ifndef PHMASK
#define PHMASK 0xFFFF
#endif

__device__ __forceinline__ void transpose_item(const float* W, int Nsrc, int K, bf16* WT, int k0, int n_src0, int dst_row0, LAS float* scr, int lane) {
#pragma unroll
    for (int i = 0; i < 32; ++i) { const int kk = 2 * i + (lane >> 5); scr[kk * 33 + (lane & 31)] = W[(size_t)(k0 + kk) * Nsrc + n_src0 + (lane & 31)]; }
    LDS_WAIT(); asm volatile("" ::: "memory");
    const int c = lane & 7;
#pragma unroll
    for (int j = 0; j < 4; ++j) { const int n = (lane >> 3) + 8 * j; const LAS float* s = scr + (8 * c) * 33 + n;
        u32x4 o; o.x = pk2(s[0 * 33], s[1 * 33]); o.y = pk2(s[2 * 33], s[3 * 33]); o.z = pk2(s[4 * 33], s[5 * 33]); o.w = pk2(s[6 * 33], s[7 * 33]);
        *(u32x4*)(WT + (size_t)(dst_row0 + n) * K + k0 + 8 * c) = o; }
    LDS_WAIT(); asm volatile("" ::: "memory");
}
__device__ __forceinline__ void transpose_item_scaled(const float* W, int Nsrc, bf16* WT0, bf16* WT1, int k0, int n_src0, int dst_row0, LAS float* scr, const LAS float* tab, float& a0, float& a1, int lane) {
    LAS float* s0 = scr; LAS float* s1 = scr + 64 * 33;
#pragma unroll
    for (int i = 0; i < 32; ++i) { const int kk = 2 * i + (lane >> 5); const float w = W[(size_t)(k0 + kk) * Nsrc + n_src0 + (lane & 31)];
        s0[kk * 33 + (lane & 31)] = w * tab[k0 + kk]; s1[kk * 33 + (lane & 31)] = w * tab[1024 + k0 + kk]; a0 += w * tab[2048 + k0 + kk]; a1 += w * tab[3072 + k0 + kk]; }
    LDS_WAIT(); asm volatile("" ::: "memory");
    const int c = lane & 7;
#pragma unroll
    for (int j = 0; j < 4; ++j) { const int n = (lane >> 3) + 8 * j; const LAS float* p0 = s0 + (8 * c) * 33 + n; const LAS float* p1 = s1 + (8 * c) * 33 + n;
        u32x4 o; o.x = pk2(p0[0 * 33], p0[1 * 33]); o.y = pk2(p0[2 * 33], p0[3 * 33]); o.z = pk2(p0[4 * 33], p0[5 * 33]); o.w = pk2(p0[6 * 33], p0[7 * 33]);
        *(u32x4*)(WT0 + (size_t)(dst_row0 + n) * D + k0 + 8 * c) = o;
        o.x = pk2(p1[0 * 33], p1[1 * 33]); o.y = pk2(p1[2 * 33], p1[3 * 33]); o.z = pk2(p1[4 * 33], p1[5 * 33]); o.w = pk2(p1[6 * 33], p1[7 * 33]);
        *(u32x4*)(WT1 + (size_t)(dst_row0 + n) * D + k0 + 8 * c) = o; }
    LDS_WAIT(); asm volatile("" ::: "memory");
}
template <bool SCALED>
__device__ __forceinline__ void tr64(const float* W, int Nsrc, int K, bf16* WT0, bf16* WT1, int k0, int n_src0, int dst_row0, const LAS float* tab, f32x4& a0, f32x4& a1, int lane) {
    const int n4 = lane & 15, kr = lane >> 4;
    const float* src = W + (size_t)(k0 + 16 * kr) * Nsrc + n_src0 + 4 * n4;
    f32x4 v[16];
#pragma unroll
    for (int i = 0; i < 16; ++i) v[i] = *(const f32x4*)(src + (size_t)i * Nsrc);
    if constexpr (!SCALED) {
#pragma unroll
        for (int j = 0; j < 4; ++j) { bf16* drow = WT0 + (size_t)(dst_row0 + 4 * n4 + j) * K + k0 + 16 * kr;
#pragma unroll
            for (int h = 0; h < 2; ++h) { u32x4 o; o.x = pk2(v[8 * h][j], v[8 * h + 1][j]); o.y = pk2(v[8 * h + 2][j], v[8 * h + 3][j]); o.z = pk2(v[8 * h + 4][j], v[8 * h + 5][j]); o.w = pk2(v[8 * h + 6][j], v[8 * h + 7][j]);
                *(u32x4*)(drow + 8 * h) = o; } }
    } else {
        float s0[16], s1[16];
#pragma unroll
        for (int i = 0; i < 16; ++i) { const int k = k0 + 16 * kr + i; s0[i] = tab[k]; s1[i] = tab[1024 + k]; a0 += v[i] * tab[2048 + k]; a1 += v[i] * tab[3072 + k]; }
#pragma unroll
        for (int j = 0; j < 4; ++j) { bf16* d0 = WT0 + (size_t)(dst_row0 + 4 * n4 + j) * K + k0 + 16 * kr; bf16* d1 = WT1 + (size_t)(dst_row0 + 4 * n4 + j) * K + k0 + 16 * kr;
#pragma unroll
            for (int h = 0; h < 2; ++h) { u32x4 o;
                o.x = pk2(v[8 * h][j] * s0[8 * h], v[8 * h + 1][j] * s0[8 * h + 1]); o.y = pk2(v[8 * h + 2][j] * s0[8 * h + 2], v[8 * h + 3][j] * s0[8 * h + 3]);
                o.z = pk2(v[8 * h + 4][j] * s0[8 * h + 4], v[8 * h + 5][j] * s0[8 * h + 5]); o.w = pk2(v[8 * h + 6][j] * s0[8 * h + 6], v[8 * h + 7][j] * s0[8 * h + 7]);
                *(u32x4*)(d0 + 8 * h) = o;
                o.x = pk2(v[8 * h][j] * s1[8 * h], v[8 * h + 1][j] * s1[8 * h + 1]); o.y = pk2(v[8 * h + 2][j] * s1[8 * h + 2], v[8 * h + 3][j] * s1[8 * h + 3]);
                o.z = pk2(v[8 * h + 4][j] * s1[8 * h + 4], v[8 * h + 5][j] * s1[8 * h + 5]); o.w = pk2(v[8 * h + 6][j] * s1[8 * h + 6], v[8 * h + 7][j] * s1[8 * h + 7]);
                *(u32x4*)(d1 + 8 * h) = o; } }
    }
}
__device__ __forceinline__ int map_qkvg(int np) {
    if (np < 2048) { const int qk = np >> 10, h = (np >> 8) & 3, cp = np & 255; const int d = 128 * ((cp >> 6) & 1) + 64 * (cp >> 7) + (cp & 63); return qk * 1024 + h * 256 + d; }
    if (np < 4096) return 4096 + (np - 2048);
    return 2048 + (np - 4096);
}
__device__ __forceinline__ int map_wci(int np) { const int tile = np >> 8, cp = np & 255; if (tile < 8) return (cp < 128) ? (1024 + 128 * tile + cp) : (2048 + 128 * tile + cp - 128); return 256 * (tile - 8) + cp; }
__device__ __forceinline__ void unpack8(const u32x4 w, float (&f)[8]) { f[0] = bflo(w.x); f[1] = bfhi(w.x); f[2] = bflo(w.y); f[3] = bfhi(w.y); f[4] = bflo(w.z); f[5] = bfhi(w.z); f[6] = bflo(w.w); f[7] = bfhi(w.w); }

template <int RB>
__device__ __forceinline__ void modrows(const float* xrow0, const float* gain, const float* scale, bf16* orow0, float* rstd0, int lane) {
    f32x4 v[RB][4]; float ss[RB];
#pragma unroll
    for (int r = 0; r < RB; ++r)
#pragma unroll
        for (int j = 0; j < 4; ++j) v[r][j] = ((const f32x4*)(xrow0 + (size_t)r * D) + lane)[64 * j];
    f32x4 w[4];
#pragma unroll
    for (int j = 0; j < 4; ++j) w[j] = ((const f32x4*)gain + lane)[64 * j] * (((const f32x4*)scale + lane)[64 * j] + 1.0f);
#pragma unroll
    for (int r = 0; r < RB; ++r) { float s_ = 0.f;
#pragma unroll
        for (int j = 0; j < 4; ++j) s_ += (v[r][j][0] * v[r][j][0] + v[r][j][1] * v[r][j][1]) + (v[r][j][2] * v[r][j][2] + v[r][j][3] * v[r][j][3]);
        ss[r] = wave_sum(s_); }
#pragma unroll
    for (int r = 0; r < RB; ++r) { if (lane == 0) rstd0[r] = 1.0f / sqrtf(ss[r] * (1.0f / D) + EPS);
        unsigned long long* o8 = (unsigned long long*)(orow0 + (size_t)r * D) + lane;
#pragma unroll
        for (int j = 0; j < 4; ++j) { const f32x4 o = v[r][j] * w[j]; o8[64 * j] = (unsigned long long)pk2(o[0], o[1]) | ((unsigned long long)pk2(o[2], o[3]) << 32); } }
}
template <int RB>
__device__ __forceinline__ void biasrows(const bf16* wrow0, const float* sh, int q_lo, int q_hi, float* out0, int lane) {
    u32x4 wv[RB][2];
#pragma unroll
    for (int r = 0; r < RB; ++r)
#pragma unroll
        for (int j = 0; j < 2; ++j) wv[r][j] = *(const u32x4*)(wrow0 + (size_t)r * D + j * 512 + lane * 8);
#pragma unroll
    for (int q = 0; q < 3; ++q) if (q >= q_lo && q < q_hi) {
        float a[RB];
#pragma unroll
        for (int r = 0; r < RB; ++r) a[r] = 0.f;
#pragma unroll
        for (int j = 0; j < 2; ++j) { const float* s_ = sh + q * NQ + j * 512 + lane * 8; const f32x4 s0 = *(const f32x4*)s_, s1 = *(const f32x4*)(s_ + 4);
#pragma unroll
            for (int r = 0; r < RB; ++r) { float wf[8]; unpack8(wv[r][j], wf);
                a[r] += (wf[0] * s0[0] + wf[1] * s0[1]) + (wf[2] * s0[2] + wf[3] * s0[3]) + (wf[4] * s1[0] + wf[5] * s1[1]) + (wf[6] * s1[2] + wf[7] * s1[3]); } }
#pragma unroll
        for (int r = 0; r < RB; ++r) { const float t = wave_sum(a[r]); if (lane == 0) out0[q * NQ + r] = t; }
    }
}

#define BUILD_TABS(S_, RS_, BS_) do { LAS float* rt_ = (LAS float*)(lds + RSTD_LDS); LAS float* bt_ = (LAS float*)(lds + BIAS_LDS); pg8::Unit u_; \
        for (int i_ = (tid >> 8); S_.next(i_, u_); i_ += 2) { const int t_ = tid & 255; rt_[i_ * 256 + t_] = RS_(u_.pm * 256 + t_); bt_[i_ * 256 + t_] = BS_(u_, t_); } \
        __syncthreads(); } while (0)
__device__ __forceinline__ float bias_sum(const float* slab, int ncol, int col) { float t = slab[col];
#pragma unroll
    for (int q = 1; q < NKQ; ++q) t += slab[q * ncol + col];
    return t; }
#define RS_SSQ(r) rstd_from_ssq(SSQ, (r))
#define RS_X(r) RSTDX[(r)]

#define WPREP_JOBS(job_lo, job_hi, gwq, ngwq) do { LAS float* tab = (LAS float*)lds; \
                for (int job = (job_lo); job < (job_hi); ++job) { \
                    const int jl = (job == 0) ? 0 : 1; const bool isci = (job == 1); \
                    const float* gain_ = (isci ? args.in[IN_NMIX] : args.in[IN_NFFN]) + jl * D; const float* ad = ADA + jl * 3 * NQ + (isci ? 0 : 3 * D); \
                    __syncthreads(); \
                    for (int i = tid; i < 2 * D; i += NTHR) { const int b_ = i >> 10, k = i & (D - 1); tab[i] = gain_[k] * (1.0f + ad[b_ * NQ + D + k]); tab[2 * D + i] = ad[b_ * NQ + k]; } \
                    __syncthreads(); \
                    const int nnb = isci ? 48 : 88, ncol = isci ? 3072 : 5632; \
                    float* bslab = isci ? BIAS5 : BIAS3 + jl * 2 * NKQ * 5632; \
                    for (int it = (gwq); it < nnb * NKQ; it += (ngwq)) { const int nb = it / NKQ, kq = it % NKQ, np = nb * 64; f32x4 a0 = {0.f, 0.f, 0.f, 0.f}, a1 = a0; \
                        for (int kb = kq * (16 / NKQ); kb < (kq + 1) * (16 / NKQ); ++kb) { \
                            if (isci) tr64<true>(args.in[IN_WCI], 3072, D, WCI, WCI + (size_t)3072 * D, kb * 64, map_wci(np), np, tab, a0, a1, lane); \
                            else { const int tile = np >> 8, cp = np & 255; const float* src = (cp < 128 ? args.in[IN_W1] : args.in[IN_W3]) + (size_t)jl * D * FF; \
                                tr64<true>(src, FF, D, W13[jl], W13[jl] + (size_t)5632 * D, kb * 64, 128 * tile + (cp & 127), np, tab, a0, a1, lane); } } \
                        _Pragma("unroll") for (int e = 0; e < 4; ++e) { a0[e] += __shfl_xor(a0[e], 16); a0[e] += __shfl_xor(a0[e], 32); a1[e] += __shfl_xor(a1[e], 16); a1[e] += __shfl_xor(a1[e], 32); } \
                        if (lane < 16) { *(f32x4*)(bslab + (0 * NKQ + kq) * ncol + np + 4 * lane) = a0; *(f32x4*)(bslab + (1 * NKQ + kq) * ncol + np + 4 * lane) = a1; } \
                    } } \
                __syncthreads(); } while (0)

__global__ void __launch_bounds__(NTHR, 2) fwd_kernel(Args args) {
    extern __shared__ __attribute__((aligned(16))) unsigned char lds_raw[];
    LAS unsigned char* lds = (LAS unsigned char*)lds_raw;
    volatile LAS unsigned* MISC = (volatile LAS unsigned*)(lds + MISC_OFF);
    const int tid0 = threadIdx.x, wave = __builtin_amdgcn_readfirstlane(tid0 >> 6);
    const int G = gridDim.x, bx = blockIdx.x;
    const int vcu = (G % 8 == 0) ? (bx % 8) * (G / 8) + bx / 8 : bx;
    const int gw = vcu * NWAVES + wave, NGW = G * NWAVES;
    unsigned char* ws = args.ws;
    unsigned* ctl = (unsigned*)(ws + WS_CTL);
    float* ADA = (float*)(ws + CTL_ADA);
    float* ROPE = (float*)(ws + MS_ROPE); float* RSTDX = (float*)(ws + MS_RSTDX); float* RSTDC = (float*)(ws + MS_RSTDC);
    float* BIAS1 = (float*)(ws + MS_BIAS1); float* BIAS3 = (float*)(ws + MS_BIAS3); float* BIAS5 = (float*)(ws + MS_BIAS5);
    float* SSQ = (float*)(ws + WS_SSQ);
    bf16* WQKVG = (bf16*)(ws + WS_WQKVG); bf16* WO = (bf16*)(ws + WS_WO); bf16* WCI = (bf16*)(ws + WS_WCI); bf16* WCO = (bf16*)(ws + WS_WCO);
    bf16* W13[2] = {(bf16*)(ws + WS_W13_0), (bf16*)(ws + WS_W13_1)};
    bf16* XB = (bf16*)(ws + WS_XB); bf16* QB = (bf16*)(ws + WS_Q); bf16* KB = (bf16*)(ws + WS_K); bf16* VT = (bf16*)(ws + WS_VT);
    bf16* SFB = (bf16*)(ws + WS_SF); bf16* SBB = (bf16*)(ws + WS_SB); bf16* KC = (bf16*)(ws + WS_KC); bf16* VCT = (bf16*)(ws + WS_VCT); bf16* ACB = (bf16*)(ws + WS_ACB);
    bf16* HID = (bf16*)(ws + WS_HID); bf16* CU = (bf16*)(ws + WS_CU); bf16* CB = (bf16*)(ws + WS_CB); bf16* ACV = (bf16*)(ws + WS_ACV);
    bf16* GB = (bf16*)args.out;
    const float* x = args.in[IN_X];

    for (int u = tid0; u < (LDS_BYTES - 131072) / 4; u += NTHR) ((LAS unsigned*)(lds + 131072))[u] = 0u;
    __syncthreads();
    const bool multi = (args.ph_hi - args.ph_lo) > 1;
    XcdBarrier bar; bar.bar = ctl + CW_BAR; bar.x = 0; bar.st = nullptr;
    if (multi) bar = xcd_barrier_post(ctl + CW_BAR, MISC + 8);

#ifndef PROBE_DUP
#define PROBE_DUP -1
#endif
#ifndef SSVAR
#define SSVAR 0
#endif
    for (int ph0 = args.ph_lo; ph0 < args.ph_hi; ) {
        const int ph = ph0++; constexpr int rep = 0;
        const int tid = opaque((int)threadIdx.x), lane = tid & 63;
        switch (ph) {
        case 0: if (PHMASK & (1<<0)) {
            { LAS float* sl = (LAS float*)(lds + 131072); LAS f32x4* red = (LAS f32x4*)lds;
              for (int i = tid; i < 3 * D; i += NTHR) { const int r = i >> 10, k = i & (D - 1); sl[i] = siluf(r < 2 ? args.in[IN_C][r * D + k] : args.in[IN_CCTX][k]); }
              __syncthreads();
              for (int it = bx; it < 256; it += G) {
                  const int l = it >> 7, c0 = (it & 127) * 48, cg = tid % 12, kg = tid / 12;
                  if (tid < 504) {
                      const float* W = args.in[IN_ADAW] + (size_t)l * D * NQ + c0 + 4 * cg;
                      f32x4 a0 = {0.f, 0.f, 0.f, 0.f}, a1 = a0, a2 = a0;
#pragma unroll 5
                      for (int k = kg; k < D; k += 42) { const f32x4 w = *(const f32x4*)(W + (size_t)k * NQ); a0 += w * sl[k]; a1 += w * sl[D + k]; a2 += w * sl[2 * D + k]; }
                      red[(kg * 12 + cg) * 3 + 0] = a0; red[(kg * 12 + cg) * 3 + 1] = a1; red[(kg * 12 + cg) * 3 + 2] = a2;
                  }
                  __syncthreads();
                  if (tid < 36) { const int cg2 = tid / 3, r = tid % 3; f32x4 t = *(const f32x4*)(args.in[IN_ADAB] + l * NQ + c0 + 4 * cg2);
                      for (int q = 0; q < 42; ++q) t += red[(q * 12 + cg2) * 3 + r];
                      *(f32x4*)(ADA + (l * 3 + r) * NQ + c0 + 4 * cg2) = t; }
                  __syncthreads();
              }
            }
            { constexpr int I_QKVG = 16 * 96, I_WO = 32 * 16, I_W2 = 44 * 16, I_WCO = 16 * 16;
              constexpr int NIT = I_QKVG + I_WO + 2 * I_W2 + I_WCO;
              f32x4 d0, d1;
              for (int it = gw; it < NIT; it += NGW) {
                  int r = it;
                  if (r < I_QKVG) { const int kb = r / 96, nb = r % 96; tr64<false>(args.in[IN_WQKVG], NQ, D, WQKVG, nullptr, kb * 64, map_qkvg(nb * 64), nb * 64, nullptr, d0, d1, lane); continue; } r -= I_QKVG;
                  if (r < I_WO) { const int kb = r / 16, nb = r % 16; tr64<false>(args.in[IN_WO], D, 2048, WO, nullptr, kb * 64, nb * 64, nb * 64, nullptr, d0, d1, lane); continue; } r -= I_WO;
                  if (r < 2 * I_W2) { const int l = r / I_W2; r %= I_W2; const int kb = r / 16, nb = r % 16;
                      tr64<false>(args.in[IN_W2] + (size_t)l * FF * D, D, FF, (bf16*)(ws + (l ? WS_W2_1 : WS_W2_0)), nullptr, kb * 64, nb * 64, nb * 64, nullptr, d0, d1, lane); continue; } r -= 2 * I_W2;
                  { const int kb = r / 16, nb = r % 16; tr64<false>(args.in[IN_WCO], D, D, WCO, nullptr, kb * 64, nb * 64, nb * 64, nullptr, d0, d1, lane); }
              }
            }
        } break;
        case 1: if (PHMASK & (1<<1)) {
            const float* gain = args.in[IN_NMIX];
            const bool hasctx = vcu < 192;
            const bool isv = vcu >= 64; const int tl = isv ? vcu - 64 : vcu, rb = tl & 7, cbk = tl >> 3, row0 = 64 * rb, col0 = 128 * cbk;
            const int wt0 = (isv ? 4096 : 1024) + col0;
            if (hasctx) {
                LAS float* wt_ = (LAS float*)lds; LAS float* sh_ = wt_ + D; LAS float* rs_ = (LAS float*)(lds + 8192); LAS float* bs_ = rs_ + 64;
                LAS unsigned char* abuf = lds + 16384; LAS unsigned char* bbuf = lds + 16384 + 2 * 9216;
                for (int k = tid; k < D; k += NTHR) { wt_[k] = gain[k] * (1.0f + ADA[2 * NQ + D + k]); sh_[k] = ADA[2 * NQ + k]; }
                __syncthreads();
                const int arow = tid >> 3, aseg = tid & 7, brow = tid >> 2, bseg = tid & 3;
                const float* ap = args.in[IN_CTX] + (size_t)(row0 + arow) * D + 8 * aseg; const bf16* bp = WQKVG + (size_t)(wt0 + brow) * D + 16 * bseg;
                const int w4 = wave & 3, wr2 = wave >> 2, fr = lane & 15, fq = lane >> 4;
                const unsigned awr = (unsigned)(arow * 144 + aseg * 16), bwr = (unsigned)(brow * 144 + bseg * 32);
                const unsigned ard = (unsigned)((32 * wr2 + fr) * 144 + fq * 16), brd = (unsigned)((32 * w4 + fr) * 144 + fq * 16);
                f32x4 a_r[2][2]; u32x4 b_r[2][2]; float ssq = 0.f, bsum = 0.f;
                f32x4 acc[2][2];
#pragma unroll
                for (int m = 0; m < 2; ++m)
#pragma unroll
                    for (int n = 0; n < 2; ++n) acc[m][n] = (f32x4){0.f, 0.f, 0.f, 0.f};
#pragma unroll
                for (int c = 0; c < 2; ++c) { a_r[c][0] = *(const f32x4*)(ap + 64 * c); a_r[c][1] = *(const f32x4*)(ap + 64 * c + 4); b_r[c][0] = *(const u32x4*)(bp + 64 * c); b_r[c][1] = *(const u32x4*)(bp + 64 * c + 8); }
#pragma unroll 1
                for (int c2 = 0; c2 < 16; c2 += 2)
#pragma unroll
                for (int cur = 0; cur < 2; ++cur) { const int c = c2 + cur;
                    { const int k0 = 64 * c + 8 * aseg; const f32x4 w0 = *(const LAS f32x4*)(wt_ + k0), w1 = *(const LAS f32x4*)(wt_ + k0 + 4); const f32x4 x0 = a_r[cur][0], x1 = a_r[cur][1];
                      ssq += (x0[0] * x0[0] + x0[1] * x0[1]) + (x0[2] * x0[2] + x0[3] * x0[3]) + (x1[0] * x1[0] + x1[1] * x1[1]) + (x1[2] * x1[2] + x1[3] * x1[3]);
                      *(LAS u32x4*)(abuf + cur * 9216 + awr) = pack8(x0 * w0, x1 * w1); }
                    { const int kb = 64 * c + 16 * bseg;
#pragma unroll
                      for (int h = 0; h < 2; ++h) { float f[8]; unpack8(b_r[cur][h], f); const f32x4 s0 = *(const LAS f32x4*)(sh_ + kb + 8 * h), s1 = *(const LAS f32x4*)(sh_ + kb + 8 * h + 4);
                          bsum += (f[0] * s0[0] + f[1] * s0[1]) + (f[2] * s0[2] + f[3] * s0[3]) + (f[4] * s1[0] + f[5] * s1[1]) + (f[6] * s1[2] + f[7] * s1[3]);
                          *(LAS u32x4*)(bbuf + cur * 18432 + bwr + 16 * h) = b_r[cur][h]; } }
                    if (c + 2 < 16) { a_r[cur][0] = *(const f32x4*)(ap + 64 * (c + 2)); a_r[cur][1] = *(const f32x4*)(ap + 64 * (c + 2) + 4); b_r[cur][0] = *(const u32x4*)(bp + 64 * (c + 2)); b_r[cur][1] = *(const u32x4*)(bp + 64 * (c + 2) + 8); }
                    __syncthreads();
#pragma unroll
                    for (int ks = 0; ks < 2; ++ks) { bf16x8 af[2], bfg[2];
#pragma unroll
                        for (int m = 0; m < 2; ++m) af[m] = *(const LAS bf16x8*)(abuf + cur * 9216 + ard + m * (16 * 144) + ks * 64);
#pragma unroll
                        for (int n = 0; n < 2; ++n) bfg[n] = *(const LAS bf16x8*)(bbuf + cur * 18432 + brd + n * (16 * 144) + ks * 64);
#pragma unroll
                        for (int m = 0; m < 2; ++m)
#pragma unroll
                            for (int n = 0; n < 2; ++n) acc[m][n] = isv ? __builtin_amdgcn_mfma_f32_16x16x32_bf16(af[m], bfg[n], acc[m][n], 0, 0, 0) : __builtin_amdgcn_mfma_f32_16x16x32_bf16(bfg[n], af[m], acc[m][n], 0, 0, 0); }
                }
                { float t = ssq; t += __shfl_xor(t, 1); t += __shfl_xor(t, 2); t += __shfl_xor(t, 4); if (aseg == 0) rs_[arow] = 1.0f / sqrtf(t * (1.0f / D) + EPS);
                  float u_ = bsum; u_ += __shfl_xor(u_, 1); u_ += __shfl_xor(u_, 2); if (bseg == 0) bs_[brow] = u_; }
                __syncthreads();
                const int b = rb >> 2;
                if (!isv) {
#pragma unroll
                    for (int m = 0; m < 2; ++m) { const int rl = 32 * wr2 + 16 * m + fr; const float rsd = rs_[rl];
#pragma unroll
                        for (int n = 0; n < 2; ++n) { const int cl = 32 * w4 + 16 * n + 4 * fq; const f32x4 bb = *(const LAS f32x4*)(bs_ + cl);
                            const f32x4 o = (acc[m][n] * rsd + bb) * 0.0625f;
                            u32x2 w; w.x = pk2(o[0], o[1]); w.y = pk2(o[2], o[3]); *(u32x2*)(KC + (size_t)(row0 + rl) * D + col0 + cl) = w; } }
                } else {
#pragma unroll
                    for (int m = 0; m < 2; ++m) { const int tl0 = 32 * wr2 + 16 * m + 4 * fq; const f32x4 rs = *(const LAS f32x4*)(rs_ + tl0);
#pragma unroll
                        for (int n = 0; n < 2; ++n) { const int cl = 32 * w4 + 16 * n + fr, c = col0 + cl, h = c >> 9, e = c & 511; const f32x4 o = acc[m][n] * rs + bs_[cl];
                            u32x2 w; w.x = pk2(o[0], o[1]); w.y = pk2(o[2], o[3]); *(u32x2*)(VCT + (size_t)((b * NH + h) * DV + e) * CTXL + ((row0 + tl0) & (CTXL - 1))) = w; } }
                }
                biasrows<4>(WQKVG + (size_t)(4 * (vcu * 8 + wave)) * D, ADA, 0, 2, BIAS1 + 4 * (vcu * 8 + wave), lane);
            } else {
                const int wk = (vcu - 192) * 8 + wave, NWK = (G - 192) * 8;
                for (int r = 4 * wk; r < P1_R1; r += 4 * NWK) modrows<4>(x + (size_t)r * D, gain, ADA + (r >> 13) * NQ + D, XB + (size_t)r * D, RSTDX + r, lane);
            }
            { const int r = P1_R1 + 4 * (vcu * 8 + wave); modrows<4>(x + (size_t)r * D, gain, ADA + (r >> 13) * NQ + D, XB + (size_t)r * D, RSTDX + r, lane); }
            if constexpr (P1_RW > 4) { const int r = P1_R1 + 8192 + (P1_RW - 4) * (vcu * 8 + wave); modrows<P1_RW - 4>(x + (size_t)r * D, gain, ADA + (r >> 13) * NQ + D, XB + (size_t)r * D, RSTDX + r, lane); }
        } break;
        case 2: if (PHMASK & (1<<2)) {
            if (G1SEL & 1) { pg8::Gemm g{XB, WQKVG, M, 4096, D, 0}; pg8::StaticOrder S; S.init(M, 4096, G, bx);
              EpiQKG E{QB, KB, GB, RSTDX, BIAS1};
              pg8::gemm_phase<EpiQKG, pg8::StaticOrder, true, true, false>(lds, g, S, E, tid); }
            { pg8::Gemm g{XB, WQKVG + (size_t)4096 * D, M, 2048, D, 0}; pg8::StaticOrder S; S.init(M, 2048, G, bx);
              EpiVT E{VT, RSTDX, BIAS1 + 4096, SEQ, 32, -1};
              pg8::gemm_phase<EpiVT, pg8::StaticOrder, true, true, true>(lds, g, S, E, tid); }
        } break;
        case 3: if (PHMASK & (1<<3)) {
            constexpr int KP = 136, BUFB = (64 + 128) * KP * 2;
            for (int u = bx; u < 256; u += G) {
                const int dir = u & 1, bh = (u >> 1) & 7, dkt = (u >> 4) & 3, dvt = u >> 6, b = bh >> 2, h = bh & 3, dk0 = 64 * dkt, dv0 = 128 * dvt;
                const float lg = __builtin_amdgcn_logf(1.0f - __builtin_amdgcn_exp2f(-(dir ? 5.5f : 5.0f) - (float)h)), g128 = __builtin_amdgcn_exp2f(128.0f * lg);
                __syncthreads();
                if (wave >= 4) {
                    const int pt = tid - 256;
                    float wK[4];
#pragma unroll
                    for (int p = 0; p < 4; ++p) { const int t = 32 * p + (pt >> 3); wK[p] = __builtin_amdgcn_exp2f((float)(dir ? t : 127 - t) * lg); }
                    u32x4 kr0[4], vr0[8], kr1[4], vr1[8], kr2[4], vr2[8];
#define SSP_LOAD(step, kr, vr) do { const int s_ = (step); const bool ic_ = s_ < 2; const int c_ = ic_ ? (dir ? 1 - s_ : s_) : (dir ? 65 - s_ : s_ - 2); const int t_ = opaque(pt); \
                        const bf16* ks_ = (ic_ ? KC + (size_t)(b * CTXL + c_ * 128) * D : KB + (size_t)(b * SEQ + c_ * 128) * D) + h * DK + dk0; \
                        const int ld_ = ic_ ? CTXL : 128; const bf16* vs_ = ic_ ? VCT + (size_t)(bh * DV + dv0) * CTXL + c_ * 128 : VT + ((size_t)((bh * 64 + c_) * DV + dv0)) * 128; \
                        _Pragma("unroll") for (int p = 0; p < 4; ++p) kr[p] = *(const u32x4*)(ks_ + (unsigned)((32 * p + (t_ >> 3)) * D + 8 * (t_ & 7))); \
                        _Pragma("unroll") for (int q = 0; q < 8; ++q) vr[q] = *(const u32x4*)(vs_ + (unsigned)(((t_ >> 4) + 16 * q) * ld_ + 8 * (t_ & 15))); } while (0)
#define SSP_WRITE(bufi, kr, vr) do { LAS bf16* kt_ = (LAS bf16*)(lds + (bufi) * BUFB); LAS bf16* vt_ = kt_ + 64 * KP; const int t_ = opaque(pt); \
                        _Pragma("unroll") for (int p = 0; p < 4; ++p) { float f_[8]; unpack8(kr[p], f_); const int c8_ = t_ & 7, tt_ = 32 * p + (t_ >> 3), pos_ = (((tt_ >> 3) ^ c8_) << 3) | (tt_ & 7); \
                            _Pragma("unroll") for (int e = 0; e < 8; ++e) kt_[(8 * c8_ + e) * KP + pos_] = (bf16)f2bf(f_[e] * wK[p]); } \
                        _Pragma("unroll") for (int q = 0; q < 8; ++q) *(LAS u32x4*)(vt_ + ((t_ >> 4) + 16 * q) * KP + 8 * (t_ & 15)) = vr[q]; } while (0)
#define SSP_STEP(s, krN, vrN, krF, vrF) do { const int s__ = (s); if (s__ < 62) { if (s__ + 3 <= 61) SSP_LOAD(s__ + 3, krF, vrF); if (s__ + 1 <= 61) SSP_WRITE((s__ + 1) & 1, krN, vrN); __syncthreads(); } } while (0)
                    SSP_LOAD(0, kr0, vr0); SSP_LOAD(1, kr1, vr1); SSP_LOAD(2, kr2, vr2); SSP_WRITE(0, kr0, vr0); __syncthreads();
                    for (int s3 = 0; s3 < 63; s3 += 3) { SSP_STEP(s3, kr1, vr1, kr0, vr0); SSP_STEP(s3 + 1, kr2, vr2, kr1, vr1); SSP_STEP(s3 + 2, kr0, vr0, kr2, vr2); }
#undef SSP_LOAD
#undef SSP_WRITE
#undef SSP_STEP
                } else {
                    const int wr = wave >> 1, wc = wave & 1, fr = lane & 15, fq = lane >> 4;
                    f32x4 acc[2][4];
#pragma unroll
                    for (int i = 0; i < 2; ++i)
#pragma unroll
                        for (int j = 0; j < 4; ++j) acc[i][j] = (f32x4){0.f, 0.f, 0.f, 0.f};
                    __syncthreads();
                    for (int s = 0; s <= 62; ++s) {
                        const bool isctx = s < 2; const int c = isctx ? (dir ? 1 - s : s) : (dir ? 65 - s : s - 2);
                        if (!isctx && (dir ? ((c & 3) == 3) : ((c & 3) == 0))) {
                            bf16* dst = (dir ? SBB : SFB) + ((size_t)((bh * NSC + (c >> 2)) * DV + dv0 + 64 * wc + fr)) * DK + dk0 + 32 * wr + 4 * fq;
#pragma unroll
                            for (int i = 0; i < 2; ++i)
#pragma unroll
                                for (int j = 0; j < 4; ++j) { u32x2 w; w.x = pk2(acc[i][j][0], acc[i][j][1]); w.y = pk2(acc[i][j][2], acc[i][j][3]); *(u32x2*)(dst + (size_t)(16 * j) * DK + 16 * i) = w; }
                        }
                        if (s == 62) break;
#pragma unroll
                        for (int i = 0; i < 2; ++i)
#pragma unroll
                            for (int j = 0; j < 4; ++j) acc[i][j] *= g128;
                        { const LAS bf16* kt = (const LAS bf16*)(lds + (s & 1) * BUFB); const LAS bf16* vt = kt + 64 * KP;
#pragma unroll
                          for (int ks = 0; ks < 4; ++ks) { bf16x8 X[2], Y[4];
#pragma unroll
                              for (int i = 0; i < 2; ++i) X[i] = *(const LAS bf16x8*)(kt + (32 * wr + 16 * i + fr) * KP + (((4 * ks + fq) ^ (4 * wr + 2 * i + (fr >> 3))) & 7) * 8 + 64 * (ks >> 1));
#pragma unroll
                              for (int j = 0; j < 4; ++j) Y[j] = *(const LAS bf16x8*)(vt + (64 * wc + 16 * j + fr) * KP + 32 * ks + 8 * fq);
#pragma unroll
                              for (int i = 0; i < 2; ++i)
#pragma unroll
                                  for (int j = 0; j < 4; ++j) acc[i][j] = __builtin_amdgcn_mfma_f32_16x16x32_bf16(X[i], Y[j], acc[i][j], 0, 0, 0); } }
                        __syncthreads();
                    }
                }
            }
        } break;
        case 4: if (PHMASK & (1<<4)) {
            constexpr int SLOT = 40960, PBUF = 3 * SLOT, REDB = PBUF + 32768;
            static_assert(REDB + 2048 <= MISC_OFF, "B' LDS map");
            const int wr = wave >> 2, wc = wave & 3;
#define BP_WAITV(n) do { switch (n) { case 0: asm volatile("s_waitcnt vmcnt(0)" ::: "memory"); break; case 4: asm volatile("s_waitcnt vmcnt(4)" ::: "memory"); break; \
                    case 5: asm volatile("s_waitcnt vmcnt(5)" ::: "memory"); break; default: asm volatile("s_waitcnt vmcnt(0)" ::: "memory"); break; } } while (0)
#define BP_GLDS(srcp, dstoff) __builtin_amdgcn_global_load_lds((const unsigned*)(srcp), (LAS unsigned*)(lds + (dstoff)), 16, 0, 0)
            for (int unit = vcu; unit < 512; unit += G) {
                const int bh = unit >> 6, c = unit & 63, b = bh >> 2, h = bh & 3, sc = c >> 2, cq = c & 3;
                const float lgf = __builtin_amdgcn_logf(1.0f - __builtin_amdgcn_exp2f(-5.0f - (float)h)), lgb = __builtin_amdgcn_logf(1.0f - __builtin_amdgcn_exp2f(-5.5f - (float)h));
                const bf16* Qsrc = QB + (size_t)(b * SEQ + c * 128) * D + h * DK;
                const bf16* Ksrc = KB + (size_t)(b * SEQ + sc * SC) * D + h * DK;
                const bf16* SFsrc = SFB + (size_t)((bh * NSC + sc) * DV) * DK; const bf16* SBsrc = SBB + (size_t)((bh * NSC + sc) * DV) * DK;
                const bf16* Vsrc = VT + (size_t)((bh * 64 + sc * 4) * DV) * 128;
                f32x4 acc[4][8], sacc[4][2];
#pragma unroll
                for (int m = 0; m < 4; ++m)
#pragma unroll
                    for (int n = 0; n < 8; ++n) acc[m][n] = (f32x4){0.f, 0.f, 0.f, 0.f};
#define BP_ISSUE(idx) do { const int i_ = (idx); const int so_ = (i_ % 3) * SLOT; const int l_ = opaque(lane); \
                    if (i_ < 16) { const int s_ = i_ & 7; const bf16* bs_ = (i_ < 8 ? SFsrc : SBsrc) + 32 * s_; const int rr_ = l_ >> 2, ch_ = (l_ & 3) ^ ((l_ >> 4) & 3); \
                        BP_GLDS(Qsrc + (unsigned)((16 * wave + rr_) * D + 32 * s_ + 8 * ch_), so_ + wave * 1024); \
                        _Pragma("unroll") for (int q = 0; q < 4; ++q) BP_GLDS(bs_ + (unsigned)((16 * (wave + 8 * q) + rr_) * DK + 8 * ch_), so_ + 8192 + (wave + 8 * q) * 1024); } \
                    else { const int j_ = (i_ - 16) >> 3, r8_ = (i_ - 16) & 7; \
                        if (r8_ < 4) { const int rr_ = l_ >> 3, ch_ = (l_ & 7) ^ ((l_ >> 4) & 3) ^ (4 * (wave & 1)); \
                            _Pragma("unroll") for (int q = 0; q < 2; ++q) { const int row_ = 8 * (wave + 8 * q) + rr_; \
                                BP_GLDS(Qsrc + (unsigned)(row_ * D + 64 * r8_ + 8 * ch_), so_ + (wave + 8 * q) * 1024); \
                                BP_GLDS(Ksrc + (unsigned)((128 * j_ + row_) * D + 64 * r8_ + 8 * ch_), so_ + 16384 + (wave + 8 * q) * 1024); } } \
                        else { const int rr_ = l_ >> 2, ch_ = (l_ & 3) ^ ((l_ >> 4) & 3); const bf16* bs_ = Vsrc + (size_t)j_ * (DV * 128) + 32 * (r8_ - 4); \
                            _Pragma("unroll") for (int q = 0; q < 4; ++q) BP_GLDS(bs_ + (unsigned)((16 * (wave + 8 * q) + rr_) * 128 + 8 * ch_), so_ + 8192 + (wave + 8 * q) * 1024); } } } while (0)
#define BP_NLOADS(idx) (((idx) >= 48) ? 0 : ((idx) < 16 ? 5 : 4))
#define BP_TOP(idx) do { BP_WAITV(BP_NLOADS((idx) + 1)); asm volatile("s_waitcnt lgkmcnt(0)" ::: "memory"); __builtin_amdgcn_s_barrier(); asm volatile("" ::: "memory"); \
                    if ((idx) + 2 < 48) BP_ISSUE((idx) + 2); } while (0)
#define BP_MMA_FULL(AADDR, so) do { bf16x8 af_[4]; const int l_ = opaque(lane), fr = l_ & 15, fq = l_ >> 4; \
                    _Pragma("unroll") for (int m = 0; m < 4; ++m) af_[m] = *(const LAS bf16x8*)(lds + AADDR(64 * wr + 16 * m + fr, fr, fq)); \
                    _Pragma("unroll") for (int nh = 0; nh < 4; ++nh) { bf16x8 bf_[2]; \
                        _Pragma("unroll") for (int n = 0; n < 2; ++n) bf_[n] = *(const LAS bf16x8*)(lds + (so) + 8192 + (128 * wc + 32 * nh + 16 * n + fr) * 64 + ((fq ^ (fr >> 2)) & 3) * 16); \
                        _Pragma("unroll") for (int m = 0; m < 4; ++m) _Pragma("unroll") for (int n = 0; n < 2; ++n) \
                            acc[m][2 * nh + n] = __builtin_amdgcn_mfma_f32_16x16x32_bf16(bf_[n], af_[m], acc[m][2 * nh + n], 0, 0, 0); } } while (0)
                __builtin_amdgcn_s_barrier();
                BP_ISSUE(0); BP_ISSUE(1);
                for (int idx = 0; idx < 16; ++idx) {
                    BP_TOP(idx);
                    const int so = (idx % 3) * SLOT;
#define AADDR_X(row, fr, fq) (so + (row) * 64 + (((fq) ^ ((fr) >> 2)) & 3) * 16)
                    BP_MMA_FULL(AADDR_X, so);
#undef AADDR_X
                    if (idx == 7 || idx == 15) { const int fr = opaque(lane) & 15;
#pragma unroll
                        for (int m = 0; m < 4; ++m) { const int il = 128 * cq + 64 * wr + 16 * m + fr;
                            const float sc_ = (idx == 7) ? __builtin_amdgcn_exp2f((float)(il + 1) * lgf - (float)(SC - il) * lgb) : __builtin_amdgcn_exp2f((float)(SC - il) * lgb);
#pragma unroll
                            for (int n = 0; n < 8; ++n) acc[m][n] *= sc_; }
                    }
                }
                for (int j = 0; j < 4; ++j) {
#pragma unroll
                    for (int m = 0; m < 4; ++m) { sacc[m][0] = (f32x4){0.f, 0.f, 0.f, 0.f}; sacc[m][1] = (f32x4){0.f, 0.f, 0.f, 0.f}; }
                    for (int r = 0; r < 4; ++r) {
                        const int idx = 16 + 8 * j + r;
                        BP_TOP(idx);
                        const int so = (idx % 3) * SLOT;
                        { const int l_ = opaque(lane), fr = l_ & 15, fq = l_ >> 4;
#pragma unroll
                          for (int ks = 0; ks < 2; ++ks) { bf16x8 af_[4], kf_[2]; const int cx = ((4 * ks + fq) ^ (fr >> 1)) & 7;
#pragma unroll
                              for (int m = 0; m < 4; ++m) af_[m] = *(const LAS bf16x8*)(lds + so + (64 * wr + 16 * m + fr) * 128 + cx * 16);
#pragma unroll
                              for (int n = 0; n < 2; ++n) kf_[n] = *(const LAS bf16x8*)(lds + so + 16384 + (32 * wc + 16 * n + fr) * 128 + cx * 16);
#pragma unroll
                              for (int m = 0; m < 4; ++m)
#pragma unroll
                                  for (int n = 0; n < 2; ++n) sacc[m][n] = __builtin_amdgcn_mfma_f32_16x16x32_bf16(kf_[n], af_[m], sacc[m][n], 0, 0, 0); } }
                        if (r == 3) {
                            const int l_ = opaque(lane), fr = l_ & 15, fq = l_ >> 4;
#pragma unroll
                            for (int m = 0; m < 4; ++m)
#pragma unroll
                                for (int n = 0; n < 2; ++n) { const int il = 128 * cq + 64 * wr + 16 * m + fr, jl0 = 128 * j + 32 * wc + 16 * n + 4 * fq; float pv[4];
#pragma unroll
                                    for (int e = 0; e < 4; ++e) { const int dl = il - (jl0 + e);
                                        const float dec = dl > 0 ? __builtin_amdgcn_exp2f((float)dl * lgf) : (dl < 0 ? __builtin_amdgcn_exp2f((float)(-dl) * lgb) : 2.0f); pv[e] = sacc[m][n][e] * dec; }
                                    u32x2 w; w.x = pk2(pv[0], pv[1]); w.y = pk2(pv[2], pv[3]);
                                    *(LAS u32x2*)(lds + PBUF + (64 * wr + 16 * m + fr) * 256 + (((4 * wc + 2 * n + (fq >> 1)) ^ fr) & 15) * 16 + (fq & 1) * 8) = w; }
                        }
                    }
                    for (int r = 0; r < 4; ++r) {
                        const int idx = 16 + 8 * j + 4 + r;
                        BP_TOP(idx);
                        const int so = (idx % 3) * SLOT;
#define AADDR_P(row, fr, fq) (PBUF + (row) * 256 + (((4 * r + (fq)) ^ (fr)) & 15) * 16)
                        BP_MMA_FULL(AADDR_P, so);
#undef AADDR_P
                    }
                }
                asm volatile("s_waitcnt vmcnt(0) lgkmcnt(0)" ::: "memory"); __builtin_amdgcn_s_barrier(); asm volatile("" ::: "memory");
                { LAS float* red = (LAS float*)(lds + REDB); const int l_ = opaque(lane), fr = l_ & 15, fq = l_ >> 4;
#pragma unroll
                  for (int m = 0; m < 4; ++m) { float ss = 0.f;
#pragma unroll
                      for (int n = 0; n < 8; ++n) ss += (acc[m][n][0] * acc[m][n][0] + acc[m][n][1] * acc[m][n][1]) + (acc[m][n][2] * acc[m][n][2] + acc[m][n][3] * acc[m][n][3]);
                      ss += __shfl_xor(ss, 16); ss += __shfl_xor(ss, 32);
                      if (fq == 0) red[(64 * wr + 16 * m + fr) * 4 + wc] = ss; }
                  __syncthreads();
                  bf16* gp0 = GB + (size_t)(b * SEQ + c * 128 + 64 * wr + fr) * 2048 + h * DV + 128 * wc + 4 * fq;
#pragma unroll
                  for (int mh = 0; mh < 4; mh += 2) {
                      u32x2 gw[2][8];
#pragma unroll
                      for (int q = 0; q < 2; ++q)
#pragma unroll
                          for (int n = 0; n < 8; ++n) gw[q][n] = *(const u32x2*)(gp0 + (size_t)(16 * (mh + q)) * 2048 + 16 * n);
#pragma unroll
                      for (int q = 0; q < 2; ++q) { const int m = mh + q, row = 64 * wr + 16 * m + fr; const f32x4 t4 = *(const LAS f32x4*)(red + row * 4);
                          const float rs = 1.0f / sqrtf(((t4[0] + t4[1]) + (t4[2] + t4[3])) * (1.0f / DV) + EPS);
                          bf16* gp = gp0 + (size_t)(16 * m) * 2048;
#pragma unroll
                          for (int n = 0; n < 8; ++n) {
                              const float o0 = siluf(bflo(gw[q][n].x)) * acc[m][n][0] * rs, o1 = siluf(bfhi(gw[q][n].x)) * acc[m][n][1] * rs, o2 = siluf(bflo(gw[q][n].y)) * acc[m][n][2] * rs, o3 = siluf(bfhi(gw[q][n].y)) * acc[m][n][3] * rs;
                              u32x2 w; w.x = pk2(o0, o1); w.y = pk2(o2, o3); if (!(PROBE_DUP == 4 && rep == 1)) *(u32x2*)(gp + 16 * n) = w; } } }
                  __syncthreads();
                }
            }
#undef BP_WAITV
#undef BP_GLDS
#undef BP_ISSUE
#undef BP_NLOADS
#undef BP_TOP
#undef BP_MMA_FULL
        } break;
        case 5: case 7: case 10: case 12: if (PHMASK & (1<<5)) {
            const int l = (ph >= 10) ? 1 : 0; const float* adal = ADA + l * 3 * NQ;
            if (ph == 5) WPREP_JOBS(0, 1, gw, NGW);
            pg8::StaticOrder S; S.init(M, D, G, bx);
            if (ph == 12) {
                pg8::Gemm g{HID, (const bf16*)(ws + WS_W2_1), M, D, FF, 0};
                EpiResFinal E{XB, args.out, adal + 5 * D, args.in[IN_FN], (float*)(ws + MS_XPART), ctl, lds + RSTD_LDS};
                pg8::gemm_phase<EpiResFinal, pg8::StaticOrder, true, true, false>(lds, g, S, E, tid);
            } else {
                pg8::Gemm g; EpiRes E;
                if (ph == 5) { g = pg8::Gemm{GB, WO, M, D, 2048, 0}; E = EpiRes{x, nullptr, XB, adal + 2 * D, SSQ, 0}; }
                else if (ph == 7) { g = pg8::Gemm{HID, (const bf16*)(ws + WS_W2_0), M, D, FF, 0}; E = EpiRes{nullptr, XB, XB, adal + 5 * D, SSQ, 0}; }
                else { g = pg8::Gemm{ACV, WCO, M, D, D, 0}; E = EpiRes{nullptr, XB, XB, adal + 2 * D, SSQ, 0}; }
                E.dry = (PROBE_DUP == ph && rep == 1) ? 1 : 0;
                pg8::gemm_phase<EpiRes, pg8::StaticOrder, true, true, false>(lds, g, S, E, tid);
            }
        } break;
        case 6: case 11: if (PHMASK & (1<<6)) {
            const int l = (ph == 11) ? 1 : 0;
            pg8::Gemm g{XB, W13[l], M, 5632, D, (size_t)5632 * D * 2}; pg8::StaticOrder S; S.init(M, 5632, G, bx);
#define BS_FFN(u, t) bias_sum(BIAS3 + (l * 2 + ((u).pm >> 5)) * NKQ * 5632, 5632, (u).pn * 256 + (t))
            BUILD_TABS(S, RS_SSQ, BS_FFN);
#undef BS_FFN
            EpiSwiGLU E{HID, (const LAS float*)(lds + RSTD_LDS), (const LAS float*)(lds + BIAS_LDS), (PROBE_DUP == ph && rep == 1 && SSVAR == 21) ? 1 : 0};
            pg8::gemm_phase<EpiSwiGLU, pg8::StaticOrder, true, true, false>(lds, g, S, E, tid);
            if (ph == 6 && bx >= 128) WPREP_JOBS(1, 3, (bx - 128) * NWAVES + wave, (G - 128) * NWAVES);
        } break;
        case 8: if (PHMASK & (1<<8)) {
            pg8::Gemm g{XB, WCI, M, 3072, D, (size_t)3072 * D * 2}; pg8::StaticOrder S; S.init(M, 3072, G, bx);
#define BS_CI(u, t) bias_sum(BIAS5 + ((u).pm >> 5) * NKQ * 3072, 3072, (u).pn * 256 + (t))
            BUILD_TABS(S, RS_SSQ, BS_CI);
#undef BS_CI
            EpiConvIn E{CU, CB, (const LAS float*)(lds + RSTD_LDS), (const LAS float*)(lds + BIAS_LDS)};
            pg8::gemm_phase<EpiConvIn, pg8::StaticOrder, true, true, false>(lds, g, S, E, tid);
        } break;
        case 9: if (PHMASK & (1<<9)) {
            const float* cw = args.in[IN_CW];
            for (int it = bx * NTHR + tid; it < M * (D / 8); it += G * NTHR) {
                const int r = it >> 7, k = (it & 127) * 8, t = r & (SEQ - 1);
                float u0[8], um[8], up[8], bb[8];
                unpack8(*(const u32x4*)(CU + (size_t)r * D + k), u0); unpack8(*(const u32x4*)(CB + (size_t)r * D + k), bb);
                if (t > 0) unpack8(*(const u32x4*)(CU + (size_t)(r - 1) * D + k), um); else { for (int q = 0; q < 8; ++q) um[q] = 0.f; }
                if (t < SEQ - 1) unpack8(*(const u32x4*)(CU + (size_t)(r + 1) * D + k), up); else { for (int q = 0; q < 8; ++q) up[q] = 0.f; }
                float o[8];
#pragma unroll
                for (int q = 0; q < 8; ++q) o[q] = bb[q] * (cw[k + q] * um[q] + cw[D + k + q] * u0[q] + cw[2 * D + k + q] * up[q]);
                u32x4 w; w.x = pk2(o[0], o[1]); w.y = pk2(o[2], o[3]); w.z = pk2(o[4], o[5]); w.w = pk2(o[6], o[7]);
                *(u32x4*)(ACV + (size_t)r * D + k) = w;
            }
        } break;
        case 13: if (PHMASK & (1<<13)) {
            const float* fn = args.in[IN_FN];
            for (int it = bx * NTHR + tid; it < M * (D / 4); it += G * NTHR) {
                const int r = it >> 8, k = (it & 255) * 4; const float rs = rstd_from_ssq(SSQ, r);
                const u32x2 hw = *(const u32x2*)(XB + (size_t)r * D + k); const f32x4 hv = {bflo(hw.x), bfhi(hw.x), bflo(hw.y), bfhi(hw.y)};
                *(f32x4*)(args.out + (size_t)r * D + k) = hv * rs * *(const f32x4*)(fn + k);
            }
        } break;
        default: break;
        }
        if (ph0 < args.ph_hi) xcd_barrier(bar);
        if (SSVAR == 6 && ph == 6) { for (int e_ = 0; e_ < 10; ++e_) xcd_barrier(bar); }
    }
}

#ifndef MK_PER_PHASE
#define MK_PER_PHASE 0
#endif
extern "C" void kernel_launch(void* const* d_in, const int* in_sizes, int n_in, void* d_out, int out_size, void* d_ws, size_t ws_size, hipStream_t stream) {
    static int grid = 0;
    if (grid == 0) {
        if (n_in != N_IN || out_size != M * D || ws_size < WS_END) { fprintf(stderr, "kernel_launch: unexpected shapes (n_in %d, out %d, ws %zu); nothing launched\n", n_in, out_size, ws_size); grid = -1; return; }
        int dev = 0, cus = 0, per_cu = 0;
        if (hipGetDevice(&dev) != hipSuccess || hipDeviceGetAttribute(&cus, hipDeviceAttributeMultiprocessorCount, dev) != hipSuccess) { grid = -1; return; }
        if (hipFuncSetAttribute((const void*)fwd_kernel, hipFuncAttributeMaxDynamicSharedMemorySize, LDS_BYTES) != hipSuccess) { fprintf(stderr, "kernel_launch: hipFuncSetAttribute failed\n"); grid = -1; return; }
        if (hipOccupancyMaxActiveBlocksPerMultiprocessor(&per_cu, (const void*)fwd_kernel, NTHR, LDS_BYTES) != hipSuccess || per_cu < 1) { fprintf(stderr, "kernel_launch: occupancy query says %d blocks per CU\n", per_cu); }
        (void)hipGetLastError();
        grid = cus;
    }
    if (grid < 0) return;
    (void)hipMemsetAsync((char*)d_ws + WS_CTL, 0, CTL_ZERO_BYTES, stream);
    Args a{};
    for (int i = 0; i < N_IN; ++i) a.in[i] = (const float*)d_in[i];
    a.out = (float*)d_out; a.ws = (unsigned char*)d_ws;
#if MK_PER_PHASE
    for (int p = 0; p < NPH; ++p) { a.ph_lo = p; a.ph_hi = p + 1; hipLaunchKernelGGL(fwd_kernel, dim3(grid), dim3(NTHR), LDS_BYTES, stream, a); }
#else
    a.ph_lo = 0; a.ph_hi = NPH; hipLaunchKernelGGL(fwd_kernel, dim3(grid), dim3(NTHR), LDS_BYTES, stream, a);
#if SSVAR == 7
    (void)hipMemsetAsync((char*)d_ws + WS_CTL, 0, CTL_ZERO_BYTES, stream); hipLaunchKernelGGL(fwd_kernel, dim3(grid), dim3(NTHR), LDS_BYTES, stream, a);
#endif
#endif
}
```

```cpp
#include <hip/hip_runtime.h>
#include <cstdio>
#include <cstdint>

#define LAS __attribute__((address_space(3)))
#define GAS __attribute__((address_space(1)))
typedef unsigned short bf16;
typedef short bf16x8 __attribute__((ext_vector_type(8)));
typedef float f32x4 __attribute__((ext_vector_type(4)));
typedef float f32x2 __attribute__((ext_vector_type(2)));
typedef unsigned u32x4 __attribute__((ext_vector_type(4)));
typedef unsigned u32x2 __attribute__((ext_vector_type(2)));

__device__ __forceinline__ int opaque(int v) { asm volatile("" : "+v"(v)); return v; }
constexpr int D = 1024, BATCH = 2, SEQ = 8192, M = BATCH * SEQ, CTXL = 256, MC = BATCH * CTXL, NH = 4, DK = 256, DV = 512, FF = 2816, NQ = 6 * D;
constexpr int SC = 512, NSC = SEQ / SC;
constexpr float EPS = 1e-6f;
constexpr int NWAVES = 8, NTHR = 512;

constexpr size_t MiB = 1u << 20, HMiB = 1u << 19;
constexpr size_t WS_CTL = 0, CTL_ZERO_BYTES = 1 * MiB;
constexpr size_t CTL_ADA = 65536;
constexpr size_t WS_MISC = 1 * MiB;
constexpr size_t MS_ROPE = WS_MISC;
constexpr size_t MS_RSTDX = MS_ROPE + 65536;
constexpr size_t MS_RSTDC = MS_RSTDX + 65536;
constexpr size_t MS_BIAS1 = MS_RSTDC + 4096;
constexpr int NKQ = 8;
constexpr size_t MS_BIAS3 = 262144;
constexpr size_t MS_BIAS5 = MS_BIAS1 + 3 * 6144 * 4;
static_assert(MS_BIAS3 + 4 * NKQ * 5632 * 4 <= 1 * MiB && MS_BIAS5 + 2 * NKQ * 3072 * 4 <= 1 * MiB + 512 * 1024, "misc region");
constexpr size_t MS_XPART = 1 * MiB + 512 * 1024;
constexpr size_t WS_SSQ = 2 * MiB;
constexpr size_t WS_WQKVG = 3 * MiB;
constexpr size_t WS_WO = 15 * MiB;
constexpr size_t WS_W2_0 = 19 * MiB;
constexpr size_t WS_W2_1 = 24 * MiB + HMiB;
constexpr size_t WS_WCO = 30 * MiB;
constexpr size_t WS_ACB = 60 * MiB;
constexpr size_t WS_XB = 61 * MiB;
constexpr size_t WS_Q = 93 * MiB;
constexpr size_t WS_K = 125 * MiB;
constexpr size_t WS_VT = 157 * MiB;
constexpr size_t WS_SB = 221 * MiB;
constexpr size_t WS_KC = 253 * MiB;
constexpr size_t WS_VCT = 254 * MiB;
constexpr size_t WS_SF = WS_XB;
constexpr size_t WS_HID = 93 * MiB;
constexpr size_t WS_CU = 93 * MiB, WS_CB = 125 * MiB, WS_ACV = 157 * MiB;
constexpr size_t WS_W13_0 = 181 * MiB;
constexpr size_t WS_WCI = 203 * MiB;
constexpr size_t WS_W13_1 = 215 * MiB;
constexpr size_t WS_END = 256 * MiB;

namespace pg8 {
typedef unsigned short bf16_t;
constexpr int BM = 256, BK = 64, HALF = 128, HTB = HALF * BK * 2, STAGE_BYTES = 8 * HTB, NXCD = 8, WGM = 8;
__host__ __device__ __forceinline__ int lds_byte(int r, int c) { const int st = (r >> 4) * 2 + (c >> 5), rr = r & 15, cc = c & 31, ob = rr * 64 + cc * 2; return st * 1024 + (ob ^ (((ob >> 9) & 1) << 5)); }
__host__ __device__ __forceinline__ void stage_rc(int b, int& R, int& C) { const int st = b / 1024, sb = b % 1024, swz = sb ^ (((sb >> 9) & 1) << 5); R = (st >> 1) * 16 + swz / 64; C = (st & 1) * 32 + (swz % 64) / 2; }
__host__ __device__ __forceinline__ int perm32(int rho) { const int n = rho >> 4, i = rho & 15; return 8 * (i >> 2) + 4 * n + (i & 3); }
struct Unit { int pm, pn; };
struct Gemm { const bf16_t* A; const bf16_t* Bt; int M, N, K; size_t bstride; };
struct StaticOrder {
    int nM, nN, nwg, G, c;
    __host__ __device__ void init(int M_, int N_, int G_, int c_) { nM = M_ / BM; nN = N_ / BM; nwg = nM * nN; G = G_; c = c_; }
    __host__ __device__ bool next(int i, Unit& u) const {
        const long L = (long)i * G + c; if (L >= nwg) return false;
        int wgid = (int)L; { const int q = nwg / NXCD, r = nwg % NXCD, xcd = wgid % NXCD, off = wgid / NXCD; wgid = (xcd < r ? xcd * (q + 1) : r * (q + 1) + (xcd - r) * q) + off; }
        const int nig = WGM * nN, gid = wgid / nig, fm = gid * WGM, gsz = (nM - fm) < WGM ? (nM - fm) : WGM;
        u.pm = fm + ((wgid % nig) % gsz); u.pn = (wgid % nig) / gsz; return true;
    }
    __device__ __forceinline__ void a_ready(const Unit&) const {}
    __device__ __forceinline__ void done(const Unit&) const {}
};
struct OneUnit { int pm, pn; bool have;
    __device__ __forceinline__ bool next(int i, Unit& u) const { if (i != 0 || !have) return false; u.pm = pm; u.pn = pn; return true; }
    __device__ __forceinline__ void a_ready(const Unit&) const {}
    __device__ __forceinline__ void done(const Unit&) const {}
};
template <class Epi, class Sched, bool ALIGN_EPI, bool SP2, bool SWAP>
__device__ __forceinline__ void gemm_phase(LAS unsigned char* lds, const Gemm g, const Sched& S, const Epi& E, const int tid) {
    const int wid = __builtin_amdgcn_readfirstlane(tid >> 6), wr = wid >> 2, wc = wid & 3;
    int lane = tid & 63, fr = lane & 15, fq = lane >> 4;
    const int K = g.K, nt = K / BK;
    unsigned voffA[2], voffB[2]; int aoff, boff;
#define PG8_SETUP() do { const int t_ = opaque(tid); lane = t_ & 63; fr = lane & 15; fq = lane >> 4; \
        _Pragma("unroll") for (int i = 0; i < 2; ++i) { int R, C; stage_rc(t_ * 16 + i * 8192, R, C); const int Rp = (R & ~31) + perm32(R & 31); \
            voffA[i] = (unsigned)((SWAP ? Rp : R) * K + C) * 2u; voffB[i] = (unsigned)((SWAP ? R : Rp) * K + C) * 2u; } \
        aoff = lds_byte(wr * 64 + fr, fq * 8); boff = lds_byte(wc * 32 + fr, fq * 8); } while (0)
    PG8_SETUP();
    const size_t kstep = (size_t)(BK * 2);
    const size_t hstep = (size_t)HALF * K * 2;
    const size_t tstep = 2 * hstep;
    const unsigned ldsw = (unsigned)wid * 1024u;
#define PG8_SA(b, h) (((b) * 2 + (h)) * HTB)
#define PG8_SB(b, h) ((4 + (b) * 2 + (h)) * HTB)
#define PG8_STAGE(bufoff, gbase, voff) do { _Pragma("unroll") for (int _i = 0; _i < 2; ++_i) \
        __builtin_amdgcn_global_load_lds((const unsigned*)((const char*)(gbase) + (voff)[_i]), (LAS unsigned*)(lds + (bufoff) + ldsw + _i * 8192), 16, 0, 0); } while (0)
#define PG8_LDA(dst, b, h) do { _Pragma("unroll") for (int m = 0; m < 4; ++m) _Pragma("unroll") for (int k = 0; k < 2; ++k) dst[m][k] = *(const LAS bf16x8*)(lds + PG8_SA(b, h) + aoff + m * 2048 + k * 1024); } while (0)
#define PG8_LDB(dst, b, h) do { _Pragma("unroll") for (int n = 0; n < 2; ++n) _Pragma("unroll") for (int k = 0; k < 2; ++k) dst[n][k] = *(const LAS bf16x8*)(lds + PG8_SB(b, h) + boff + n * 2048 + k * 1024); } while (0)
#define PG8_MMA(ai, bj, At, Bt) do { __builtin_amdgcn_s_setprio(1); _Pragma("unroll") for (int m = 0; m < 4; ++m) _Pragma("unroll") for (int n = 0; n < 2; ++n) _Pragma("unroll") for (int k = 0; k < 2; ++k) \
        acc[ai][bj][m][n] = SWAP ? __builtin_amdgcn_mfma_f32_16x16x32_bf16(At[m][k], Bt[n][k], acc[ai][bj][m][n], 0, 0, 0) \
                                 : __builtin_amdgcn_mfma_f32_16x16x32_bf16(Bt[n][k], At[m][k], acc[ai][bj][m][n], 0, 0, 0); __builtin_amdgcn_s_setprio(0); } while (0)
#define PG8_WAIT_V(n) asm volatile("s_waitcnt vmcnt(" #n ")" ::: "memory")
#define PG8_WAIT_L(n) asm volatile("s_waitcnt lgkmcnt(" #n ")" ::: "memory")
#define PG8_BAR __builtin_amdgcn_s_barrier()
#define PG8_SCHED __builtin_amdgcn_sched_barrier(0)
    Unit cur, nxt; int ui = 0;
    if (!S.next(0, cur)) return;
    f32x4 acc[2][2][4][2];
#pragma unroll
    for (int a = 0; a < 2; ++a)
#pragma unroll
        for (int b = 0; b < 2; ++b)
#pragma unroll
            for (int m = 0; m < 4; ++m)
#pragma unroll
                for (int n = 0; n < 2; ++n) acc[a][b][m][n] = (f32x4){0.f, 0.f, 0.f, 0.f};
    bf16x8 At[4][2], B0[2][2], B1[2][2];
    const char* cA = (const char*)g.A + (size_t)cur.pm * tstep; const char* cB = (const char*)g.Bt + (size_t)cur.pn * tstep + (cur.pm >= 32 ? g.bstride : 0);
    S.a_ready(cur);
    if constexpr (SP2) {
        PG8_STAGE(PG8_SB(0, 0), cB, voffB); PG8_STAGE(PG8_SB(0, 1), cB + hstep, voffB); PG8_STAGE(PG8_SA(0, 0), cA, voffA); PG8_STAGE(PG8_SA(0, 1), cA + hstep, voffA);
        if (wr == 1) PG8_BAR;
        PG8_WAIT_V(2); PG8_BAR;
        PG8_STAGE(PG8_SB(1, 0), cB + kstep, voffB); PG8_STAGE(PG8_SA(1, 0), cA + kstep, voffA); PG8_STAGE(PG8_SB(1, 1), cB + hstep + kstep, voffB);
        PG8_WAIT_V(6); PG8_BAR;
    } else {
        PG8_STAGE(PG8_SB(0, 0), cB, voffB); PG8_STAGE(PG8_SA(0, 0), cA, voffA); PG8_STAGE(PG8_SB(0, 1), cB + hstep, voffB); PG8_STAGE(PG8_SA(0, 1), cA + hstep, voffA);
        if (wr == 1) PG8_BAR;
        PG8_WAIT_V(4); PG8_BAR;
        PG8_STAGE(PG8_SB(1, 0), cB + kstep, voffB); PG8_STAGE(PG8_SA(1, 0), cA + kstep, voffA); PG8_STAGE(PG8_SB(1, 1), cB + hstep + kstep, voffB);
        PG8_WAIT_V(6); PG8_BAR;
    }
    for (;;) {
        const bool has_next = S.next(ui + 1, nxt);
        const char* nA = has_next ? (const char*)g.A + (size_t)nxt.pm * tstep : cA; const char* nB = has_next ? (const char*)g.Bt + (size_t)nxt.pn * tstep + (nxt.pm >= 32 ? g.bstride : 0) : cB;
        for (int t = 0; t < nt; t += 2) {
            const bool last = (t == nt - 2);
            const char* a1 = cA + (size_t)(t + 1) * kstep;
            const char* a2 = last ? nA : cA + (size_t)(t + 2) * kstep; const char* b2 = last ? nB : cB + (size_t)(t + 2) * kstep;
            const char* a3 = a2 + kstep; const char* b3 = b2 + kstep;
            if (last && has_next) S.a_ready(nxt);
            if constexpr (SP2) {
            PG8_LDB(B0, 0, 0); PG8_LDB(B1, 0, 1); PG8_SCHED; PG8_LDA(At, 0, 0); PG8_STAGE(PG8_SA(1, 1), a1 + hstep, voffA);
            PG8_WAIT_V(8); PG8_WAIT_L(0); PG8_BAR; PG8_MMA(0, 0, At, B0); PG8_MMA(0, 1, At, B1); PG8_BAR; PG8_SCHED;
            PG8_LDA(At, 0, 1); PG8_STAGE(PG8_SB(0, 0), b2, voffB); PG8_STAGE(PG8_SB(0, 1), b2 + hstep, voffB); PG8_STAGE(PG8_SA(0, 0), a2, voffA);
            PG8_WAIT_V(8); PG8_WAIT_L(0); PG8_BAR; PG8_MMA(1, 0, At, B0); PG8_MMA(1, 1, At, B1); PG8_BAR; PG8_SCHED;
            PG8_LDB(B0, 1, 0); PG8_LDB(B1, 1, 1); PG8_SCHED; PG8_LDA(At, 1, 0); PG8_STAGE(PG8_SA(0, 1), a2 + hstep, voffA);
            PG8_WAIT_V(8); PG8_WAIT_L(0); PG8_BAR; PG8_MMA(0, 0, At, B0); PG8_MMA(0, 1, At, B1); PG8_BAR; PG8_SCHED;
            PG8_LDA(At, 1, 1); PG8_STAGE(PG8_SB(1, 0), b3, voffB); PG8_STAGE(PG8_SB(1, 1), b3 + hstep, voffB); PG8_STAGE(PG8_SA(1, 0), a3, voffA);
            PG8_WAIT_V(8); PG8_WAIT_L(0); PG8_BAR; PG8_MMA(1, 0, At, B0); PG8_MMA(1, 1, At, B1); PG8_BAR; PG8_SCHED;
            } else {
            PG8_LDB(B0, 0, 0); PG8_SCHED; PG8_LDA(At, 0, 0); PG8_STAGE(PG8_SA(1, 1), a1 + hstep, voffA);
            PG8_WAIT_L(8); PG8_BAR; PG8_WAIT_L(0); PG8_MMA(0, 0, At, B0); PG8_BAR; PG8_SCHED;
            PG8_LDB(B1, 0, 1); PG8_STAGE(PG8_SB(0, 0), b2, voffB);
            PG8_BAR; PG8_WAIT_L(0); PG8_MMA(0, 1, At, B1); PG8_BAR;
            PG8_LDA(At, 0, 1); PG8_STAGE(PG8_SA(0, 0), a2, voffA);
            PG8_BAR; PG8_WAIT_L(0); PG8_MMA(1, 0, At, B0); PG8_BAR; PG8_SCHED;
            PG8_STAGE(PG8_SB(0, 1), b2 + hstep, voffB);
            PG8_WAIT_V(6); PG8_BAR; PG8_MMA(1, 1, At, B1); PG8_BAR;
            PG8_LDB(B0, 1, 0); PG8_SCHED; PG8_LDA(At, 1, 0); PG8_STAGE(PG8_SA(0, 1), a2 + hstep, voffA);
            PG8_WAIT_L(8); PG8_BAR; PG8_WAIT_L(0); PG8_MMA(0, 0, At, B0); PG8_BAR; PG8_SCHED;
            PG8_LDB(B1, 1, 1); PG8_STAGE(PG8_SB(1, 0), b3, voffB);
            PG8_BAR; PG8_WAIT_L(0); PG8_MMA(0, 1, At, B1); PG8_BAR;
            PG8_LDA(At, 1, 1); PG8_STAGE(PG8_SA(1, 0), a3, voffA);
            PG8_BAR; PG8_WAIT_L(0); PG8_MMA(1, 0, At, B0); PG8_BAR; PG8_SCHED;
            PG8_STAGE(PG8_SB(1, 1), b3 + hstep, voffB);
            PG8_WAIT_V(6); PG8_BAR; PG8_MMA(1, 1, At, B1); PG8_BAR;
            }
        }
        if constexpr (ALIGN_EPI) { if (wr == 0) PG8_BAR; }
        E(acc, cur, wr, wc, fr, fq, ui); S.done(cur);
        PG8_SETUP();
        if (!has_next) break;
#pragma unroll
        for (int a = 0; a < 2; ++a)
#pragma unroll
            for (int b = 0; b < 2; ++b)
#pragma unroll
                for (int m = 0; m < 4; ++m)
#pragma unroll
                    for (int n = 0; n < 2; ++n) acc[a][b][m][n] = (f32x4){0.f, 0.f, 0.f, 0.f};
        cur = nxt; cA = nA; cB = nB; ++ui;
        if constexpr (ALIGN_EPI) { if (wr == 1) PG8_BAR; }
    }
    PG8_WAIT_V(0);
    if constexpr (!ALIGN_EPI) { if (wr == 0) PG8_BAR; }
    PG8_BAR;
#undef PG8_SETUP
#undef PG8_SA
#undef PG8_SB
#undef PG8_STAGE
#undef PG8_LDA
#undef PG8_LDB
#undef PG8_MMA
#undef PG8_WAIT_V
#undef PG8_WAIT_L
#undef PG8_BAR
#undef PG8_SCHED
}
}

#define RLX_AGENT __ATOMIC_RELAXED, __HIP_MEMORY_SCOPE_AGENT
#define LDS_WAIT() asm volatile("s_waitcnt lgkmcnt(0)" ::: "memory")
typedef __bf16 hbf16x2 __attribute__((ext_vector_type(2)));
__device__ __forceinline__ unsigned pk2(float lo, float hi) { const f32x2 v = {lo, hi}; return __builtin_bit_cast(unsigned, __builtin_convertvector(v, hbf16x2)); }
__device__ __forceinline__ unsigned f2bf(float f) { return pk2(f, 0.f) & 0xffffu; }
__device__ __forceinline__ float bf2f(unsigned h) { return __builtin_bit_cast(float, h << 16); }
__device__ __forceinline__ float bflo(unsigned w) { return __builtin_bit_cast(float, w << 16); }
__device__ __forceinline__ float bfhi(unsigned w) { return __builtin_bit_cast(float, w & 0xffff0000u); }
__device__ __forceinline__ float siluf(float x) { return x * __builtin_amdgcn_rcpf(1.0f + __builtin_amdgcn_exp2f(-1.44269504089f * x)); }
__device__ __forceinline__ float wave_sum(float v) {
#pragma unroll
    for (int o = 1; o < 64; o <<= 1) v += __shfl_xor(v, o);
    return v;
}
__device__ __forceinline__ u32x4 pack8(const f32x4 a, const f32x4 b) { u32x4 w; w.x = pk2(a[0], a[1]); w.y = pk2(a[2], a[3]); w.z = pk2(b[0], b[1]); w.w = pk2(b[2], b[3]); return w; }

using pg8::Unit;
typedef f32x4 Acc[2][2][4][2];
struct EpiQKG {
    bf16* Q; bf16* K; bf16* G; const float* rstd; const float* bias;
    __device__ __forceinline__ void operator()(const Acc& acc, const Unit& u, int wr, int wc, int fr_, int fq_, int ui) const {
        const int fr = opaque(fr_), fq = opaque(fq_);
        const int b = u.pm >> 5; const float* bb = bias + b * NQ + u.pn * 256 + wc * 32 + 8 * fq;
        const int row0 = u.pm * 256 + wr * 64 + fr;
        f32x4 bv[2][2]; float rs[2][4];
#pragma unroll
        for (int ai = 0; ai < 2; ++ai)
#pragma unroll
            for (int m = 0; m < 4; ++m) rs[ai][m] = rstd[row0 + ai * 128 + m * 16];
#pragma unroll
        for (int bj = 0; bj < 2; ++bj)
#pragma unroll
            for (int n = 0; n < 2; ++n) bv[bj][n] = *(const f32x4*)(bb + bj * 128 + 4 * n);
        if (u.pn < 8) {
            const bool isk = u.pn >= 4; bf16* O = isk ? K : Q; const float osc = isk ? 0.0625f : 1.0f;
            const int a = wc >> 1, i0 = (wc & 1) * 32 + 8 * fq, colo = (u.pn & 3) * 256 + wc * 32 + 8 * fq;
            f32x4 frv[2];
#pragma unroll
            for (int n = 0; n < 2; ++n)
#pragma unroll
                for (int j = 0; j < 4; ++j) frv[n][j] = __builtin_amdgcn_exp2f(-(float)(i0 + 4 * n + j) * (13.287712379549449f / 64.0f)) * 0.15915494309189535f;
#pragma unroll
            for (int ai = 0; ai < 2; ++ai)
#pragma unroll
                for (int m = 0; m < 4; ++m) {
                    const int r = row0 + ai * 128 + m * 16; const float rsv = rs[ai][m]; const int t = r & (SEQ - 1); const float pos = (float)(a ? (t & 63) : (t >> 6));
                    f32x4 o1[2], o2[2];
#pragma unroll
                    for (int n = 0; n < 2; ++n) {
                        f32x4 cs, sn;
#pragma unroll
                        for (int j = 0; j < 4; ++j) { const float rv = __builtin_amdgcn_fractf(pos * frv[n][j]); cs[j] = __builtin_amdgcn_cosf(rv); sn[j] = __builtin_amdgcn_sinf(rv); }
                        const f32x4 x1 = acc[ai][0][m][n] * rsv + bv[0][n], x2 = acc[ai][1][m][n] * rsv + bv[1][n];
                        o1[n] = (x1 * cs - x2 * sn) * osc; o2[n] = (x1 * sn + x2 * cs) * osc;
                    }
                    bf16* rowp = O + (size_t)r * D + colo;
                    *(u32x4*)(rowp) = pack8(o1[0], o1[1]); *(u32x4*)(rowp + 128) = pack8(o2[0], o2[1]);
                }
        } else {
            const int colo = (u.pn - 8) * 256 + wc * 32 + 8 * fq;
#pragma unroll
            for (int ai = 0; ai < 2; ++ai)
#pragma unroll
                for (int m = 0; m < 4; ++m) {
                    const int r = row0 + ai * 128 + m * 16; const float rsv = rs[ai][m]; bf16* rowp = G + (size_t)r * 2048 + colo;
#pragma unroll
                    for (int bj = 0; bj < 2; ++bj) *(u32x4*)(rowp + bj * 128) = pack8(acc[ai][bj][m][0] * rsv + bv[bj][0], acc[ai][bj][m][1] * rsv + bv[bj][1]);
                }
        }
    }
};
struct EpiVT {
    bf16* VT; const float* rstd; const float* bias; int ldt; int tiles_per_b; int bias_row;
    __device__ __forceinline__ void operator()(const Acc& acc, const Unit& u, int wr, int wc, int fr_, int fq_, int ui) const {
        const int fr = opaque(fr_), fq = opaque(fq_);
        const int b = u.pm / tiles_per_b, t00 = (u.pm % tiles_per_b) * 256 + wr * 64 + 8 * fq, h = u.pn >> 1, e0 = (u.pn & 1) * 256 + wc * 32 + fr;
        const float* bb = bias + (bias_row < 0 ? b : bias_row) * NQ;
        float bs[2][2];
#pragma unroll
        for (int bj = 0; bj < 2; ++bj)
#pragma unroll
            for (int n = 0; n < 2; ++n) bs[bj][n] = bb[u.pn * 256 + bj * 128 + wc * 32 + n * 16 + fr];
        f32x4 rsv[2][2][2];
#pragma unroll
        for (int ai = 0; ai < 2; ++ai)
#pragma unroll
            for (int mp = 0; mp < 2; ++mp) { const float* rp = rstd + b * ldt + t00 + ai * 128 + mp * 32; rsv[ai][mp][0] = *(const f32x4*)rp; rsv[ai][mp][1] = *(const f32x4*)(rp + 4); }
#pragma unroll
        for (int ai = 0; ai < 2; ++ai)
#pragma unroll
            for (int mp = 0; mp < 2; ++mp) {
                const int tl = t00 + ai * 128 + mp * 32;
                const f32x4 r0 = rsv[ai][mp][0], r1 = rsv[ai][mp][1];
#pragma unroll
                for (int bj = 0; bj < 2; ++bj)
#pragma unroll
                    for (int n = 0; n < 2; ++n) {
                        const f32x4 v0 = acc[ai][bj][2 * mp][n] * r0 + bs[bj][n], v1 = acc[ai][bj][2 * mp + 1][n] * r1 + bs[bj][n];
                        bf16* p = VT + ((size_t)(((b * NH + h) * (ldt >> 7) + (tl >> 7)) * DV + e0 + bj * 128 + n * 16)) * 128 + (tl & 127);
                        *(u32x4*)p = pack8(v0, v1);
                    }
            }
    }
};
struct EpiRes {
    const float* res32; const bf16* res16; bf16* hx; const float* gate; float* ssq; int dry;
    __device__ __forceinline__ void operator()(const Acc& acc, const Unit& u, int wr, int wc, int fr_, int fq_, int ui) const {
        const int fr = opaque(fr_), fq = opaque(fq_);
        const int b = u.pm >> 5, col0 = u.pn * 256 + wc * 32 + 8 * fq, row0 = u.pm * 256 + wr * 64 + fr;
        f32x4 gv[2][2];
#pragma unroll
        for (int bj = 0; bj < 2; ++bj)
#pragma unroll
            for (int n = 0; n < 2; ++n) gv[bj][n] = *(const f32x4*)(gate + b * NQ + col0 + bj * 128 + 4 * n);
#pragma unroll
        for (int am = 0; am < 8; am += 2) {
            f32x4 rv[2][2][2];
            if (res32) {
#pragma unroll
                for (int q = 0; q < 2; ++q)
#pragma unroll
                    for (int bj = 0; bj < 2; ++bj) { const float* p = res32 + (size_t)(row0 + ((am + q) >> 2) * 128 + ((am + q) & 3) * 16) * D + col0 + bj * 128; rv[q][bj][0] = *(const f32x4*)p; rv[q][bj][1] = *(const f32x4*)(p + 4); }
            } else {
                u32x4 rw[2][2];
#pragma unroll
                for (int q = 0; q < 2; ++q)
#pragma unroll
                    for (int bj = 0; bj < 2; ++bj) rw[q][bj] = *(const u32x4*)(res16 + (size_t)(row0 + ((am + q) >> 2) * 128 + ((am + q) & 3) * 16) * D + col0 + bj * 128);
#pragma unroll
                for (int q = 0; q < 2; ++q)
#pragma unroll
                    for (int bj = 0; bj < 2; ++bj) { const u32x4 w = rw[q][bj]; rv[q][bj][0] = (f32x4){bflo(w.x), bfhi(w.x), bflo(w.y), bfhi(w.y)}; rv[q][bj][1] = (f32x4){bflo(w.z), bfhi(w.z), bflo(w.w), bfhi(w.w)}; }
            }
#pragma unroll
            for (int q = 0; q < 2; ++q) {
                const int ai = (am + q) >> 2, m = (am + q) & 3;
                const int r = row0 + ai * 128 + m * 16; const size_t off = (size_t)r * D + col0; float ss = 0.f;
#pragma unroll
                for (int bj = 0; bj < 2; ++bj) {
                    const f32x4 o0 = rv[q][bj][0] + gv[bj][0] * acc[ai][bj][m][0], o1 = rv[q][bj][1] + gv[bj][1] * acc[ai][bj][m][1];
                    ss += (o0[0] * o0[0] + o0[1] * o0[1]) + (o0[2] * o0[2] + o0[3] * o0[3]) + (o1[0] * o1[0] + o1[1] * o1[1]) + (o1[2] * o1[2] + o1[3] * o1[3]);
                    if (!dry) *(u32x4*)(hx + off + bj * 128) = pack8(o0, o1);
                }
                ss += __shfl_xor(ss, 16); ss += __shfl_xor(ss, 32);
                if (fq == 0) ssq[(size_t)r * 16 + u.pn * 4 + wc] = ss;
            }
        }
    }
};
constexpr int CW_PANEL = 8192;
struct EpiResFinal {
    const bf16* res16; float* out; const float* gate; const float* fn; float* xpart; unsigned* cnt; LAS unsigned char* ldsb;
    __device__ __forceinline__ void operator()(Acc& acc, const Unit& u, int wr, int wc, int fr_, int fq_, int ui) const {
        const int fr = opaque(fr_), fq = opaque(fq_), tid = opaque((int)threadIdx.x);
        const int b = u.pm >> 5, col0 = u.pn * 256 + wc * 32 + 8 * fq, row0 = u.pm * 256 + wr * 64 + fr;
        LAS float* part = (LAS float*)ldsb;
        LAS float* rtab = (LAS float*)(ldsb + 4096);
        f32x4 gv[2][2];
#pragma unroll
        for (int bj = 0; bj < 2; ++bj)
#pragma unroll
            for (int n = 0; n < 2; ++n) gv[bj][n] = *(const f32x4*)(gate + b * NQ + col0 + bj * 128 + 4 * n);
#pragma unroll
        for (int am = 0; am < 8; am += 2) {
            u32x4 rw[2][2];
#pragma unroll
            for (int q = 0; q < 2; ++q)
#pragma unroll
                for (int bj = 0; bj < 2; ++bj) rw[q][bj] = *(const u32x4*)(res16 + (size_t)(row0 + ((am + q) >> 2) * 128 + ((am + q) & 3) * 16) * D + col0 + bj * 128);
#pragma unroll
            for (int q = 0; q < 2; ++q) { const int ai = (am + q) >> 2, m = (am + q) & 3; float ss = 0.f;
#pragma unroll
                for (int bj = 0; bj < 2; ++bj) { const u32x4 w = rw[q][bj];
                    const f32x4 o0 = (f32x4){bflo(w.x), bfhi(w.x), bflo(w.y), bfhi(w.y)} + gv[bj][0] * acc[ai][bj][m][0], o1 = (f32x4){bflo(w.z), bfhi(w.z), bflo(w.w), bfhi(w.w)} + gv[bj][1] * acc[ai][bj][m][1];
                    ss += (o0[0] * o0[0] + o0[1] * o0[1]) + (o0[2] * o0[2] + o0[3] * o0[3]) + (o1[0] * o1[0] + o1[1] * o1[1]) + (o1[2] * o1[2] + o1[3] * o1[3]);
                    acc[ai][bj][m][0] = o0; acc[ai][bj][m][1] = o1; }
                ss += __shfl_xor(ss, 16); ss += __shfl_xor(ss, 32);
                if (fq == 0) part[(ai * 128 + wr * 64 + m * 16 + fr) * 4 + wc] = ss; }
        }
        asm volatile("s_waitcnt lgkmcnt(0)" ::: "memory"); __builtin_amdgcn_s_barrier(); asm volatile("" ::: "memory");
        if (tid < 256) { const f32x4 p4 = *(const LAS f32x4*)(part + tid * 4);
            __hip_atomic_store(xpart + (size_t)(u.pm * 256 + tid) * 4 + u.pn, (p4[0] + p4[1]) + (p4[2] + p4[3]), __ATOMIC_RELAXED, __HIP_MEMORY_SCOPE_AGENT); }
        asm volatile("s_waitcnt vmcnt(0)" ::: "memory"); __builtin_amdgcn_s_barrier(); asm volatile("" ::: "memory");
        if (tid == 0) { __hip_atomic_fetch_add(cnt + CW_PANEL + 64 * u.pm, 1u, __ATOMIC_RELAXED, __HIP_MEMORY_SCOPE_AGENT);
            unsigned sp = 0; while (__hip_atomic_load(cnt + CW_PANEL + 64 * u.pm, __ATOMIC_RELAXED, __HIP_MEMORY_SCOPE_AGENT) < 4u) { __builtin_amdgcn_s_sleep(2); if (++sp > (1u << 22)) break; } }
        asm volatile("s_waitcnt vmcnt(0) lgkmcnt(0)" ::: "memory"); __builtin_amdgcn_s_barrier(); asm volatile("" ::: "memory");
        if (tid < 256) { const float* xp = xpart + (size_t)(u.pm * 256 + tid) * 4; float t = 0.f;
#pragma unroll
            for (int q = 0; q < 4; ++q) t += __hip_atomic_load(xp + q, __ATOMIC_RELAXED, __HIP_MEMORY_SCOPE_AGENT);
            rtab[tid] = 1.0f / sqrtf(t * (1.0f / D) + EPS); }
        asm volatile("s_waitcnt vmcnt(0) lgkmcnt(0)" ::: "memory"); __builtin_amdgcn_s_barrier(); asm volatile("" ::: "memory");
        f32x4 fv[2][2];
#pragma unroll
        for (int bj = 0; bj < 2; ++bj)
#pragma unroll
            for (int n = 0; n < 2; ++n) fv[bj][n] = *(const f32x4*)(fn + col0 + bj * 128 + 4 * n);
#pragma unroll
        for (int ai = 0; ai < 2; ++ai)
#pragma unroll
            for (int m = 0; m < 4; ++m) { const float rs = rtab[ai * 128 + wr * 64 + m * 16 + fr]; float* op = out + (size_t)(row0 + ai * 128 + m * 16) * D + col0;
#pragma unroll
                for (int bj = 0; bj < 2; ++bj) { *(f32x4*)(op + bj * 128) = acc[ai][bj][m][0] * rs * fv[bj][0]; *(f32x4*)(op + bj * 128 + 4) = acc[ai][bj][m][1] * rs * fv[bj][1]; } }
    }
};
__device__ __forceinline__ float rstd_from_ssq(const float* ssq, int r) {
    const f32x4* p = (const f32x4*)(ssq + (size_t)r * 16); const f32x4 a = p[0], b = p[1], c = p[2], d = p[3];
    const float s = ((a[0] + a[1]) + (a[2] + a[3])) + ((b[0] + b[1]) + (b[2] + b[3])) + ((c[0] + c[1]) + (c[2] + c[3])) + ((d[0] + d[1]) + (d[2] + d[3]));
    return 1.0f / sqrtf(s * (1.0f / D) + EPS);
}
constexpr int RSTD_LDS = 131072, BIAS_LDS = 131072 + 8192;
struct EpiSwiGLU {
    bf16* HID; const LAS float* rtab; const LAS float* btab; int dry;
    __device__ __forceinline__ void operator()(const Acc& acc, const Unit& u, int wr, int wc, int fr_, int fq_, int ui) const {
        const int fr = opaque(fr_), fq = opaque(fq_); if (dry) return;
        f32x4 bv[2][2]; float rs[2][4];
#pragma unroll
        for (int ai = 0; ai < 2; ++ai)
#pragma unroll
            for (int m = 0; m < 4; ++m) rs[ai][m] = rtab[ui * 256 + ai * 128 + wr * 64 + m * 16 + fr];
#pragma unroll
        for (int bj = 0; bj < 2; ++bj)
#pragma unroll
            for (int n = 0; n < 2; ++n) bv[bj][n] = *(const LAS f32x4*)(btab + ui * 256 + bj * 128 + wc * 32 + 8 * fq + 4 * n);
        const int row0 = u.pm * 256 + wr * 64 + fr, colo = u.pn * 128 + wc * 32 + 8 * fq;
#pragma unroll
        for (int ai = 0; ai < 2; ++ai)
#pragma unroll
            for (int m = 0; m < 4; ++m) {
                const int r = row0 + ai * 128 + m * 16;
                f32x4 hv[2];
#pragma unroll
                for (int n = 0; n < 2; ++n) { const f32x4 a1 = acc[ai][0][m][n] * rs[ai][m] + bv[0][n], a3 = acc[ai][1][m][n] * rs[ai][m] + bv[1][n];
#pragma unroll
                    for (int j = 0; j < 4; ++j) hv[n][j] = siluf(a1[j]) * a3[j]; }
                *(u32x4*)(HID + (size_t)r * FF + colo) = pack8(hv[0], hv[1]);
            }
    }
};
struct EpiConvIn {
    bf16* CU; bf16* CB; const LAS float* rtab; const LAS float* btab;
    __device__ __forceinline__ void operator()(const Acc& acc, const Unit& u, int wr, int wc, int fr_, int fq_, int ui) const {
        const int fr = opaque(fr_), fq = opaque(fq_);
        f32x4 bv[2][2]; float rs[2][4];
#pragma unroll
        for (int ai = 0; ai < 2; ++ai)
#pragma unroll
            for (int m = 0; m < 4; ++m) rs[ai][m] = rtab[ui * 256 + ai * 128 + wr * 64 + m * 16 + fr];
#pragma unroll
        for (int bj = 0; bj < 2; ++bj)
#pragma unroll
            for (int n = 0; n < 2; ++n) bv[bj][n] = *(const LAS f32x4*)(btab + ui * 256 + bj * 128 + wc * 32 + 8 * fq + 4 * n);
        const int row0 = u.pm * 256 + wr * 64 + fr;
#pragma unroll
        for (int ai = 0; ai < 2; ++ai)
#pragma unroll
            for (int m = 0; m < 4; ++m) {
                const int r = row0 + ai * 128 + m * 16; const float rs_ = rs[ai][m];
                if (u.pn < 8) {
                    const f32x4 u0 = (acc[ai][0][m][0] * rs_ + bv[0][0]) * (acc[ai][1][m][0] * rs_ + bv[1][0]), u1 = (acc[ai][0][m][1] * rs_ + bv[0][1]) * (acc[ai][1][m][1] * rs_ + bv[1][1]);
                    *(u32x4*)(CU + (size_t)r * D + u.pn * 128 + wc * 32 + 8 * fq) = pack8(u0, u1);
                } else {
#pragma unroll
                    for (int bj = 0; bj < 2; ++bj) *(u32x4*)(CB + (size_t)r * D + (u.pn - 8) * 256 + bj * 128 + wc * 32 + 8 * fq) = pack8(acc[ai][bj][m][0] * rs_ + bv[bj][0], acc[ai][bj][m][1] * rs_ + bv[bj][1]);
                }
            }
    }
};

#define XB_TMO      128
#define XB_XCNT(j)  (256  + 64 * (j))
#define XB_XSUB(j)  (1280 + 64 * (j))
#define XB_XGEN(j)  (2304 + 64 * (j))
#define XB_TOP      3328
#define XB_TOPGEN   3392
#define XCD_BAR_WORDS 3456
#define XB_SPIN_CAP (1u << 20)
__device__ __forceinline__ unsigned xb_ld(unsigned* p)              { return __hip_atomic_load(p, __ATOMIC_RELAXED, __HIP_MEMORY_SCOPE_AGENT); }
__device__ __forceinline__ unsigned xb_add(unsigned* p, unsigned v) { return __hip_atomic_fetch_add(p, v, __ATOMIC_RELAXED, __HIP_MEMORY_SCOPE_AGENT); }
__device__ __forceinline__ unsigned xb_xcc_id() { return (unsigned)__builtin_amdgcn_s_getreg((3 << 11) | 20) & 0xFu; }
#define XB_SPIN(cond, bar) do { unsigned _sp = 0; while (cond) { __builtin_amdgcn_s_sleep(1); \
    if ((++_sp & 255u) == 0u) { if (xb_ld(&(bar)[XB_TMO])) break; if (_sp > XB_SPIN_CAP) { atomicAdd(&(bar)[XB_TMO], 1u); break; } } } } while (0)
struct XcdBarrier { unsigned* bar; unsigned x; volatile LAS unsigned* st; };
__device__ __forceinline__ XcdBarrier xcd_barrier_post(unsigned* bar, volatile LAS unsigned* st) {
    XcdBarrier b; b.bar = bar; b.x = xb_xcc_id(); b.st = st;
    if (threadIdx.x == 0) (void)xb_add(&bar[XB_XCNT(b.x)], 1u);
    return b;
}
__device__ __forceinline__ void xcd_barrier_complete(unsigned* bar, unsigned x, unsigned& nloc, unsigned& nx) {
    const unsigned G = gridDim.x * gridDim.y * gridDim.z;
    unsigned sum, cnt, mine, sp = 0u;
    for (;;) {
        sum = 0u; cnt = 0u; mine = 0u;
#pragma unroll
        for (unsigned j = 0; j < 16; ++j) { const unsigned c = xb_ld(&bar[XB_XCNT(j)]); sum += c; cnt += (c > 0u) ? 1u : 0u; mine = (j == x) ? c : mine; }
        if (sum == G) break;
        __builtin_amdgcn_s_sleep(1);
        if ((++sp & 255u) == 0u) { if (xb_ld(&bar[XB_TMO])) break; if (sp > XB_SPIN_CAP) { atomicAdd(&bar[XB_TMO], 1u); break; } }
    }
    nloc = mine > 0u ? mine : 1u; nx = cnt > 0u ? cnt : 1u;
}
__device__ __forceinline__ void xcd_barrier(const XcdBarrier& b) {
    asm volatile("s_waitcnt vmcnt(0)" ::: "memory");
    __syncthreads();
    if (threadIdx.x == 0) {
        unsigned* bar = b.bar;
        __builtin_amdgcn_s_waitcnt(0);
        unsigned nloc = b.st[0], nx = b.st[1];
        if (nloc == 0u) { xcd_barrier_complete(bar, b.x, nloc, nx); b.st[0] = nloc; b.st[1] = nx; }
        const unsigned old = xb_add(&bar[XB_XSUB(b.x)], 1u);
        const unsigned gen = old / nloc;
        if (old + 1u == (gen + 1u) * nloc) {
            __builtin_amdgcn_fence(__ATOMIC_RELEASE, "agent");
            asm volatile("s_waitcnt vmcnt(0)" ::: "memory");
            const unsigned og = xb_add(&bar[XB_TOP], 1u);
            const unsigned tg = og / nx;
            if (og + 1u == (tg + 1u) * nx) xb_add(&bar[XB_TOPGEN], 1u);
            else XB_SPIN(xb_ld(&bar[XB_TOPGEN]) == tg, bar);
            __builtin_amdgcn_fence(__ATOMIC_ACQUIRE, "agent");
            xb_add(&bar[XB_XGEN(b.x)], 1u);
            asm volatile("s_waitcnt vmcnt(0)" ::: "memory");
        } else {
            XB_SPIN(xb_ld(&bar[XB_XGEN(b.x)]) == gen, bar);
            __builtin_amdgcn_fence(__ATOMIC_ACQUIRE, "agent");
            asm volatile("s_waitcnt vmcnt(0)" ::: "memory");
        }
    }
    __syncthreads();
}

enum { IN_X = 0, IN_C, IN_CTX, IN_CCTX, IN_ADAW, IN_ADAB, IN_NMIX, IN_NFFN, IN_WQKVG, IN_WO, IN_WCI, IN_CW, IN_WCO, IN_W1, IN_W3, IN_W2, IN_FN, N_IN };
struct Args { const float* in[N_IN]; float* out; unsigned char* ws; int ph_lo, ph_hi; };
constexpr int CW_BAR = 4096;
constexpr int LDS_BYTES = 163840, MISC_OFF = 163712;
constexpr int NPH = 14;
#ifndef P1_RW
#define P1_RW 5
#endif
#define P1_R1 (16384 - 2048 * P1_RW)
#ifndef G1SEL
#define G1SEL 7
#endif
#ifndef PHMASK
#define PHMASK 0xFFFF
#endif

__device__ __forceinline__ void transpose_item(const float* W, int Nsrc, int K, bf16* WT, int k0, int n_src0, int dst_row0, LAS float* scr, int lane) {
#pragma unroll
    for (int i = 0; i < 32; ++i) { const int kk = 2 * i + (lane >> 5); scr[kk * 33 + (lane & 31)] = W[(size_t)(k0 + kk) * Nsrc + n_src0 + (lane & 31)]; }
    LDS_WAIT(); asm volatile("" ::: "memory");
    const int c = lane & 7;
#pragma unroll
    for (int j = 0; j < 4; ++j) { const int n = (lane >> 3) + 8 * j; const LAS float* s = scr + (8 * c) * 33 + n;
        u32x4 o; o.x = pk2(s[0 * 33], s[1 * 33]); o.y = pk2(s[2 * 33], s[3 * 33]); o.z = pk2(s[4 * 33], s[5 * 33]); o.w = pk2(s[6 * 33], s[7 * 33]);
        *(u32x4*)(WT + (size_t)(dst_row0 + n) * K + k0 + 8 * c) = o; }
    LDS_WAIT(); asm volatile("" ::: "memory");
}
__device__ __forceinline__ void transpose_item_scaled(const float* W, int Nsrc, bf16* WT0, bf16* WT1, int k0, int n_src0, int dst_row0, LAS float* scr, const LAS float* tab, float& a0, float& a1, int lane) {
    LAS float* s0 = scr; LAS float* s1 = scr + 64 * 33;
#pragma unroll
    for (int i = 0; i < 32; ++i) { const int kk = 2 * i + (lane >> 5); const float w = W[(size_t)(k0 + kk) * Nsrc + n_src0 + (lane & 31)];
        s0[kk * 33 + (lane & 31)] = w * tab[k0 + kk]; s1[kk * 33 + (lane & 31)] = w * tab[1024 + k0 + kk]; a0 += w * tab[2048 + k0 + kk]; a1 += w * tab[3072 + k0 + kk]; }
    LDS_WAIT(); asm volatile("" ::: "memory");
    const int c = lane & 7;
#pragma unroll
    for (int j = 0; j < 4; ++j) { const int n = (lane >> 3) + 8 * j; const LAS float* p0 = s0 + (8 * c) * 33 + n; const LAS float* p1 = s1 + (8 * c) * 33 + n;
        u32x4 o; o.x = pk2(p0[0 * 33], p0[1 * 33]); o.y = pk2(p0[2 * 33], p0[3 * 33]); o.z = pk2(p0[4 * 33], p0[5 * 33]); o.w = pk2(p0[6 * 33], p0[7 * 33]);
        *(u32x4*)(WT0 + (size_t)(dst_row0 + n) * D + k0 + 8 * c) = o;
        o.x = pk2(p1[0 * 33], p1[1 * 33]); o.y = pk2(p1[2 * 33], p1[3 * 33]); o.z = pk2(p1[4 * 33], p1[5 * 33]); o.w = pk2(p1[6 * 33], p1[7 * 33]);
        *(u32x4*)(WT1 + (size_t)(dst_row0 + n) * D + k0 + 8 * c) = o; }
    LDS_WAIT(); asm volatile("" ::: "memory");
}
template <bool SCALED>
__device__ __forceinline__ void tr64(const float* W, int Nsrc, int K, bf16* WT0, bf16* WT1, int k0, int n_src0, int dst_row0, const LAS float* tab, f32x4& a0, f32x4& a1, int lane) {
    const int n4 = lane & 15, kr = lane >> 4;
    const float* src = W + (size_t)(k0 + 16 * kr) * Nsrc + n_src0 + 4 * n4;
    f32x4 v[16];
#pragma unroll
    for (int i = 0; i < 16; ++i) v[i] = *(const f32x4*)(src + (size_t)i * Nsrc);
    if constexpr (!SCALED) {
#pragma unroll
        for (int j = 0; j < 4; ++j) { bf16* drow = WT0 + (size_t)(dst_row0 + 4 * n4 + j) * K + k0 + 16 * kr;
#pragma unroll
            for (int h = 0; h < 2; ++h) { u32x4 o; o.x = pk2(v[8 * h][j], v[8 * h + 1][j]); o.y = pk2(v[8 * h + 2][j], v[8 * h + 3][j]); o.z = pk2(v[8 * h + 4][j], v[8 * h + 5][j]); o.w = pk2(v[8 * h + 6][j], v[8 * h + 7][j]);
                *(u32x4*)(drow + 8 * h) = o; } }
    } else {
        float s0[16], s1[16];
#pragma unroll
        for (int i = 0; i < 16; ++i) { const int k = k0 + 16 * kr + i; s0[i] = tab[k]; s1[i] = tab[1024 + k]; a0 += v[i] * tab[2048 + k]; a1 += v[i] * tab[3072 + k]; }
#pragma unroll
        for (int j = 0; j < 4; ++j) { bf16* d0 = WT0 + (size_t)(dst_row0 + 4 * n4 + j) * K + k0 + 16 * kr; bf16* d1 = WT1 + (size_t)(dst_row0 + 4 * n4 + j) * K + k0 + 16 * kr;
#pragma unroll
            for (int h = 0; h < 2; ++h) { u32x4 o;
                o.x = pk2(v[8 * h][j] * s0[8 * h], v[8 * h + 1][j] * s0[8 * h + 1]); o.y = pk2(v[8 * h + 2][j] * s0[8 * h + 2], v[8 * h + 3][j] * s0[8 * h + 3]);
                o.z = pk2(v[8 * h + 4][j] * s0[8 * h + 4], v[8 * h + 5][j] * s0[8 * h + 5]); o.w = pk2(v[8 * h + 6][j] * s0[8 * h + 6], v[8 * h + 7][j] * s0[8 * h + 7]);
                *(u32x4*)(d0 + 8 * h) = o;
                o.x = pk2(v[8 * h][j] * s1[8 * h], v[8 * h + 1][j] * s1[8 * h + 1]); o.y = pk2(v[8 * h + 2][j] * s1[8 * h + 2], v[8 * h + 3][j] * s1[8 * h + 3]);
                o.z = pk2(v[8 * h + 4][j] * s1[8 * h + 4], v[8 * h + 5][j] * s1[8 * h + 5]); o.w = pk2(v[8 * h + 6][j] * s1[8 * h + 6], v[8 * h + 7][j] * s1[8 * h + 7]);
                *(u32x4*)(d1 + 8 * h) = o; } }
    }
}
__device__ __forceinline__ int map_qkvg(int np) {
    if (np < 2048) { const int qk = np >> 10, h = (np >> 8) & 3, cp = np & 255; const int d = 128 * ((cp >> 6) & 1) + 64 * (cp >> 7) + (cp & 63); return qk * 1024 + h * 256 + d; }
    if (np < 4096) return 4096 + (np - 2048);
    return 2048 + (np - 4096);
}
__device__ __forceinline__ int map_wci(int np) { const int tile = np >> 8, cp = np & 255; if (tile < 8) return (cp < 128) ? (1024 + 128 * tile + cp) : (2048 + 128 * tile + cp - 128); return 256 * (tile - 8) + cp; }
__device__ __forceinline__ void unpack8(const u32x4 w, float (&f)[8]) { f[0] = bflo(w.x); f[1] = bfhi(w.x); f[2] = bflo(w.y); f[3] = bfhi(w.y); f[4] = bflo(w.z); f[5] = bfhi(w.z); f[6] = bflo(w.w); f[7] = bfhi(w.w); }

template <int RB>
__device__ __forceinline__ void modrows(const float* xrow0, const float* gain, const float* scale, bf16* orow0, float* rstd0, int lane) {
    f32x4 v[RB][4]; float ss[RB];
#pragma unroll
    for (int r = 0; r < RB; ++r)
#pragma unroll
        for (int j = 0; j < 4; ++j) v[r][j] = ((const f32x4*)(xrow0 + (size_t)r * D) + lane)[64 * j];
    f32x4 w[4];
#pragma unroll
    for (int j = 0; j < 4; ++j) w[j] = ((const f32x4*)gain + lane)[64 * j] * (((const f32x4*)scale + lane)[64 * j] + 1.0f);
#pragma unroll
    for (int r = 0; r < RB; ++r) { float s_ = 0.f;
#pragma unroll
        for (int j = 0; j < 4; ++j) s_ += (v[r][j][0] * v[r][j][0] + v[r][j][1] * v[r][j][1]) + (v[r][j][2] * v[r][j][2] + v[r][j][3] * v[r][j][3]);
        ss[r] = wave_sum(s_); }
#pragma unroll
    for (int r = 0; r < RB; ++r) { if (lane == 0) rstd0[r] = 1.0f / sqrtf(ss[r] * (1.0f / D) + EPS);
        unsigned long long* o8 = (unsigned long long*)(orow0 + (size_t)r * D) + lane;
#pragma unroll
        for (int j = 0; j < 4; ++j) { const f32x4 o = v[r][j] * w[j]; o8[64 * j] = (unsigned long long)pk2(o[0], o[1]) | ((unsigned long long)pk2(o[2], o[3]) << 32); } }
}
template <int RB>
__device__ __forceinline__ void biasrows(const bf16* wrow0, const float* sh, int q_lo, int q_hi, float* out0, int lane) {
    u32x4 wv[RB][2];
#pragma unroll
    for (int r = 0; r < RB; ++r)
#pragma unroll
        for (int j = 0; j < 2; ++j) wv[r][j] = *(const u32x4*)(wrow0 + (size_t)r * D + j * 512 + lane * 8);
#pragma unroll
    for (int q = 0; q < 3; ++q) if (q >= q_lo && q < q_hi) {
        float a[RB];
#pragma unroll
        for (int r = 0; r < RB; ++r) a[r] = 0.f;
#pragma unroll
        for (int j = 0; j < 2; ++j) { const float* s_ = sh + q * NQ + j * 512 + lane * 8; const f32x4 s0 = *(const f32x4*)s_, s1 = *(const f32x4*)(s_ + 4);
#pragma unroll
            for (int r = 0; r < RB; ++r) { float wf[8]; unpack8(wv[r][j], wf);
                a[r] += (wf[0] * s0[0] + wf[1] * s0[1]) + (wf[2] * s0[2] + wf[3] * s0[3]) + (wf[4] * s1[0] + wf[5] * s1[1]) + (wf[6] * s1[2] + wf[7] * s1[3]); } }
#pragma unroll
        for (int r = 0; r < RB; ++r) { const float t = wave_sum(a[r]); if (lane == 0) out0[q * NQ + r] = t; }
    }
}

#define BUILD_TABS(S_, RS_, BS_) do { LAS float* rt_ = (LAS float*)(lds + RSTD_LDS); LAS float* bt_ = (LAS float*)(lds + BIAS_LDS); pg8::Unit u_; \
        for (int i_ = (tid >> 8); S_.next(i_, u_); i_ += 2) { const int t_ = tid & 255; rt_[i_ * 256 + t_] = RS_(u_.pm * 256 + t_); bt_[i_ * 256 + t_] = BS_(u_, t_); } \
        __syncthreads(); } while (0)
__device__ __forceinline__ float bias_sum(const float* slab, int ncol, int col) { float t = slab[col];
#pragma unroll
    for (int q = 1; q < NKQ; ++q) t += slab[q * ncol + col];
    return t; }
#define RS_SSQ(r) rstd_from_ssq(SSQ, (r))
#define RS_X(r) RSTDX[(r)]

#define WPREP_JOBS(job_lo, job_hi, gwq, ngwq) do { LAS float* tab = (LAS float*)lds; \
                for (int job = (job_lo); job < (job_hi); ++job) { \
                    const int jl = (job == 0) ? 0 : 1; const bool isci = (job == 1); \
                    const float* gain_ = (isci ? args.in[IN_NMIX] : args.in[IN_NFFN]) + jl * D; const float* ad = ADA + jl * 3 * NQ + (isci ? 0 : 3 * D); \
                    __syncthreads(); \
                    for (int i = tid; i < 2 * D; i += NTHR) { const int b_ = i >> 10, k = i & (D - 1); tab[i] = gain_[k] * (1.0f + ad[b_ * NQ + D + k]); tab[2 * D + i] = ad[b_ * NQ + k]; } \
                    __syncthreads(); \
                    const int nnb = isci ? 48 : 88, ncol = isci ? 3072 : 5632; \
                    float* bslab = isci ? BIAS5 : BIAS3 + jl * 2 * NKQ * 5632; \
                    for (int it = (gwq); it < nnb * NKQ; it += (ngwq)) { const int nb = it / NKQ, kq = it % NKQ, np = nb * 64; f32x4 a0 = {0.f, 0.f, 0.f, 0.f}, a1 = a0; \
                        for (int kb = kq * (16 / NKQ); kb < (kq + 1) * (16 / NKQ); ++kb) { \
                            if (isci) tr64<true>(args.in[IN_WCI], 3072, D, WCI, WCI + (size_t)3072 * D, kb * 64, map_wci(np), np, tab, a0, a1, lane); \
                            else { const int tile = np >> 8, cp = np & 255; const float* src = (cp < 128 ? args.in[IN_W1] : args.in[IN_W3]) + (size_t)jl * D * FF; \
                                tr64<true>(src, FF, D, W13[jl], W13[jl] + (size_t)5632 * D, kb * 64, 128 * tile + (cp & 127), np, tab, a0, a1, lane); } } \
                        _Pragma("unroll") for (int e = 0; e < 4; ++e) { a0[e] += __shfl_xor(a0[e], 16); a0[e] += __shfl_xor(a0[e], 32); a1[e] += __shfl_xor(a1[e], 16); a1[e] += __shfl_xor(a1[e], 32); } \
                        if (lane < 16) { *(f32x4*)(bslab + (0 * NKQ + kq) * ncol + np + 4 * lane) = a0; *(f32x4*)(bslab + (1 * NKQ + kq) * ncol + np + 4 * lane) = a1; } \
                    } } \
                __syncthreads(); } while (0)

__global__ void __launch_bounds__(NTHR, 2) fwd_kernel(Args args) {
    extern __shared__ __attribute__((aligned(16))) unsigned char lds_raw[];
    LAS unsigned char* lds = (LAS unsigned char*)lds_raw;
    volatile LAS unsigned* MISC = (volatile LAS unsigned*)(lds + MISC_OFF);
    const int tid0 = threadIdx.x, wave = __builtin_amdgcn_readfirstlane(tid0 >> 6);
    const int G = gridDim.x, bx = blockIdx.x;
    const int vcu = (G % 8 == 0) ? (bx % 8) * (G / 8) + bx / 8 : bx;
    const int gw = vcu * NWAVES + wave, NGW = G * NWAVES;
    unsigned char* ws = args.ws;
    unsigned* ctl = (unsigned*)(ws + WS_CTL);
    float* ADA = (float*)(ws + CTL_ADA);
    float* ROPE = (float*)(ws + MS_ROPE); float* RSTDX = (float*)(ws + MS_RSTDX); float* RSTDC = (float*)(ws + MS_RSTDC);
    float* BIAS1 = (float*)(ws + MS_BIAS1); float* BIAS3 = (float*)(ws + MS_BIAS3); float* BIAS5 = (float*)(ws + MS_BIAS5);
    float* SSQ = (float*)(ws + WS_SSQ);
    bf16* WQKVG = (bf16*)(ws + WS_WQKVG); bf16* WO = (bf16*)(ws + WS_WO); bf16* WCI = (bf16*)(ws + WS_WCI); bf16* WCO = (bf16*)(ws + WS_WCO);
    bf16* W13[2] = {(bf16*)(ws + WS_W13_0), (bf16*)(ws + WS_W13_1)};
    bf16* XB = (bf16*)(ws + WS_XB); bf16* QB = (bf16*)(ws + WS_Q); bf16* KB = (bf16*)(ws + WS_K); bf16* VT = (bf16*)(ws + WS_VT);
    bf16* SFB = (bf16*)(ws + WS_SF); bf16* SBB = (bf16*)(ws + WS_SB); bf16* KC = (bf16*)(ws + WS_KC); bf16* VCT = (bf16*)(ws + WS_VCT); bf16* ACB = (bf16*)(ws + WS_ACB);
    bf16* HID = (bf16*)(ws + WS_HID); bf16* CU = (bf16*)(ws + WS_CU); bf16* CB = (bf16*)(ws + WS_CB); bf16* ACV = (bf16*)(ws + WS_ACV);
    bf16* GB = (bf16*)args.out;
    const float* x = args.in[IN_X];

    for (int u = tid0; u < (LDS_BYTES - 131072) / 4; u += NTHR) ((LAS unsigned*)(lds + 131072))[u] = 0u;
    __syncthreads();
    const bool multi = (args.ph_hi - args.ph_lo) > 1;
    XcdBarrier bar; bar.bar = ctl + CW_BAR; bar.x = 0; bar.st = nullptr;
    if (multi) bar = xcd_barrier_post(ctl + CW_BAR, MISC + 8);

#ifndef PROBE_DUP
#define PROBE_DUP -1
#endif
#ifndef SSVAR
#define SSVAR 0
#endif
    for (int ph0 = args.ph_lo; ph0 < args.ph_hi; ) {
        const int sq_ = ph0++; const int ph = (sq_ < 4) ? sq_ : (sq_ == 4 ? 13 : sq_ - 1); constexpr int rep = 0;
        const int tid = opaque((int)threadIdx.x), lane = tid & 63;
        switch (ph) {
        case 0: if (PHMASK & (1<<0)) {
            { LAS float* sl = (LAS float*)(lds + 131072); LAS f32x4* red = (LAS f32x4*)lds;
              for (int i = tid; i < 3 * D; i += NTHR) { const int r = i >> 10, k = i & (D - 1); sl[i] = siluf(r < 2 ? args.in[IN_C][r * D + k] : args.in[IN_CCTX][k]); }
              __syncthreads();
              for (int it = bx; it < 256; it += G) {
                  const int l = it >> 7, c0 = (it & 127) * 48, cg = tid % 12, kg = tid / 12;
                  if (tid < 504) {
                      const float* W = args.in[IN_ADAW] + (size_t)l * D * NQ + c0 + 4 * cg;
                      f32x4 a0 = {0.f, 0.f, 0.f, 0.f}, a1 = a0, a2 = a0;
#pragma unroll 5
                      for (int k = kg; k < D; k += 42) { const f32x4 w = *(const f32x4*)(W + (size_t)k * NQ); a0 += w * sl[k]; a1 += w * sl[D + k]; a2 += w * sl[2 * D + k]; }
                      red[(kg * 12 + cg) * 3 + 0] = a0; red[(kg * 12 + cg) * 3 + 1] = a1; red[(kg * 12 + cg) * 3 + 2] = a2;
                  }
                  __syncthreads();
                  if (tid < 36) { const int cg2 = tid / 3, r = tid % 3; f32x4 t = *(const f32x4*)(args.in[IN_ADAB] + l * NQ + c0 + 4 * cg2);
                      for (int q = 0; q < 42; ++q) t += red[(q * 12 + cg2) * 3 + r];
                      *(f32x4*)(ADA + (l * 3 + r) * NQ + c0 + 4 * cg2) = t; }
                  __syncthreads();
              }
            }
            { constexpr int I_QKVG = 16 * 96, I_WO = 32 * 16, I_W2 = 44 * 16, I_WCO = 16 * 16;
              constexpr int NIT = I_QKVG + I_WO + 2 * I_W2 + I_WCO;
              f32x4 d0, d1;
              for (int it = gw; it < NIT; it += NGW) {
                  int r = it;
                  if (r < I_QKVG) { const int kb = r / 96, nb = r % 96; tr64<false>(args.in[IN_WQKVG], NQ, D, WQKVG, nullptr, kb * 64, map_qkvg(nb * 64), nb * 64, nullptr, d0, d1, lane); continue; } r -= I_QKVG;
                  if (r < I_WO) { const int kb = r / 16, nb = r % 16; tr64<false>(args.in[IN_WO], D, 2048, WO, nullptr, kb * 64, nb * 64, nb * 64, nullptr, d0, d1, lane); continue; } r -= I_WO;
                  if (r < 2 * I_W2) { const int l = r / I_W2; r %= I_W2; const int kb = r / 16, nb = r % 16;
                      tr64<false>(args.in[IN_W2] + (size_t)l * FF * D, D, FF, (bf16*)(ws + (l ? WS_W2_1 : WS_W2_0)), nullptr, kb * 64, nb * 64, nb * 64, nullptr, d0, d1, lane); continue; } r -= 2 * I_W2;
                  { const int kb = r / 16, nb = r % 16; tr64<false>(args.in[IN_WCO], D, D, WCO, nullptr, kb * 64, nb * 64, nb * 64, nullptr, d0, d1, lane); }
              }
            }
        } break;
        case 1: if (PHMASK & (1<<1)) {
            const float* gain = args.in[IN_NMIX];
            const bool hasctx = vcu < 192;
            const bool isv = vcu >= 64; const int tl = isv ? vcu - 64 : vcu, rb = tl & 7, cbk = tl >> 3, row0 = 64 * rb, col0 = 128 * cbk;
            const int wt0 = (isv ? 4096 : 1024) + col0;
            if (hasctx) {
                LAS float* wt_ = (LAS float*)lds; LAS float* sh_ = wt_ + D; LAS float* rs_ = (LAS float*)(lds + 8192); LAS float* bs_ = rs_ + 64;
                LAS unsigned char* abuf = lds + 16384; LAS unsigned char* bbuf = lds + 16384 + 2 * 9216;
                for (int k = tid; k < D; k += NTHR) { wt_[k] = gain[k] * (1.0f + ADA[2 * NQ + D + k]); sh_[k] = ADA[2 * NQ + k]; }
                __syncthreads();
                const int arow = tid >> 3, aseg = tid & 7, brow = tid >> 2, bseg = tid & 3;
                const float* ap = args.in[IN_CTX] + (size_t)(row0 + arow) * D + 8 * aseg; const bf16* bp = WQKVG + (size_t)(wt0 + brow) * D + 16 * bseg;
                const int w4 = wave & 3, wr2 = wave >> 2, fr = lane & 15, fq = lane >> 4;
                const unsigned awr = (unsigned)(arow * 144 + aseg * 16), bwr = (unsigned)(brow * 144 + bseg * 32);
                const unsigned ard = (unsigned)((32 * wr2 + fr) * 144 + fq * 16), brd = (unsigned)((32 * w4 + fr) * 144 + fq * 16);
                f32x4 a_r[2][2]; u32x4 b_r[2][2]; float ssq = 0.f, bsum = 0.f;
                f32x4 acc[2][2];
#pragma unroll
                for (int m = 0; m < 2; ++m)
#pragma unroll
                    for (int n = 0; n < 2; ++n) acc[m][n] = (f32x4){0.f, 0.f, 0.f, 0.f};
#pragma unroll
                for (int c = 0; c < 2; ++c) { a_r[c][0] = *(const f32x4*)(ap + 64 * c); a_r[c][1] = *(const f32x4*)(ap + 64 * c + 4); b_r[c][0] = *(const u32x4*)(bp + 64 * c); b_r[c][1] = *(const u32x4*)(bp + 64 * c + 8); }
#pragma unroll 1
                for (int c2 = 0; c2 < 16; c2 += 2)
#pragma unroll
                for (int cur = 0; cur < 2; ++cur) { const int c = c2 + cur;
                    { const int k0 = 64 * c + 8 * aseg; const f32x4 w0 = *(const LAS f32x4*)(wt_ + k0), w1 = *(const LAS f32x4*)(wt_ + k0 + 4); const f32x4 x0 = a_r[cur][0], x1 = a_r[cur][1];
                      ssq += (x0[0] * x0[0] + x0[1] * x0[1]) + (x0[2] * x0[2] + x0[3] * x0[3]) + (x1[0] * x1[0] + x1[1] * x1[1]) + (x1[2] * x1[2] + x1[3] * x1[3]);
                      *(LAS u32x4*)(abuf + cur * 9216 + awr) = pack8(x0 * w0, x1 * w1); }
                    { const int kb = 64 * c + 16 * bseg;
#pragma unroll
                      for (int h = 0; h < 2; ++h) { float f[8]; unpack8(b_r[cur][h], f); const f32x4 s0 = *(const LAS f32x4*)(sh_ + kb + 8 * h), s1 = *(const LAS f32x4*)(sh_ + kb + 8 * h + 4);
                          bsum += (f[0] * s0[0] + f[1] * s0[1]) + (f[2] * s0[2] + f[3] * s0[3]) + (f[4] * s1[0] + f[5] * s1[1]) + (f[6] * s1[2] + f[7] * s1[3]);
                          *(LAS u32x4*)(bbuf + cur * 18432 + bwr + 16 * h) = b_r[cur][h]; } }
                    if (c + 2 < 16) { a_r[cur][0] = *(const f32x4*)(ap + 64 * (c + 2)); a_r[cur][1] = *(const f32x4*)(ap + 64 * (c + 2) + 4); b_r[cur][0] = *(const u32x4*)(bp + 64 * (c + 2)); b_r[cur][1] = *(const u32x4*)(bp + 64 * (c + 2) + 8); }
                    __syncthreads();
#pragma unroll
                    for (int ks = 0; ks < 2; ++ks) { bf16x8 af[2], bfg[2];
#pragma unroll
                        for (int m = 0; m < 2; ++m) af[m] = *(const LAS bf16x8*)(abuf + cur * 9216 + ard + m * (16 * 144) + ks * 64);
#pragma unroll
                        for (int n = 0; n < 2; ++n) bfg[n] = *(const LAS bf16x8*)(bbuf + cur * 18432 + brd + n * (16 * 144) + ks * 64);
#pragma unroll
                        for (int m = 0; m < 2; ++m)
#pragma unroll
                            for (int n = 0; n < 2; ++n) acc[m][n] = isv ? __builtin_amdgcn_mfma_f32_16x16x32_bf16(af[m], bfg[n], acc[m][n], 0, 0, 0) : __builtin_amdgcn_mfma_f32_16x16x32_bf16(bfg[n], af[m], acc[m][n], 0, 0, 0); }
                }
                { float t = ssq; t += __shfl_xor(t, 1); t += __shfl_xor(t, 2); t += __shfl_xor(t, 4); if (aseg == 0) rs_[arow] = 1.0f / sqrtf(t * (1.0f / D) + EPS);
                  float u_ = bsum; u_ += __shfl_xor(u_, 1); u_ += __shfl_xor(u_, 2); if (bseg == 0) bs_[brow] = u_; }
                __syncthreads();
                const int b = rb >> 2;
                if (!isv) {
#pragma unroll
                    for (int m = 0; m < 2; ++m) { const int rl = 32 * wr2 + 16 * m + fr; const float rsd = rs_[rl];
#pragma unroll
                        for (int n = 0; n < 2; ++n) { const int cl = 32 * w4 + 16 * n + 4 * fq; const f32x4 bb = *(const LAS f32x4*)(bs_ + cl);
                            const f32x4 o = (acc[m][n] * rsd + bb) * 0.0625f;
                            u32x2 w; w.x = pk2(o[0], o[1]); w.y = pk2(o[2], o[3]); *(u32x2*)(KC + (size_t)(row0 + rl) * D + col0 + cl) = w; } }
                } else {
#pragma unroll
                    for (int m = 0; m < 2; ++m) { const int tl0 = 32 * wr2 + 16 * m + 4 * fq; const f32x4 rs = *(const LAS f32x4*)(rs_ + tl0);
#pragma unroll
                        for (int n = 0; n < 2; ++n) { const int cl = 32 * w4 + 16 * n + fr, c = col0 + cl, h = c >> 9, e = c & 511; const f32x4 o = acc[m][n] * rs + bs_[cl];
                            u32x2 w; w.x = pk2(o[0], o[1]); w.y = pk2(o[2], o[3]); *(u32x2*)(VCT + (size_t)((b * NH + h) * DV + e) * CTXL + ((row0 + tl0) & (CTXL - 1))) = w; } }
                }
                biasrows<4>(WQKVG + (size_t)(4 * (vcu * 8 + wave)) * D, ADA, 0, 2, BIAS1 + 4 * (vcu * 8 + wave), lane);
            } else {
                const int wk = (vcu - 192) * 8 + wave, NWK = (G - 192) * 8;
                for (int r = 4 * wk; r < P1_R1; r += 4 * NWK) modrows<4>(x + (size_t)r * D, gain, ADA + (r >> 13) * NQ + D, XB + (size_t)r * D, RSTDX + r, lane);
            }
            { const int r = P1_R1 + 4 * (vcu * 8 + wave); modrows<4>(x + (size_t)r * D, gain, ADA + (r >> 13) * NQ + D, XB + (size_t)r * D, RSTDX + r, lane); }
            if constexpr (P1_RW > 4) { const int r = P1_R1 + 8192 + (P1_RW - 4) * (vcu * 8 + wave); modrows<P1_RW - 4>(x + (size_t)r * D, gain, ADA + (r >> 13) * NQ + D, XB + (size_t)r * D, RSTDX + r, lane); }
        } break;
        case 2: if (PHMASK & (1<<2)) {
            if (G1SEL & 1) { pg8::Gemm g{XB, WQKVG, M, 4096, D, 0}; pg8::StaticOrder S; S.init(M, 4096, G, bx);
              EpiQKG E{QB, KB, GB, RSTDX, BIAS1};
              pg8::gemm_phase<EpiQKG, pg8::StaticOrder, true, true, false>(lds, g, S, E, tid); }
            { pg8::Gemm g{XB, WQKVG + (size_t)4096 * D, M, 2048, D, 0}; pg8::StaticOrder S; S.init(M, 2048, G, bx);
              EpiVT E{VT, RSTDX, BIAS1 + 4096, SEQ, 32, -1};
              pg8::gemm_phase<EpiVT, pg8::StaticOrder, true, true, true>(lds, g, S, E, tid); }
        } break;
        case 3: if (PHMASK & (1<<3)) {
            constexpr int KP = 136, BUFB = (64 + 64 + 128) * KP * 2, NST = 34;
            static_assert(2 * BUFB <= MISC_OFF, "SS LDS map");
            for (int u = bx; u < 256; u += G) {
                const int grp = u & 1, bh = (u >> 1) & 7, dkt = (u >> 4) & 3, dvt = u >> 6, b = bh >> 2, h = bh & 3, dk0 = 64 * dkt, dv0 = 128 * dvt;
                const float lgf = __builtin_amdgcn_logf(1.0f - __builtin_amdgcn_exp2f(-5.0f - (float)h)), lgb = __builtin_amdgcn_logf(1.0f - __builtin_amdgcn_exp2f(-5.5f - (float)h));
                __syncthreads();
#define SS_DEC(s_) const bool ic_ = grp ? ((s_) >= 32) : ((s_) < 2); const int c_ = ic_ ? (grp ? (s_) - 32 : (s_)) : (grp ? 32 + (s_) : (s_) - 2); const int q_ = ic_ ? c_ : (c_ & 3), nq_ = ic_ ? 2 : 4
                if (wave >= 4) {
                    const int pt = tid - 256;
                    float wKf[4], wKb[4];
#pragma unroll
                    for (int p = 0; p < 4; ++p) { const int t = 4 * (pt >> 3) + p; wKf[p] = __builtin_amdgcn_exp2f((float)(127 - t) * lgf); wKb[p] = __builtin_amdgcn_exp2f((float)t * lgb); }
                    u32x4 kr0[4], vr0[8], kr1[4], vr1[8], kr2[4], vr2[8];
#define SSP_LOAD(step, kr, vr) do { const int s_ = (step); SS_DEC(s_); (void)q_; (void)nq_; const int t_ = opaque(pt); \
                        const bf16* ks_ = (ic_ ? KC + (size_t)(b * CTXL + c_ * 128) * D : KB + (size_t)(b * SEQ + c_ * 128) * D) + h * DK + dk0; \
                        const int ld_ = ic_ ? CTXL : 128; const bf16* vs_ = ic_ ? VCT + (size_t)(bh * DV + dv0) * CTXL + c_ * 128 : VT + ((size_t)((bh * 64 + c_) * DV + dv0)) * 128; \
                        _Pragma("unroll") for (int p = 0; p < 4; ++p) kr[p] = *(const u32x4*)(ks_ + (unsigned)((4 * (t_ >> 3) + p) * D + 8 * (t_ & 7))); \
                        _Pragma("unroll") for (int q = 0; q < 8; ++q) vr[q] = *(const u32x4*)(vs_ + (unsigned)(((t_ >> 4) + 16 * q) * ld_ + 8 * (t_ & 15))); } while (0)
#define SSP_WRITE(step, kr, vr) do { const int sw_ = (step); SS_DEC(sw_); (void)c_; LAS bf16* kf_ = (LAS bf16*)(lds + (sw_ & 1) * BUFB); LAS bf16* kb_ = kf_ + 64 * KP; LAS bf16* vt_ = kb_ + 64 * KP; const int t_ = opaque(pt); \
                        const float cf_ = __builtin_amdgcn_exp2f((float)(128 * (nq_ - 1 - q_)) * lgf), cb_ = __builtin_amdgcn_exp2f((float)(128 * q_) * lgb); \
                        { float f0_[8], f1_[8], f2_[8], f3_[8]; unpack8(kr[0], f0_); unpack8(kr[1], f1_); unpack8(kr[2], f2_); unpack8(kr[3], f3_); \
                          const int c8_ = t_ & 7, tg_ = t_ >> 3, pos_ = (((tg_ >> 1) ^ c8_) << 3) | (4 * (tg_ & 1)); \
                          const float wf0_ = wKf[0] * cf_, wf1_ = wKf[1] * cf_, wf2_ = wKf[2] * cf_, wf3_ = wKf[3] * cf_, wb0_ = wKb[0] * cb_, wb1_ = wKb[1] * cb_, wb2_ = wKb[2] * cb_, wb3_ = wKb[3] * cb_; \
                          _Pragma("unroll") for (int e = 0; e < 8; ++e) { u32x2 wf_, wb_; wf_.x = pk2(f0_[e] * wf0_, f1_[e] * wf1_); wf_.y = pk2(f2_[e] * wf2_, f3_[e] * wf3_); wb_.x = pk2(f0_[e] * wb0_, f1_[e] * wb1_); wb_.y = pk2(f2_[e] * wb2_, f3_[e] * wb3_); \
                              *(LAS u32x2*)(kf_ + (8 * c8_ + e) * KP + pos_) = wf_; *(LAS u32x2*)(kb_ + (8 * c8_ + e) * KP + pos_) = wb_; } } \
                        _Pragma("unroll") for (int q = 0; q < 8; ++q) *(LAS u32x4*)(vt_ + ((t_ >> 4) + 16 * q) * KP + 8 * (t_ & 15)) = vr[q]; } while (0)
#define SSP_STEP(s, krN, vrN, krF, vrF) do { const int s__ = (s); if (s__ < NST) { if (s__ + 3 <= NST - 1) SSP_LOAD(s__ + 3, krF, vrF); if (s__ + 1 <= NST - 1) SSP_WRITE(s__ + 1, krN, vrN); __syncthreads(); } } while (0)
                    SSP_LOAD(0, kr0, vr0); SSP_LOAD(1, kr1, vr1); SSP_LOAD(2, kr2, vr2); SSP_WRITE(0, kr0, vr0); __syncthreads();
                    for (int s3 = 0; s3 < NST; s3 += 3) { SSP_STEP(s3, kr1, vr1, kr0, vr0); SSP_STEP(s3 + 1, kr2, vr2, kr1, vr1); SSP_STEP(s3 + 2, kr0, vr0, kr2, vr2); }
#undef SSP_LOAD
#undef SSP_WRITE
#undef SSP_STEP
                } else {
                    const int wr = wave >> 1, wc = wave & 1, fr = lane & 15, fq = lane >> 4;
                    f32x4 accf[2][4], accb[2][4];
#pragma unroll
                    for (int i = 0; i < 2; ++i)
#pragma unroll
                        for (int j = 0; j < 4; ++j) { accf[i][j] = (f32x4){0.f, 0.f, 0.f, 0.f}; accb[i][j] = (f32x4){0.f, 0.f, 0.f, 0.f}; }
                    __syncthreads();
                    for (int s = 0; s < NST; ++s) {
                        { const LAS bf16* kf = (const LAS bf16*)(lds + (s & 1) * BUFB); const LAS bf16* kb = kf + 64 * KP; const LAS bf16* vt = kb + 64 * KP;
#pragma unroll
                          for (int ks = 0; ks < 4; ++ks) { bf16x8 XF[2], XB_[2], Y[4];
#pragma unroll
                              for (int i = 0; i < 2; ++i) { const int o_ = (32 * wr + 16 * i + fr) * KP + (((4 * ks + fq) ^ (4 * wr + 2 * i + (fr >> 3))) & 7) * 8 + 64 * (ks >> 1);
                                  XF[i] = *(const LAS bf16x8*)(kf + o_); XB_[i] = *(const LAS bf16x8*)(kb + o_); }
#pragma unroll
                              for (int j = 0; j < 4; ++j) Y[j] = *(const LAS bf16x8*)(vt + (64 * wc + 16 * j + fr) * KP + 32 * ks + 8 * fq);
#pragma unroll
                              for (int i = 0; i < 2; ++i)
#pragma unroll
                                  for (int j = 0; j < 4; ++j) { accf[i][j] = __builtin_amdgcn_mfma_f32_16x16x32_bf16(XF[i], Y[j], accf[i][j], 0, 0, 0); accb[i][j] = __builtin_amdgcn_mfma_f32_16x16x32_bf16(XB_[i], Y[j], accb[i][j], 0, 0, 0); } } }
                        __syncthreads();
                        SS_DEC(s);
                        if (q_ == nq_ - 1) {
                            const int sc = c_ >> 2;
                            const int fslot = ic_ ? (grp ? -1 : 0) : (sc + 1 <= 15 ? sc + 1 : -1), bslot = ic_ ? (grp ? 15 : -1) : sc - 1;
                            const size_t eo = (size_t)(dv0 + 64 * wc + fr) * DK + dk0 + 32 * wr + 4 * fq;
                            if (fslot >= 0) { bf16* dst = SFB + (size_t)(bh * NSC + fslot) * DV * DK + eo;
#pragma unroll
                                for (int i = 0; i < 2; ++i)
#pragma unroll
                                    for (int j = 0; j < 4; ++j) { u32x2 w; w.x = pk2(accf[i][j][0], accf[i][j][1]); w.y = pk2(accf[i][j][2], accf[i][j][3]); *(u32x2*)(dst + (size_t)(16 * j) * DK + 16 * i) = w; } }
                            if (bslot >= 0) { bf16* dst = SBB + (size_t)(bh * NSC + bslot) * DV * DK + eo;
#pragma unroll
                                for (int i = 0; i < 2; ++i)
#pragma unroll
                                    for (int j = 0; j < 4; ++j) { u32x2 w; w.x = pk2(accb[i][j][0], accb[i][j][1]); w.y = pk2(accb[i][j][2], accb[i][j][3]); *(u32x2*)(dst + (size_t)(16 * j) * DK + 16 * i) = w; } }
#pragma unroll
                            for (int i = 0; i < 2; ++i)
#pragma unroll
                                for (int j = 0; j < 4; ++j) { accf[i][j] = (f32x4){0.f, 0.f, 0.f, 0.f}; accb[i][j] = (f32x4){0.f, 0.f, 0.f, 0.f}; }
                        }
                    }
                }
#undef SS_DEC
            }
        } break;
        case 4: if (PHMASK & (1<<4)) {
            constexpr int SLOT = 40960, PBUF = 3 * SLOT, REDB = PBUF + 32768;
            static_assert(REDB + 2048 <= MISC_OFF, "B' LDS map");
            const int wr = wave >> 2, wc = wave & 3;
#define BP_WAITV(n) do { switch (n) { case 0: asm volatile("s_waitcnt vmcnt(0)" ::: "memory"); break; case 4: asm volatile("s_waitcnt vmcnt(4)" ::: "memory"); break; \
                    case 5: asm volatile("s_waitcnt vmcnt(5)" ::: "memory"); break; default: asm volatile("s_waitcnt vmcnt(0)" ::: "memory"); break; } } while (0)
#define BP_GLDS(srcp, dstoff) __builtin_amdgcn_global_load_lds((const unsigned*)(srcp), (LAS unsigned*)(lds + (dstoff)), 16, 0, 0)
            for (int unit = vcu; unit < 512; unit += G) {
                const int bh = unit >> 6, c = unit & 63, b = bh >> 2, h = bh & 3, sc = c >> 2, cq = c & 3;
                const float lgf = __builtin_amdgcn_logf(1.0f - __builtin_amdgcn_exp2f(-5.0f - (float)h)), lgb = __builtin_amdgcn_logf(1.0f - __builtin_amdgcn_exp2f(-5.5f - (float)h));
                const bf16* Qsrc = QB + (size_t)(b * SEQ + c * 128) * D + h * DK;
                const bf16* Ksrc = KB + (size_t)(b * SEQ + sc * SC) * D + h * DK;
                const bf16* SFsrc = SFB + (size_t)((bh * NSC + sc) * DV) * DK; const bf16* SBsrc = SBB + (size_t)((bh * NSC + sc) * DV) * DK;
                const bf16* Vsrc = VT + (size_t)((bh * 64 + sc * 4) * DV) * 128;
                f32x4 acc[4][8], sacc[4][2];
#pragma unroll
                for (int m = 0; m < 4; ++m)
#pragma unroll
                    for (int n = 0; n < 8; ++n) acc[m][n] = (f32x4){0.f, 0.f, 0.f, 0.f};
#define BP_ISSUE(idx) do { const int i_ = (idx); const int so_ = (i_ % 3) * SLOT; const int l_ = opaque(lane); \
                    if (i_ < 16) { const int s_ = i_ & 7; const bf16* bs_ = (i_ < 8 ? SFsrc : SBsrc) + 32 * s_; const int rr_ = l_ >> 2, ch_ = (l_ & 3) ^ ((l_ >> 4) & 3); \
                        BP_GLDS(Qsrc + (unsigned)((16 * wave + rr_) * D + 32 * s_ + 8 * ch_), so_ + wave * 1024); \
                        _Pragma("unroll") for (int q = 0; q < 4; ++q) BP_GLDS(bs_ + (unsigned)((16 * (wave + 8 * q) + rr_) * DK + 8 * ch_), so_ + 8192 + (wave + 8 * q) * 1024); } \
                    else { const int j_ = (i_ - 16) >> 3, r8_ = (i_ - 16) & 7; \
                        if (r8_ < 4) { const int rr_ = l_ >> 3, ch_ = (l_ & 7) ^ ((l_ >> 4) & 3) ^ (4 * (wave & 1)); \
                            _Pragma("unroll") for (int q = 0; q < 2; ++q) { const int row_ = 8 * (wave + 8 * q) + rr_; \
                                BP_GLDS(Qsrc + (unsigned)(row_ * D + 64 * r8_ + 8 * ch_), so_ + (wave + 8 * q) * 1024); \
                                BP_GLDS(Ksrc + (unsigned)((128 * j_ + row_) * D + 64 * r8_ + 8 * ch_), so_ + 16384 + (wave + 8 * q) * 1024); } } \
                        else { const int rr_ = l_ >> 2, ch_ = (l_ & 3) ^ ((l_ >> 4) & 3); const bf16* bs_ = Vsrc + (size_t)j_ * (DV * 128) + 32 * (r8_ - 4); \
                            _Pragma("unroll") for (int q = 0; q < 4; ++q) BP_GLDS(bs_ + (unsigned)((16 * (wave + 8 * q) + rr_) * 128 + 8 * ch_), so_ + 8192 + (wave + 8 * q) * 1024); } } } while (0)
#define BP_NLOADS(idx) (((idx) >= 48) ? 0 : ((idx) < 16 ? 5 : 4))
#define BP_TOP(idx) do { BP_WAITV(BP_NLOADS((idx) + 1)); asm volatile("s_waitcnt lgkmcnt(0)" ::: "memory"); __builtin_amdgcn_s_barrier(); asm volatile("" ::: "memory"); \
                    if ((idx) + 2 < 48) BP_ISSUE((idx) + 2); } while (0)
#define BP_MMA_FULL(AADDR, so) do { bf16x8 af_[4]; const int l_ = opaque(lane), fr = l_ & 15, fq = l_ >> 4; \
                    _Pragma("unroll") for (int m = 0; m < 4; ++m) af_[m] = *(const LAS bf16x8*)(lds + AADDR(64 * wr + 16 * m + fr, fr, fq)); \
                    _Pragma("unroll") for (int nh = 0; nh < 4; ++nh) { bf16x8 bf_[2]; \
                        _Pragma("unroll") for (int n = 0; n < 2; ++n) bf_[n] = *(const LAS bf16x8*)(lds + (so) + 8192 + (128 * wc + 32 * nh + 16 * n + fr) * 64 + ((fq ^ (fr >> 2)) & 3) * 16); \
                        _Pragma("unroll") for (int m = 0; m < 4; ++m) _Pragma("unroll") for (int n = 0; n < 2; ++n) \
                            acc[m][2 * nh + n] = __builtin_amdgcn_mfma_f32_16x16x32_bf16(bf_[n], af_[m], acc[m][2 * nh + n], 0, 0, 0); } } while (0)
                __builtin_amdgcn_s_barrier();
                BP_ISSUE(0); BP_ISSUE(1);
                for (int idx = 0; idx < 16; ++idx) {
                    BP_TOP(idx);
                    const int so = (idx % 3) * SLOT;
#define AADDR_X(row, fr, fq) (so + (row) * 64 + (((fq) ^ ((fr) >> 2)) & 3) * 16)
                    BP_MMA_FULL(AADDR_X, so);
#undef AADDR_X
                    if (idx == 7 || idx == 15) { const int fr = opaque(lane) & 15;
#pragma unroll
                        for (int m = 0; m < 4; ++m) { const int il = 128 * cq + 64 * wr + 16 * m + fr;
                            const float sc_ = (idx == 7) ? __builtin_amdgcn_exp2f((float)(il + 1) * lgf - (float)(SC - il) * lgb) : __builtin_amdgcn_exp2f((float)(SC - il) * lgb);
#pragma unroll
                            for (int n = 0; n < 8; ++n) acc[m][n] *= sc_; }
                    }
                }
                for (int j = 0; j < 4; ++j) {
#pragma unroll
                    for (int m = 0; m < 4; ++m) { sacc[m][0] = (f32x4){0.f, 0.f, 0.f, 0.f}; sacc[m][1] = (f32x4){0.f, 0.f, 0.f, 0.f}; }
                    for (int r = 0; r < 4; ++r) {
                        const int idx = 16 + 8 * j + r;
                        BP_TOP(idx);
                        const int so = (idx % 3) * SLOT;
                        { const int l_ = opaque(lane), fr = l_ & 15, fq = l_ >> 4;
#pragma unroll
                          for (int ks = 0; ks < 2; ++ks) { bf16x8 af_[4], kf_[2]; const int cx = ((4 * ks + fq) ^ (fr >> 1)) & 7;
#pragma unroll
                              for (int m = 0; m < 4; ++m) af_[m] = *(const LAS bf16x8*)(lds + so + (64 * wr + 16 * m + fr) * 128 + cx * 16);
#pragma unroll
                              for (int n = 0; n < 2; ++n) kf_[n] = *(const LAS bf16x8*)(lds + so + 16384 + (32 * wc + 16 * n + fr) * 128 + cx * 16);
#pragma unroll
                              for (int m = 0; m < 4; ++m)
#pragma unroll
                                  for (int n = 0; n < 2; ++n) sacc[m][n] = __builtin_amdgcn_mfma_f32_16x16x32_bf16(kf_[n], af_[m], sacc[m][n], 0, 0, 0); } }
                        if (r == 3) {
                            const int l_ = opaque(lane), fr = l_ & 15, fq = l_ >> 4;
#pragma unroll
                            for (int m = 0; m < 4; ++m)
#pragma unroll
                                for (int n = 0; n < 2; ++n) { const int il = 128 * cq + 64 * wr + 16 * m + fr, jl0 = 128 * j + 32 * wc + 16 * n + 4 * fq; float pv[4];
#pragma unroll
                                    for (int e = 0; e < 4; ++e) { const int dl = il - (jl0 + e);
                                        const float dec = dl > 0 ? __builtin_amdgcn_exp2f((float)dl * lgf) : (dl < 0 ? __builtin_amdgcn_exp2f((float)(-dl) * lgb) : 2.0f); pv[e] = sacc[m][n][e] * dec; }
                                    u32x2 w; w.x = pk2(pv[0], pv[1]); w.y = pk2(pv[2], pv[3]);
                                    *(LAS u32x2*)(lds + PBUF + (64 * wr + 16 * m + fr) * 256 + (((4 * wc + 2 * n + (fq >> 1)) ^ fr) & 15) * 16 + (fq & 1) * 8) = w; }
                        }
                    }
                    for (int r = 0; r < 4; ++r) {
                        const int idx = 16 + 8 * j + 4 + r;
                        BP_TOP(idx);
                        const int so = (idx % 3) * SLOT;
#define AADDR_P(row, fr, fq) (PBUF + (row) * 256 + (((4 * r + (fq)) ^ (fr)) & 15) * 16)
                        BP_MMA_FULL(AADDR_P, so);
#undef AADDR_P
                    }
                }
                asm volatile("s_waitcnt vmcnt(0) lgkmcnt(0)" ::: "memory"); __builtin_amdgcn_s_barrier(); asm volatile("" ::: "memory");
                { LAS float* red = (LAS float*)(lds + REDB); const int l_ = opaque(lane), fr = l_ & 15, fq = l_ >> 4;
#pragma unroll
                  for (int m = 0; m < 4; ++m) { float ss = 0.f;
#pragma unroll
                      for (int n = 0; n < 8; ++n) ss += (acc[m][n][0] * acc[m][n][0] + acc[m][n][1] * acc[m][n][1]) + (acc[m][n][2] * acc[m][n][2] + acc[m][n][3] * acc[m][n][3]);
                      ss += __shfl_xor(ss, 16); ss += __shfl_xor(ss, 32);
                      if (fq == 0) red[(64 * wr + 16 * m + fr) * 4 + wc] = ss; }
                  __syncthreads();
                  bf16* gp0 = GB + (size_t)(b * SEQ + c * 128 + 64 * wr + fr) * 2048 + h * DV + 128 * wc + 4 * fq;
#pragma unroll
                  for (int mh = 0; mh < 4; mh += 2) {
                      u32x2 gw[2][8];
#pragma unroll
                      for (int q = 0; q < 2; ++q)
#pragma unroll
                          for (int n = 0; n < 8; ++n) gw[q][n] = *(const u32x2*)(gp0 + (size_t)(16 * (mh + q)) * 2048 + 16 * n);
#pragma unroll
                      for (int q = 0; q < 2; ++q) { const int m = mh + q, row = 64 * wr + 16 * m + fr; const f32x4 t4 = *(const LAS f32x4*)(red + row * 4);
                          const float rs = 1.0f / sqrtf(((t4[0] + t4[1]) + (t4[2] + t4[3])) * (1.0f / DV) + EPS);
                          bf16* gp = gp0 + (size_t)(16 * m) * 2048;
#pragma unroll
                          for (int n = 0; n < 8; ++n) {
                              const float o0 = siluf(bflo(gw[q][n].x)) * acc[m][n][0] * rs, o1 = siluf(bfhi(gw[q][n].x)) * acc[m][n][1] * rs, o2 = siluf(bflo(gw[q][n].y)) * acc[m][n][2] * rs, o3 = siluf(bfhi(gw[q][n].y)) * acc[m][n][3] * rs;
                              u32x2 w; w.x = pk2(o0, o1); w.y = pk2(o2, o3); if (!(PROBE_DUP == 4 && rep == 1)) *(u32x2*)(gp + 16 * n) = w; } } }
                  __syncthreads();
                }
            }
#undef BP_WAITV
#undef BP_GLDS
#undef BP_ISSUE
#undef BP_NLOADS
#undef BP_TOP
#undef BP_MMA_FULL
        } break;
        case 5: case 7: case 10: case 12: if (PHMASK & (1<<5)) {
            const int l = (ph >= 10) ? 1 : 0; const float* adal = ADA + l * 3 * NQ;
            if (ph == 5) WPREP_JOBS(0, 1, gw, NGW);
            pg8::StaticOrder S; S.init(M, D, G, bx);
            if (ph == 12) {
                pg8::Gemm g{HID, (const bf16*)(ws + WS_W2_1), M, D, FF, 0};
                EpiResFinal E{XB, args.out, adal + 5 * D, args.in[IN_FN], (float*)(ws + MS_XPART), ctl, lds + RSTD_LDS};
                pg8::gemm_phase<EpiResFinal, pg8::StaticOrder, true, true, false>(lds, g, S, E, tid);
            } else {
                pg8::Gemm g; EpiRes E;
                if (ph == 5) { g = pg8::Gemm{GB, WO, M, D, 2048, 0}; E = EpiRes{x, nullptr, XB, adal + 2 * D, SSQ, 0}; }
                else if (ph == 7) { g = pg8::Gemm{HID, (const bf16*)(ws + WS_W2_0), M, D, FF, 0}; E = EpiRes{nullptr, XB, XB, adal + 5 * D, SSQ, 0}; }
                else { g = pg8::Gemm{ACV, WCO, M, D, D, 0}; E = EpiRes{nullptr, XB, XB, adal + 2 * D, SSQ, 0}; }
                E.dry = (PROBE_DUP == ph && rep == 1) ? 1 : 0;
                pg8::gemm_phase<EpiRes, pg8::StaticOrder, true, true, false>(lds, g, S, E, tid);
            }
        } break;
        case 6: case 11: if (PHMASK & (1<<6)) {
            const int l = (ph == 11) ? 1 : 0;
            pg8::Gemm g{XB, W13[l], M, 5632, D, (size_t)5632 * D * 2}; pg8::StaticOrder S; S.init(M, 5632, G, bx);
#define BS_FFN(u, t) bias_sum(BIAS3 + (l * 2 + ((u).pm >> 5)) * NKQ * 5632, 5632, (u).pn * 256 + (t))
            BUILD_TABS(S, RS_SSQ, BS_FFN);
#undef BS_FFN
            EpiSwiGLU E{HID, (const LAS float*)(lds + RSTD_LDS), (const LAS float*)(lds + BIAS_LDS), (PROBE_DUP == ph && rep == 1 && SSVAR == 21) ? 1 : 0};
            pg8::gemm_phase<EpiSwiGLU, pg8::StaticOrder, true, true, false>(lds, g, S, E, tid);
            if (ph == 6 && bx >= 128) WPREP_JOBS(1, 3, (bx - 128) * NWAVES + wave, (G - 128) * NWAVES);
        } break;
        case 8: if (PHMASK & (1<<8)) {
            pg8::Gemm g{XB, WCI, M, 3072, D, (size_t)3072 * D * 2}; pg8::StaticOrder S; S.init(M, 3072, G, bx);
#define BS_CI(u, t) bias_sum(BIAS5 + ((u).pm >> 5) * NKQ * 3072, 3072, (u).pn * 256 + (t))
            BUILD_TABS(S, RS_SSQ, BS_CI);
#undef BS_CI
            EpiConvIn E{CU, CB, (const LAS float*)(lds + RSTD_LDS), (const LAS float*)(lds + BIAS_LDS)};
            pg8::gemm_phase<EpiConvIn, pg8::StaticOrder, true, true, false>(lds, g, S, E, tid);
        } break;
        case 9: if (PHMASK & (1<<9)) {
            const float* cw = args.in[IN_CW];
            for (int it = bx * NTHR + tid; it < M * (D / 8); it += G * NTHR) {
                const int r = it >> 7, k = (it & 127) * 8, t = r & (SEQ - 1);
                float u0[8], um[8], up[8], bb[8];
                unpack8(*(const u32x4*)(CU + (size_t)r * D + k), u0); unpack8(*(const u32x4*)(CB + (size_t)r * D + k), bb);
                if (t > 0) unpack8(*(const u32x4*)(CU + (size_t)(r - 1) * D + k), um); else { for (int q = 0; q < 8; ++q) um[q] = 0.f; }
                if (t < SEQ - 1) unpack8(*(const u32x4*)(CU + (size_t)(r + 1) * D + k), up); else { for (int q = 0; q < 8; ++q) up[q] = 0.f; }
                float o[8];
#pragma unroll
                for (int q = 0; q < 8; ++q) o[q] = bb[q] * (cw[k + q] * um[q] + cw[D + k + q] * u0[q] + cw[2 * D + k + q] * up[q]);
                u32x4 w; w.x = pk2(o[0], o[1]); w.y = pk2(o[2], o[3]); w.z = pk2(o[4], o[5]); w.w = pk2(o[6], o[7]);
                *(u32x4*)(ACV + (size_t)r * D + k) = w;
            }
        } break;
        case 13: if (PHMASK & (1<<13)) {
            for (int v = bx * NTHR + tid; v < 2 * 131072; v += G * NTHR) {
                const int dir = v >> 17, w = v & 131071, bh_ = w >> 14, h = bh_ & 3;
                bf16* base = (dir ? SBB : SFB) + (size_t)bh_ * NSC * DV * DK + (size_t)(w & 16383) * 8;
                const float g512 = __builtin_amdgcn_exp2f(512.0f * __builtin_amdgcn_logf(1.0f - __builtin_amdgcn_exp2f(-(dir ? 5.5f : 5.0f) - (float)h)));
                u32x4 r[16];
#pragma unroll
                for (int k = 0; k < 16; ++k) r[k] = *(const u32x4*)(base + (size_t)(dir ? 15 - k : k) * DV * DK);
                float S[8]; unpack8(r[0], S);
#pragma unroll
                for (int k = 1; k < 16; ++k) { float f[8]; unpack8(r[k], f);
#pragma unroll
                    for (int e = 0; e < 8; ++e) S[e] = S[e] * g512 + f[e];
                    u32x4 o; o.x = pk2(S[0], S[1]); o.y = pk2(S[2], S[3]); o.z = pk2(S[4], S[5]); o.w = pk2(S[6], S[7]);
                    *(u32x4*)(base + (size_t)(dir ? 15 - k : k) * DV * DK) = o; }
            }
        } break;
        default: break;
        }
        if (ph0 < args.ph_hi) xcd_barrier(bar);
        if (SSVAR == 6 && ph == 6) { for (int e_ = 0; e_ < 10; ++e_) xcd_barrier(bar); }
    }
}

#ifndef MK_PER_PHASE
#define MK_PER_PHASE 0
#endif
extern "C" void kernel_launch(void* const* d_in, const int* in_sizes, int n_in, void* d_out, int out_size, void* d_ws, size_t ws_size, hipStream_t stream) {
    static int grid = 0;
    if (grid == 0) {
        if (n_in != N_IN || out_size != M * D || ws_size < WS_END) { fprintf(stderr, "kernel_launch: unexpected shapes (n_in %d, out %d, ws %zu); nothing launched\n", n_in, out_size, ws_size); grid = -1; return; }
        int dev = 0, cus = 0, per_cu = 0;
        if (hipGetDevice(&dev) != hipSuccess || hipDeviceGetAttribute(&cus, hipDeviceAttributeMultiprocessorCount, dev) != hipSuccess) { grid = -1; return; }
        if (hipFuncSetAttribute((const void*)fwd_kernel, hipFuncAttributeMaxDynamicSharedMemorySize, LDS_BYTES) != hipSuccess) { fprintf(stderr, "kernel_launch: hipFuncSetAttribute failed\n"); grid = -1; return; }
        if (hipOccupancyMaxActiveBlocksPerMultiprocessor(&per_cu, (const void*)fwd_kernel, NTHR, LDS_BYTES) != hipSuccess || per_cu < 1) { fprintf(stderr, "kernel_launch: occupancy query says %d blocks per CU\n", per_cu); }
        (void)hipGetLastError();
        grid = cus;
    }
    if (grid < 0) return;
    (void)hipMemsetAsync((char*)d_ws + WS_CTL, 0, CTL_ZERO_BYTES, stream);
    Args a{};
    for (int i = 0; i < N_IN; ++i) a.in[i] = (const float*)d_in[i];
    a.out = (float*)d_out; a.ws = (unsigned char*)d_ws;
#if MK_PER_PHASE
    for (int p = 0; p < NPH; ++p) { a.ph_lo = p; a.ph_hi = p + 1; hipLaunchKernelGGL(fwd_kernel, dim3(grid), dim3(NTHR), LDS_BYTES, stream, a); }
#else
    a.ph_lo = 0; a.ph_hi = NPH; hipLaunchKernelGGL(fwd_kernel, dim3(grid), dim3(NTHR), LDS_BYTES, stream, a);
#if SSVAR == 7
    (void)hipMemsetAsync((char*)d_ws + WS_CTL, 0, CTL_ZERO_BYTES, stream); hipLaunchKernelGGL(fwd_kernel, dim3(grid), dim3(NTHR), LDS_BYTES, stream, a);
#endif
#endif
}
```

```cpp
#include <hip/hip_runtime.h>
#include <cstdio>
#include <cstdint>

#define LAS __attribute__((address_space(3)))
#define GAS __attribute__((address_space(1)))
typedef unsigned short bf16;
typedef short bf16x8 __attribute__((ext_vector_type(8)));
typedef float f32x4 __attribute__((ext_vector_type(4)));
typedef float f32x2 __attribute__((ext_vector_type(2)));
typedef unsigned u32x4 __attribute__((ext_vector_type(4)));
typedef unsigned u32x2 __attribute__((ext_vector_type(2)));

__device__ __forceinline__ int opaque(int v) { asm volatile("" : "+v"(v)); return v; }
constexpr int D = 1024, BATCH = 2, SEQ = 8192, M = BATCH * SEQ, CTXL = 256, MC = BATCH * CTXL, NH = 4, DK = 256, DV = 512, FF = 2816, NQ = 6 * D;
constexpr int SC = 512, NSC = SEQ / SC;
constexpr float EPS = 1e-6f;
constexpr int NWAVES = 8, NTHR = 512;

constexpr size_t MiB = 1u << 20, HMiB = 1u << 19;
constexpr size_t WS_CTL = 0, CTL_ZERO_BYTES = 1 * MiB;
constexpr size_t CTL_ADA = 65536;
constexpr size_t WS_MISC = 1 * MiB;
constexpr size_t MS_ROPE = WS_MISC;
constexpr size_t MS_RSTDX = MS_ROPE + 65536;
constexpr size_t MS_RSTDC = MS_RSTDX + 65536;
constexpr size_t MS_BIAS1 = MS_RSTDC + 4096;
constexpr int NKQ = 8;
constexpr size_t MS_BIAS3 = 262144;
constexpr size_t MS_BIAS5 = MS_BIAS1 + 3 * 6144 * 4;
static_assert(MS_BIAS3 + 4 * NKQ * 5632 * 4 <= 1 * MiB && MS_BIAS5 + 2 * NKQ * 3072 * 4 <= 1 * MiB + 512 * 1024, "misc region");
constexpr size_t MS_XPART = 1 * MiB + 512 * 1024;
constexpr size_t WS_SSQ = 2 * MiB;
constexpr size_t WS_WQKVG = 3 * MiB;
constexpr size_t WS_WO = 15 * MiB;
constexpr size_t WS_W2_0 = 19 * MiB;
constexpr size_t WS_W2_1 = 24 * MiB + HMiB;
constexpr size_t WS_WCO = 30 * MiB;
constexpr size_t WS_ACB = 60 * MiB;
constexpr size_t WS_XB = 61 * MiB;
constexpr size_t WS_Q = 93 * MiB;
constexpr size_t WS_K = 125 * MiB;
constexpr size_t WS_VT = 157 * MiB;
constexpr size_t WS_SB = 221 * MiB;
constexpr size_t WS_KC = 253 * MiB;
constexpr size_t WS_VCT = 254 * MiB;
constexpr size_t WS_SF = WS_XB;
constexpr size_t WS_HID = 93 * MiB;
constexpr size_t WS_CU = 93 * MiB, WS_CB = 125 * MiB, WS_ACV = 157 * MiB;
constexpr size_t WS_W13_0 = 181 * MiB;
constexpr size_t WS_WCI = 203 * MiB;
constexpr size_t WS_W13_1 = 215 * MiB;
constexpr size_t WS_END = 256 * MiB;

namespace pg8 {
typedef unsigned short bf16_t;
constexpr int BM = 256, BK = 64, HALF = 128, HTB = HALF * BK * 2, STAGE_BYTES = 8 * HTB, NXCD = 8, WGM = 8;
__host__ __device__ __forceinline__ int lds_byte(int r, int c) { const int st = (r >> 4) * 2 + (c >> 5), rr = r & 15, cc = c & 31, ob = rr * 64 + cc * 2; return st * 1024 + (ob ^ (((ob >> 9) & 1) << 5)); }
__host__ __device__ __forceinline__ void stage_rc(int b, int& R, int& C) { const int st = b / 1024, sb = b % 1024, swz = sb ^ (((sb >> 9) & 1) << 5); R = (st >> 1) * 16 + swz / 64; C = (st & 1) * 32 + (swz % 64) / 2; }
__host__ __device__ __forceinline__ int perm32(int rho) { const int n = rho >> 4, i = rho & 15; return 8 * (i >> 2) + 4 * n + (i & 3); }
struct Unit { int pm, pn; };
struct Gemm { const bf16_t* A; const bf16_t* Bt; int M, N, K; size_t bstride; };
struct StaticOrder {
    int nM, nN, nwg, G, c;
    __host__ __device__ void init(int M_, int N_, int G_, int c_) { nM = M_ / BM; nN = N_ / BM; nwg = nM * nN; G = G_; c = c_; }
    __host__ __device__ bool next(int i, Unit& u) const {
        const long L = (long)i * G + c; if (L >= nwg) return false;
        int wgid = (int)L; { const int q = nwg / NXCD, r = nwg % NXCD, xcd = wgid % NXCD, off = wgid / NXCD; wgid = (xcd < r ? xcd * (q + 1) : r * (q + 1) + (xcd - r) * q) + off; }
        const int nig = WGM * nN, gid = wgid / nig, fm = gid * WGM, gsz = (nM - fm) < WGM ? (nM - fm) : WGM;
        u.pm = fm + ((wgid % nig) % gsz); u.pn = (wgid % nig) / gsz; return true;
    }
    __device__ __forceinline__ void a_ready(const Unit&) const {}
    __device__ __forceinline__ void done(const Unit&) const {}
};
struct OneUnit { int pm, pn; bool have;
    __device__ __forceinline__ bool next(int i, Unit& u) const { if (i != 0 || !have) return false; u.pm = pm; u.pn = pn; return true; }
    __device__ __forceinline__ void a_ready(const Unit&) const {}
    __device__ __forceinline__ void done(const Unit&) const {}
};
template <class Epi, class Sched, bool ALIGN_EPI, bool SP2, bool SWAP>
__device__ __forceinline__ void gemm_phase(LAS unsigned char* lds, const Gemm g, const Sched& S, const Epi& E, const int tid) {
    const int wid = __builtin_amdgcn_readfirstlane(tid >> 6), wr = wid >> 2, wc = wid & 3;
    int lane = tid & 63, fr = lane & 15, fq = lane >> 4;
    const int K = g.K, nt = K / BK;
    unsigned voffA[2], voffB[2]; int aoff, boff;
#define PG8_SETUP() do { const int t_ = opaque(tid); lane = t_ & 63; fr = lane & 15; fq = lane >> 4; \
        _Pragma("unroll") for (int i = 0; i < 2; ++i) { int R, C; stage_rc(t_ * 16 + i * 8192, R, C); const int Rp = (R & ~31) + perm32(R & 31); \
            voffA[i] = (unsigned)((SWAP ? Rp : R) * K + C) * 2u; voffB[i] = (unsigned)((SWAP ? R : Rp) * K + C) * 2u; } \
        aoff = lds_byte(wr * 64 + fr, fq * 8); boff = lds_byte(wc * 32 + fr, fq * 8); } while (0)
    PG8_SETUP();
    const size_t kstep = (size_t)(BK * 2);
    const size_t hstep = (size_t)HALF * K * 2;
    const size_t tstep = 2 * hstep;
    const unsigned ldsw = (unsigned)wid * 1024u;
#define PG8_SA(b, h) (((b) * 2 + (h)) * HTB)
#define PG8_SB(b, h) ((4 + (b) * 2 + (h)) * HTB)
#define PG8_STAGE(bufoff, gbase, voff) do { _Pragma("unroll") for (int _i = 0; _i < 2; ++_i) \
        __builtin_amdgcn_global_load_lds((const unsigned*)((const char*)(gbase) + (voff)[_i]), (LAS unsigned*)(lds + (bufoff) + ldsw + _i * 8192), 16, 0, 0); } while (0)
#define PG8_LDA(dst, b, h) do { _Pragma("unroll") for (int m = 0; m < 4; ++m) _Pragma("unroll") for (int k = 0; k < 2; ++k) dst[m][k] = *(const LAS bf16x8*)(lds + PG8_SA(b, h) + aoff + m * 2048 + k * 1024); } while (0)
#define PG8_LDB(dst, b, h) do { _Pragma("unroll") for (int n = 0; n < 2; ++n) _Pragma("unroll") for (int k = 0; k < 2; ++k) dst[n][k] = *(const LAS bf16x8*)(lds + PG8_SB(b, h) + boff + n * 2048 + k * 1024); } while (0)
#define PG8_MMA(ai, bj, At, Bt) do { __builtin_amdgcn_s_setprio(1); _Pragma("unroll") for (int m = 0; m < 4; ++m) _Pragma("unroll") for (int n = 0; n < 2; ++n) _Pragma("unroll") for (int k = 0; k < 2; ++k) \
        acc[ai][bj][m][n] = SWAP ? __builtin_amdgcn_mfma_f32_16x16x32_bf16(At[m][k], Bt[n][k], acc[ai][bj][m][n], 0, 0, 0) \
                                 : __builtin_amdgcn_mfma_f32_16x16x32_bf16(Bt[n][k], At[m][k], acc[ai][bj][m][n], 0, 0, 0); __builtin_amdgcn_s_setprio(0); } while (0)
#define PG8_WAIT_V(n) asm volatile("s_waitcnt vmcnt(" #n ")" ::: "memory")
#define PG8_WAIT_L(n) asm volatile("s_waitcnt lgkmcnt(" #n ")" ::: "memory")
#define PG8_BAR __builtin_amdgcn_s_barrier()
#define PG8_SCHED __builtin_amdgcn_sched_barrier(0)
    Unit cur, nxt; int ui = 0;
    if (!S.next(0, cur)) return;
    f32x4 acc[2][2][4][2];
#pragma unroll
    for (int a = 0; a < 2; ++a)
#pragma unroll
        for (int b = 0; b < 2; ++b)
#pragma unroll
            for (int m = 0; m < 4; ++m)
#pragma unroll
                for (int n = 0; n < 2; ++n) acc[a][b][m][n] = (f32x4){0.f, 0.f, 0.f, 0.f};
    bf16x8 At[4][2], B0[2][2], B1[2][2];
    const char* cA = (const char*)g.A + (size_t)cur.pm * tstep; const char* cB = (const char*)g.Bt + (size_t)cur.pn * tstep + (cur.pm >= 32 ? g.bstride : 0);
    S.a_ready(cur);
    if constexpr (SP2) {
        PG8_STAGE(PG8_SB(0, 0), cB, voffB); PG8_STAGE(PG8_SB(0, 1), cB + hstep, voffB); PG8_STAGE(PG8_SA(0, 0), cA, voffA); PG8_STAGE(PG8_SA(0, 1), cA + hstep, voffA);
        if (wr == 1) PG8_BAR;
        PG8_WAIT_V(2); PG8_BAR;
        PG8_STAGE(PG8_SB(1, 0), cB + kstep, voffB); PG8_STAGE(PG8_SA(1, 0), cA + kstep, voffA); PG8_STAGE(PG8_SB(1, 1), cB + hstep + kstep, voffB);
        PG8_WAIT_V(6); PG8_BAR;
    } else {
        PG8_STAGE(PG8_SB(0, 0), cB, voffB); PG8_STAGE(PG8_SA(0, 0), cA, voffA); PG8_STAGE(PG8_SB(0, 1), cB + hstep, voffB); PG8_STAGE(PG8_SA(0, 1), cA + hstep, voffA);
        if (wr == 1) PG8_BAR;
        PG8_WAIT_V(4); PG8_BAR;
        PG8_STAGE(PG8_SB(1, 0), cB + kstep, voffB); PG8_STAGE(PG8_SA(1, 0), cA + kstep, voffA); PG8_STAGE(PG8_SB(1, 1), cB + hstep + kstep, voffB);
        PG8_WAIT_V(6); PG8_BAR;
    }
    for (;;) {
        const bool has_next = S.next(ui + 1, nxt);
        const char* nA = has_next ? (const char*)g.A + (size_t)nxt.pm * tstep : cA; const char* nB = has_next ? (const char*)g.Bt + (size_t)nxt.pn * tstep + (nxt.pm >= 32 ? g.bstride : 0) : cB;
        for (int t = 0; t < nt; t += 2) {
            const bool last = (t == nt - 2);
            const char* a1 = cA + (size_t)(t + 1) * kstep;
            const char* a2 = last ? nA : cA + (size_t)(t + 2) * kstep; const char* b2 = last ? nB : cB + (size_t)(t + 2) * kstep;
            const char* a3 = a2 + kstep; const char* b3 = b2 + kstep;
            if (last && has_next) S.a_ready(nxt);
            if constexpr (SP2) {
            PG8_LDB(B0, 0, 0); PG8_LDB(B1, 0, 1); PG8_SCHED; PG8_LDA(At, 0, 0); PG8_STAGE(PG8_SA(1, 1), a1 + hstep, voffA);
            PG8_WAIT_V(8); PG8_WAIT_L(0); PG8_BAR; PG8_MMA(0, 0, At, B0); PG8_MMA(0, 1, At, B1); PG8_BAR; PG8_SCHED;
            PG8_LDA(At, 0, 1); PG8_STAGE(PG8_SB(0, 0), b2, voffB); PG8_STAGE(PG8_SB(0, 1), b2 + hstep, voffB); PG8_STAGE(PG8_SA(0, 0), a2, voffA);
            PG8_WAIT_V(8); PG8_WAIT_L(0); PG8_BAR; PG8_MMA(1, 0, At, B0); PG8_MMA(1, 1, At, B1); PG8_BAR; PG8_SCHED;
            PG8_LDB(B0, 1, 0); PG8_LDB(B1, 1, 1); PG8_SCHED; PG8_LDA(At, 1, 0); PG8_STAGE(PG8_SA(0, 1), a2 + hstep, voffA);
            PG8_WAIT_V(8); PG8_WAIT_L(0); PG8_BAR; PG8_MMA(0, 0, At, B0); PG8_MMA(0, 1, At, B1); PG8_BAR; PG8_SCHED;
            PG8_LDA(At, 1, 1); PG8_STAGE(PG8_SB(1, 0), b3, voffB); PG8_STAGE(PG8_SB(1, 1), b3 + hstep, voffB); PG8_STAGE(PG8_SA(1, 0), a3, voffA);
            PG8_WAIT_V(8); PG8_WAIT_L(0); PG8_BAR; PG8_MMA(1, 0, At, B0); PG8_MMA(1, 1, At, B1); PG8_BAR; PG8_SCHED;
            } else {
            PG8_LDB(B0, 0, 0); PG8_SCHED; PG8_LDA(At, 0, 0); PG8_STAGE(PG8_SA(1, 1), a1 + hstep, voffA);
            PG8_WAIT_L(8); PG8_BAR; PG8_WAIT_L(0); PG8_MMA(0, 0, At, B0); PG8_BAR; PG8_SCHED;
            PG8_LDB(B1, 0, 1); PG8_STAGE(PG8_SB(0, 0), b2, voffB);
            PG8_BAR; PG8_WAIT_L(0); PG8_MMA(0, 1, At, B1); PG8_BAR;
            PG8_LDA(At, 0, 1); PG8_STAGE(PG8_SA(0, 0), a2, voffA);
            PG8_BAR; PG8_WAIT_L(0); PG8_MMA(1, 0, At, B0); PG8_BAR; PG8_SCHED;
            PG8_STAGE(PG8_SB(0, 1), b2 + hstep, voffB);
            PG8_WAIT_V(6); PG8_BAR; PG8_MMA(1, 1, At, B1); PG8_BAR;
            PG8_LDB(B0, 1, 0); PG8_SCHED; PG8_LDA(At, 1, 0); PG8_STAGE(PG8_SA(0, 1), a2 + hstep, voffA);
            PG8_WAIT_L(8); PG8_BAR; PG8_WAIT_L(0); PG8_MMA(0, 0, At, B0); PG8_BAR; PG8_SCHED;
            PG8_LDB(B1, 1, 1); PG8_STAGE(PG8_SB(1, 0), b3, voffB);
            PG8_BAR; PG8_WAIT_L(0); PG8_MMA(0, 1, At, B1); PG8_BAR;
            PG8_LDA(At, 1, 1); PG8_STAGE(PG8_SA(1, 0), a3, voffA);
            PG8_BAR; PG8_WAIT_L(0); PG8_MMA(1, 0, At, B0); PG8_BAR; PG8_SCHED;
            PG8_STAGE(PG8_SB(1, 1), b3 + hstep, voffB);
            PG8_WAIT_V(6); PG8_BAR; PG8_MMA(1, 1, At, B1); PG8_BAR;
            }
        }
        if constexpr (ALIGN_EPI) { if (wr == 0) PG8_BAR; }
        E(acc, cur, wr, wc, fr, fq, ui); S.done(cur);
        PG8_SETUP();
        if (!has_next) break;
#pragma unroll
        for (int a = 0; a < 2; ++a)
#pragma unroll
            for (int b = 0; b < 2; ++b)
#pragma unroll
                for (int m = 0; m < 4; ++m)
#pragma unroll
                    for (int n = 0; n < 2; ++n) acc[a][b][m][n] = (f32x4){0.f, 0.f, 0.f, 0.f};
        cur = nxt; cA = nA; cB = nB; ++ui;
        if constexpr (ALIGN_EPI) { if (wr == 1) PG8_BAR; }
    }
    PG8_WAIT_V(0);
    if constexpr (!ALIGN_EPI) { if (wr == 0) PG8_BAR; }
    PG8_BAR;
#undef PG8_SETUP
#undef PG8_SA
#undef PG8_SB
#undef PG8_STAGE
#undef PG8_LDA
#undef PG8_LDB
#undef PG8_MMA
#undef PG8_WAIT_V
#undef PG8_WAIT_L
#undef PG8_BAR
#undef PG8_SCHED
}
}

#define RLX_AGENT __ATOMIC_RELAXED, __HIP_MEMORY_SCOPE_AGENT
#define LDS_WAIT() asm volatile("s_waitcnt lgkmcnt(0)" ::: "memory")
typedef __bf16 hbf16x2 __attribute__((ext_vector_type(2)));
__device__ __forceinline__ unsigned pk2(float lo, float hi) { const f32x2 v = {lo, hi}; return __builtin_bit_cast(unsigned, __builtin_convertvector(v, hbf16x2)); }
__device__ __forceinline__ unsigned f2bf(float f) { return pk2(f, 0.f) & 0xffffu; }
__device__ __forceinline__ float bf2f(unsigned h) { return __builtin_bit_cast(float, h << 16); }
__device__ __forceinline__ float bflo(unsigned w) { return __builtin_bit_cast(float, w << 16); }
__device__ __forceinline__ float bfhi(unsigned w) { return __builtin_bit_cast(float, w & 0xffff0000u); }
__device__ __forceinline__ float siluf(float x) { return x * __builtin_amdgcn_rcpf(1.0f + __builtin_amdgcn_exp2f(-1.44269504089f * x)); }
__device__ __forceinline__ float wave_sum(float v) {
#pragma unroll
    for (int o = 1; o < 64; o <<= 1) v += __shfl_xor(v, o);
    return v;
}
__device__ __forceinline__ u32x4 pack8(const f32x4 a, const f32x4 b) { u32x4 w; w.x = pk2(a[0], a[1]); w.y = pk2(a[2], a[3]); w.z = pk2(b[0], b[1]); w.w = pk2(b[2], b[3]); return w; }

using pg8::Unit;
typedef f32x4 Acc[2][2][4][2];
struct EpiQKG {
    bf16* Q; bf16* K; bf16* G; const float* rstd; const float* bias;
    __device__ __forceinline__ void operator()(const Acc& acc, const Unit& u, int wr, int wc, int fr_, int fq_, int ui) const {
        const int fr = opaque(fr_), fq = opaque(fq_);
        const int b = u.pm >> 5; const float* bb = bias + b * NQ + u.pn * 256 + wc * 32 + 8 * fq;
        const int row0 = u.pm * 256 + wr * 64 + fr;
        f32x4 bv[2][2]; float rs[2][4];
#pragma unroll
        for (int ai = 0; ai < 2; ++ai)
#pragma unroll
            for (int m = 0; m < 4; ++m) rs[ai][m] = rstd[row0 + ai * 128 + m * 16];
#pragma unroll
        for (int bj = 0; bj < 2; ++bj)
#pragma unroll
            for (int n = 0; n < 2; ++n) bv[bj][n] = *(const f32x4*)(bb + bj * 128 + 4 * n);
        if (u.pn < 8) {
            const bool isk = u.pn >= 4; bf16* O = isk ? K : Q; const float osc = isk ? 0.0625f : 1.0f;
            const int a = wc >> 1, i0 = (wc & 1) * 32 + 8 * fq, colo = (u.pn & 3) * 256 + wc * 32 + 8 * fq;
            f32x4 frv[2];
#pragma unroll
            for (int n = 0; n < 2; ++n)
#pragma unroll
                for (int j = 0; j < 4; ++j) frv[n][j] = __builtin_amdgcn_exp2f(-(float)(i0 + 4 * n + j) * (13.287712379549449f / 64.0f)) * 0.15915494309189535f;
#pragma unroll
            for (int ai = 0; ai < 2; ++ai)
#pragma unroll
                for (int m = 0; m < 4; ++m) {
                    const int r = row0 + ai * 128 + m * 16; const float rsv = rs[ai][m]; const int t = r & (SEQ - 1); const float pos = (float)(a ? (t & 63) : (t >> 6));
                    f32x4 o1[2], o2[2];
#pragma unroll
                    for (int n = 0; n < 2; ++n) {
                        f32x4 cs, sn;
#pragma unroll
                        for (int j = 0; j < 4; ++j) { const float rv = __builtin_amdgcn_fractf(pos * frv[n][j]); cs[j] = __builtin_amdgcn_cosf(rv); sn[j] = __builtin_amdgcn_sinf(rv); }
                        const f32x4 x1 = acc[ai][0][m][n] * rsv + bv[0][n], x2 = acc[ai][1][m][n] * rsv + bv[1][n];
                        o1[n] = (x1 * cs - x2 * sn) * osc; o2[n] = (x1 * sn + x2 * cs) * osc;
                    }
                    bf16* rowp = O + (size_t)r * D + colo;
                    *(u32x4*)(rowp) = pack8(o1[0], o1[1]); *(u32x4*)(rowp + 128) = pack8(o2[0], o2[1]);
                }
        } else {
            const int colo = (u.pn - 8) * 256 + wc * 32 + 8 * fq;
#pragma unroll
            for (int ai = 0; ai < 2; ++ai)
#pragma unroll
                for (int m = 0; m < 4; ++m) {
                    const int r = row0 + ai * 128 + m * 16; const float rsv = rs[ai][m]; bf16* rowp = G + (size_t)r * 2048 + colo;
#pragma unroll
                    for (int bj = 0; bj < 2; ++bj) *(u32x4*)(rowp + bj * 128) = pack8(acc[ai][bj][m][0] * rsv + bv[bj][0], acc[ai][bj][m][1] * rsv + bv[bj][1]);
                }
        }
    }
};
struct EpiVT {
    bf16* VT; const float* rstd; const float* bias; int ldt; int tiles_per_b; int bias_row;
    __device__ __forceinline__ void operator()(const Acc& acc, const Unit& u, int wr, int wc, int fr_, int fq_, int ui) const {
        const int fr = opaque(fr_), fq = opaque(fq_);
        const int b = u.pm / tiles_per_b, t00 = (u.pm % tiles_per_b) * 256 + wr * 64 + 8 * fq, h = u.pn >> 1, e0 = (u.pn & 1) * 256 + wc * 32 + fr;
        const float* bb = bias + (bias_row < 0 ? b : bias_row) * NQ;
        float bs[2][2];
#pragma unroll
        for (int bj = 0; bj < 2; ++bj)
#pragma unroll
            for (int n = 0; n < 2; ++n) bs[bj][n] = bb[u.pn * 256 + bj * 128 + wc * 32 + n * 16 + fr];
        f32x4 rsv[2][2][2];
#pragma unroll
        for (int ai = 0; ai < 2; ++ai)
#pragma unroll
            for (int mp = 0; mp < 2; ++mp) { const float* rp = rstd + b * ldt + t00 + ai * 128 + mp * 32; rsv[ai][mp][0] = *(const f32x4*)rp; rsv[ai][mp][1] = *(const f32x4*)(rp + 4); }
#pragma unroll
        for (int ai = 0; ai < 2; ++ai)
#pragma unroll
            for (int mp = 0; mp < 2; ++mp) {
                const int tl = t00 + ai * 128 + mp * 32;
                const f32x4 r0 = rsv[ai][mp][0], r1 = rsv[ai][mp][1];
#pragma unroll
                for (int bj = 0; bj < 2; ++bj)
#pragma unroll
                    for (int n = 0; n < 2; ++n) {
                        const f32x4 v0 = acc[ai][bj][2 * mp][n] * r0 + bs[bj][n], v1 = acc[ai][bj][2 * mp + 1][n] * r1 + bs[bj][n];
                        bf16* p = VT + ((size_t)(((b * NH + h) * (ldt >> 7) + (tl >> 7)) * DV + e0 + bj * 128 + n * 16)) * 128 + (tl & 127);
                        *(u32x4*)p = pack8(v0, v1);
                    }
            }
    }
};
struct EpiRes {
    const float* res32; const bf16* res16; bf16* hx; const float* gate; float* ssq; int dry;
    __device__ __forceinline__ void operator()(const Acc& acc, const Unit& u, int wr, int wc, int fr_, int fq_, int ui) const {
        const int fr = opaque(fr_), fq = opaque(fq_);
        const int b = u.pm >> 5, col0 = u.pn * 256 + wc * 32 + 8 * fq, row0 = u.pm * 256 + wr * 64 + fr;
        f32x4 gv[2][2];
#pragma unroll
        for (int bj = 0; bj < 2; ++bj)
#pragma unroll
            for (int n = 0; n < 2; ++n) gv[bj][n] = *(const f32x4*)(gate + b * NQ + col0 + bj * 128 + 4 * n);
#pragma unroll
        for (int am = 0; am < 8; am += 2) {
            f32x4 rv[2][2][2];
            if (res32) {
#pragma unroll
                for (int q = 0; q < 2; ++q)
#pragma unroll
                    for (int bj = 0; bj < 2; ++bj) { const float* p = res32 + (size_t)(row0 + ((am + q) >> 2) * 128 + ((am + q) & 3) * 16) * D + col0 + bj * 128; rv[q][bj][0] = *(const f32x4*)p; rv[q][bj][1] = *(const f32x4*)(p + 4); }
            } else {
                u32x4 rw[2][2];
#pragma unroll
                for (int q = 0; q < 2; ++q)
#pragma unroll
                    for (int bj = 0; bj < 2; ++bj) rw[q][bj] = *(const u32x4*)(res16 + (size_t)(row0 + ((am + q) >> 2) * 128 + ((am + q) & 3) * 16) * D + col0 + bj * 128);
#pragma unroll
                for (int q = 0; q < 2; ++q)
#pragma unroll
                    for (int bj = 0; bj < 2; ++bj) { const u32x4 w = rw[q][bj]; rv[q][bj][0] = (f32x4){bflo(w.x), bfhi(w.x), bflo(w.y), bfhi(w.y)}; rv[q][bj][1] = (f32x4){bflo(w.z), bfhi(w.z), bflo(w.w), bfhi(w.w)}; }
            }
#pragma unroll
            for (int q = 0; q < 2; ++q) {
                const int ai = (am + q) >> 2, m = (am + q) & 3;
                const int r = row0 + ai * 128 + m * 16; const size_t off = (size_t)r * D + col0; float ss = 0.f;
#pragma unroll
                for (int bj = 0; bj < 2; ++bj) {
                    const f32x4 o0 = rv[q][bj][0] + gv[bj][0] * acc[ai][bj][m][0], o1 = rv[q][bj][1] + gv[bj][1] * acc[ai][bj][m][1];
                    ss += (o0[0] * o0[0] + o0[1] * o0[1]) + (o0[2] * o0[2] + o0[3] * o0[3]) + (o1[0] * o1[0] + o1[1] * o1[1]) + (o1[2] * o1[2] + o1[3] * o1[3]);
                    if (!dry) *(u32x4*)(hx + off + bj * 128) = pack8(o0, o1);
                }
                ss += __shfl_xor(ss, 16); ss += __shfl_xor(ss, 32);
                if (fq == 0) ssq[(size_t)r * 16 + u.pn * 4 + wc] = ss;
            }
        }
    }
};
constexpr int CW_PANEL = 8192;
struct EpiResFinal {
    const bf16* res16; float* out; const float* gate; const float* fn; float* xpart; unsigned* cnt; LAS unsigned char* ldsb;
    __device__ __forceinline__ void operator()(Acc& acc, const Unit& u, int wr, int wc, int fr_, int fq_, int ui) const {
        const int fr = opaque(fr_), fq = opaque(fq_), tid = opaque((int)threadIdx.x);
        const int b = u.pm >> 5, col0 = u.pn * 256 + wc * 32 + 8 * fq, row0 = u.pm * 256 + wr * 64 + fr;
        LAS float* part = (LAS float*)ldsb;
        LAS float* rtab = (LAS float*)(ldsb + 4096);
        f32x4 gv[2][2];
#pragma unroll
        for (int bj = 0; bj < 2; ++bj)
#pragma unroll
            for (int n = 0; n < 2; ++n) gv[bj][n] = *(const f32x4*)(gate + b * NQ + col0 + bj * 128 + 4 * n);
#pragma unroll
        for (int am = 0; am < 8; am += 2) {
            u32x4 rw[2][2];
#pragma unroll
            for (int q = 0; q < 2; ++q)
#pragma unroll
                for (int bj = 0; bj < 2; ++bj) rw[q][bj] = *(const u32x4*)(res16 + (size_t)(row0 + ((am + q) >> 2) * 128 + ((am + q) & 3) * 16) * D + col0 + bj * 128);
#pragma unroll
            for (int q = 0; q < 2; ++q) { const int ai = (am + q) >> 2, m = (am + q) & 3; float ss = 0.f;
#pragma unroll
                for (int bj = 0; bj < 2; ++bj) { const u32x4 w = rw[q][bj];
                    const f32x4 o0 = (f32x4){bflo(w.x), bfhi(w.x), bflo(w.y), bfhi(w.y)} + gv[bj][0] * acc[ai][bj][m][0], o1 = (f32x4){bflo(w.z), bfhi(w.z), bflo(w.w), bfhi(w.w)} + gv[bj][1] * acc[ai][bj][m][1];
                    ss += (o0[0] * o0[0] + o0[1] * o0[1]) + (o0[2] * o0[2] + o0[3] * o0[3]) + (o1[0] * o1[0] + o1[1] * o1[1]) + (o1[2] * o1[2] + o1[3] * o1[3]);
                    acc[ai][bj][m][0] = o0; acc[ai][bj][m][1] = o1; }
                ss += __shfl_xor(ss, 16); ss += __shfl_xor(ss, 32);
                if (fq == 0) part[(ai * 128 + wr * 64 + m * 16 + fr) * 4 + wc] = ss; }
        }
        asm volatile("s_waitcnt lgkmcnt(0)" ::: "memory"); __builtin_amdgcn_s_barrier(); asm volatile("" ::: "memory");
        if (tid < 256) { const f32x4 p4 = *(const LAS f32x4*)(part + tid * 4);
            __hip_atomic_store(xpart + (size_t)(u.pm * 256 + tid) * 4 + u.pn, (p4[0] + p4[1]) + (p4[2] + p4[3]), __ATOMIC_RELAXED, __HIP_MEMORY_SCOPE_AGENT); }
        asm volatile("s_waitcnt vmcnt(0)" ::: "memory"); __builtin_amdgcn_s_barrier(); asm volatile("" ::: "memory");
        if (tid == 0) { __hip_atomic_fetch_add(cnt + CW_PANEL + 64 * u.pm, 1u, __ATOMIC_RELAXED, __HIP_MEMORY_SCOPE_AGENT);
            unsigned sp = 0; while (__hip_atomic_load(cnt + CW_PANEL + 64 * u.pm, __ATOMIC_RELAXED, __HIP_MEMORY_SCOPE_AGENT) < 4u) { __builtin_amdgcn_s_sleep(2); if (++sp > (1u << 22)) break; } }
        asm volatile("s_waitcnt vmcnt(0) lgkmcnt(0)" ::: "memory"); __builtin_amdgcn_s_barrier(); asm volatile("" ::: "memory");
        if (tid < 256) { const float* xp = xpart + (size_t)(u.pm * 256 + tid) * 4; float t = 0.f;
#pragma unroll
            for (int q = 0; q < 4; ++q) t += __hip_atomic_load(xp + q, __ATOMIC_RELAXED, __HIP_MEMORY_SCOPE_AGENT);
            rtab[tid] = 1.0f / sqrtf(t * (1.0f / D) + EPS); }
        asm volatile("s_waitcnt vmcnt(0) lgkmcnt(0)" ::: "memory"); __builtin_amdgcn_s_barrier(); asm volatile("" ::: "memory");
        f32x4 fv[2][2];
#pragma unroll
        for (int bj = 0; bj < 2; ++bj)
#pragma unroll
            for (int n = 0; n < 2; ++n) fv[bj][n] = *(const f32x4*)(fn + col0 + bj * 128 + 4 * n);
#pragma unroll
        for (int ai = 0; ai < 2; ++ai)
#pragma unroll
            for (int m = 0; m < 4; ++m) { const float rs = rtab[ai * 128 + wr * 64 + m * 16 + fr]; float* op = out + (size_t)(row0 + ai * 128 + m * 16) * D + col0;
#pragma unroll
                for (int bj = 0; bj < 2; ++bj) { *(f32x4*)(op + bj * 128) = acc[ai][bj][m][0] * rs * fv[bj][0]; *(f32x4*)(op + bj * 128 + 4) = acc[ai][bj][m][1] * rs * fv[bj][1]; } }
    }
};
__device__ __forceinline__ float rstd_from_ssq(const float* ssq, int r) {
    const f32x4* p = (const f32x4*)(ssq + (size_t)r * 16); const f32x4 a = p[0], b = p[1], c = p[2], d = p[3];
    const float s = ((a[0] + a[1]) + (a[2] + a[3])) + ((b[0] + b[1]) + (b[2] + b[3])) + ((c[0] + c[1]) + (c[2] + c[3])) + ((d[0] + d[1]) + (d[2] + d[3]));
    return 1.0f / sqrtf(s * (1.0f / D) + EPS);
}
constexpr int RSTD_LDS = 131072, BIAS_LDS = 131072 + 8192;
struct EpiSwiGLU {
    bf16* HID; const LAS float* rtab; const LAS float* btab; int dry;
    __device__ __forceinline__ void operator()(const Acc& acc, const Unit& u, int wr, int wc, int fr_, int fq_, int ui) const {
        const int fr = opaque(fr_), fq = opaque(fq_); if (dry) return;
        f32x4 bv[2][2]; float rs[2][4];
#pragma unroll
        for (int ai = 0; ai < 2; ++ai)
#pragma unroll
            for (int m = 0; m < 4; ++m) rs[ai][m] = rtab[ui * 256 + ai * 128 + wr * 64 + m * 16 + fr];
#pragma unroll
        for (int bj = 0; bj < 2; ++bj)
#pragma unroll
            for (int n = 0; n < 2; ++n) bv[bj][n] = *(const LAS f32x4*)(btab + ui * 256 + bj * 128 + wc * 32 + 8 * fq + 4 * n);
        const int row0 = u.pm * 256 + wr * 64 + fr, colo = u.pn * 128 + wc * 32 + 8 * fq;
#pragma unroll
        for (int ai = 0; ai < 2; ++ai)
#pragma unroll
            for (int m = 0; m < 4; ++m) {
                const int r = row0 + ai * 128 + m * 16;
                f32x4 hv[2];
#pragma unroll
                for (int n = 0; n < 2; ++n) { const f32x4 a1 = acc[ai][0][m][n] * rs[ai][m] + bv[0][n], a3 = acc[ai][1][m][n] * rs[ai][m] + bv[1][n];
#pragma unroll
                    for (int j = 0; j < 4; ++j) hv[n][j] = siluf(a1[j]) * a3[j]; }
                *(u32x4*)(HID + (size_t)r * FF + colo) = pack8(hv[0], hv[1]);
            }
    }
};
struct EpiConvIn {
    bf16* CU; bf16* CB; const LAS float* rtab; const LAS float* btab;
    __device__ __forceinline__ void operator()(const Acc& acc, const Unit& u, int wr, int wc, int fr_, int fq_, int ui) const {
        const int fr = opaque(fr_), fq = opaque(fq_);
        f32x4 bv[2][2]; float rs[2][4];
#pragma unroll
        for (int ai = 0; ai < 2; ++ai)
#pragma unroll
            for (int m = 0; m < 4; ++m) rs[ai][m] = rtab[ui * 256 + ai * 128 + wr * 64 + m * 16 + fr];
#pragma unroll
        for (int bj = 0; bj < 2; ++bj)
#pragma unroll
            for (int n = 0; n < 2; ++n) bv[bj][n] = *(const LAS f32x4*)(btab + ui * 256 + bj * 128 + wc * 32 + 8 * fq + 4 * n);
        const int row0 = u.pm * 256 + wr * 64 + fr;
#pragma unroll
        for (int ai = 0; ai < 2; ++ai)
#pragma unroll
            for (int m = 0; m < 4; ++m) {
                const int r = row0 + ai * 128 + m * 16; const float rs_ = rs[ai][m];
                if (u.pn < 8) {
                    const f32x4 u0 = (acc[ai][0][m][0] * rs_ + bv[0][0]) * (acc[ai][1][m][0] * rs_ + bv[1][0]), u1 = (acc[ai][0][m][1] * rs_ + bv[0][1]) * (acc[ai][1][m][1] * rs_ + bv[1][1]);
                    *(u32x4*)(CU + (size_t)r * D + u.pn * 128 + wc * 32 + 8 * fq) = pack8(u0, u1);
                } else {
#pragma unroll
                    for (int bj = 0; bj < 2; ++bj) *(u32x4*)(CB + (size_t)r * D + (u.pn - 8) * 256 + bj * 128 + wc * 32 + 8 * fq) = pack8(acc[ai][bj][m][0] * rs_ + bv[bj][0], acc[ai][bj][m][1] * rs_ + bv[bj][1]);
                }
            }
    }
};

#define XB_TMO      128
#define XB_XCNT(j)  (256  + 64 * (j))
#define XB_XSUB(j)  (1280 + 64 * (j))
#define XB_XGEN(j)  (2304 + 64 * (j))
#define XB_TOP      3328
#define XB_TOPGEN   3392
#define XCD_BAR_WORDS 3456
#define XB_SPIN_CAP (1u << 20)
__device__ __forceinline__ unsigned xb_ld(unsigned* p)              { return __hip_atomic_load(p, __ATOMIC_RELAXED, __HIP_MEMORY_SCOPE_AGENT); }
__device__ __forceinline__ unsigned xb_add(unsigned* p, unsigned v) { return __hip_atomic_fetch_add(p, v, __ATOMIC_RELAXED, __HIP_MEMORY_SCOPE_AGENT); }
__device__ __forceinline__ unsigned xb_xcc_id() { return (unsigned)__builtin_amdgcn_s_getreg((3 << 11) | 20) & 0xFu; }
#define XB_SPIN(cond, bar) do { unsigned _sp = 0; while (cond) { __builtin_amdgcn_s_sleep(1); \
    if ((++_sp & 255u) == 0u) { if (xb_ld(&(bar)[XB_TMO])) break; if (_sp > XB_SPIN_CAP) { atomicAdd(&(bar)[XB_TMO], 1u); break; } } } } while (0)
struct XcdBarrier { unsigned* bar; unsigned x; volatile LAS unsigned* st; };
__device__ __forceinline__ XcdBarrier xcd_barrier_post(unsigned* bar, volatile LAS unsigned* st) {
    XcdBarrier b; b.bar = bar; b.x = xb_xcc_id(); b.st = st;
    if (threadIdx.x == 0) (void)xb_add(&bar[XB_XCNT(b.x)], 1u);
    return b;
}
__device__ __forceinline__ void xcd_barrier_complete(unsigned* bar, unsigned x, unsigned& nloc, unsigned& nx) {
    const unsigned G = gridDim.x * gridDim.y * gridDim.z;
    unsigned sum, cnt, mine, sp = 0u;
    for (;;) {
        sum = 0u; cnt = 0u; mine = 0u;
#pragma unroll
        for (unsigned j = 0; j < 16; ++j) { const unsigned c = xb_ld(&bar[XB_XCNT(j)]); sum += c; cnt += (c > 0u) ? 1u : 0u; mine = (j == x) ? c : mine; }
        if (sum == G) break;
        __builtin_amdgcn_s_sleep(1);
        if ((++sp & 255u) == 0u) { if (xb_ld(&bar[XB_TMO])) break; if (sp > XB_SPIN_CAP) { atomicAdd(&bar[XB_TMO], 1u); break; } }
    }
    nloc = mine > 0u ? mine : 1u; nx = cnt > 0u ? cnt : 1u;
}
__device__ __forceinline__ void xcd_barrier(const XcdBarrier& b) {
    asm volatile("s_waitcnt vmcnt(0)" ::: "memory");
    __syncthreads();
    if (threadIdx.x == 0) {
        unsigned* bar = b.bar;
        __builtin_amdgcn_s_waitcnt(0);
        unsigned nloc = b.st[0], nx = b.st[1];
        if (nloc == 0u) { xcd_barrier_complete(bar, b.x, nloc, nx); b.st[0] = nloc; b.st[1] = nx; }
        const unsigned old = xb_add(&bar[XB_XSUB(b.x)], 1u);
        const unsigned gen = old / nloc;
        if (old + 1u == (gen + 1u) * nloc) {
            __builtin_amdgcn_fence(__ATOMIC_RELEASE, "agent");
            asm volatile("s_waitcnt vmcnt(0)" ::: "memory");
            const unsigned og = xb_add(&bar[XB_TOP], 1u);
            const unsigned tg = og / nx;
            if (og + 1u == (tg + 1u) * nx) xb_add(&bar[XB_TOPGEN], 1u);
            else XB_SPIN(xb_ld(&bar[XB_TOPGEN]) == tg, bar);
            __builtin_amdgcn_fence(__ATOMIC_ACQUIRE, "agent");
            xb_add(&bar[XB_XGEN(b.x)], 1u);
            asm volatile("s_waitcnt vmcnt(0)" ::: "memory");
        } else {
            XB_SPIN(xb_ld(&bar[XB_XGEN(b.x)]) == gen, bar);
            __builtin_amdgcn_fence(__ATOMIC_ACQUIRE, "agent");
            asm volatile("s_waitcnt vmcnt(0)" ::: "memory");
        }
    }
    __syncthreads();
}

enum { IN_X = 0, IN_C, IN_CTX, IN_CCTX, IN_ADAW, IN_ADAB, IN_NMIX, IN_NFFN, IN_WQKVG, IN_WO, IN_WCI, IN_CW, IN_WCO, IN_W1, IN_W3, IN_W2, IN_FN, N_IN };
struct Args { const float* in[N_IN]; float* out; unsigned char* ws; int ph_lo, ph_hi; };
constexpr int CW_BAR = 4096;
constexpr int LDS_BYTES = 163840, MISC_OFF = 163712;
constexpr int NPH = 14;
#ifndef P1_RW
#define P1_RW 5
#endif
#define P1_R1 (16384 - 2048 * P1_RW)
#ifndef G1SEL
#define G1SEL 7
#endif
#ifndef PHMASK
#define PHMASK 0xFFFF
#endif

__device__ __forceinline__ void transpose_item(const float* W, int Nsrc, int K, bf16* WT, int k0, int n_src0, int dst_row0, LAS float* scr, int lane) {
#pragma unroll
    for (int i = 0; i < 32; ++i) { const int kk = 2 * i + (lane >> 5); scr[kk * 33 + (lane & 31)] = W[(size_t)(k0 + kk) * Nsrc + n_src0 + (lane & 31)]; }
    LDS_WAIT(); asm volatile("" ::: "memory");
    const int c = lane & 7;
#pragma unroll
    for (int j = 0; j < 4; ++j) { const int n = (lane >> 3) + 8 * j; const LAS float* s = scr + (8 * c) * 33 + n;
        u32x4 o; o.x = pk2(s[0 * 33], s[1 * 33]); o.y = pk2(s[2 * 33], s[3 * 33]); o.z = pk2(s[4 * 33], s[5 * 33]); o.w = pk2(s[6 * 33], s[7 * 33]);
        *(u32x4*)(WT + (size_t)(dst_row0 + n) * K + k0 + 8 * c) = o; }
    LDS_WAIT(); asm volatile("" ::: "memory");
}
__device__ __forceinline__ void transpose_item_scaled(const float* W, int Nsrc, bf16* WT0, bf16* WT1, int k0, int n_src0, int dst_row0, LAS float* scr, const LAS float* tab, float& a0, float& a1, int lane) {
    LAS float* s0 = scr; LAS float* s1 = scr + 64 * 33;
#pragma unroll
    for (int i = 0; i < 32; ++i) { const int kk = 2 * i + (lane >> 5); const float w = W[(size_t)(k0 + kk) * Nsrc + n_src0 + (lane & 31)];
        s0[kk * 33 + (lane & 31)] = w * tab[k0 + kk]; s1[kk * 33 + (lane & 31)] = w * tab[1024 + k0 + kk]; a0 += w * tab[2048 + k0 + kk]; a1 += w * tab[3072 + k0 + kk]; }
    LDS_WAIT(); asm volatile("" ::: "memory");
    const int c = lane & 7;
#pragma unroll
    for (int j = 0; j < 4; ++j) { const int n = (lane >> 3) + 8 * j; const LAS float* p0 = s0 + (8 * c) * 33 + n; const LAS float* p1 = s1 + (8 * c) * 33 + n;
        u32x4 o; o.x = pk2(p0[0 * 33], p0[1 * 33]); o.y = pk2(p0[2 * 33], p0[3 * 33]); o.z = pk2(p0[4 * 33], p0[5 * 33]); o.w = pk2(p0[6 * 33], p0[7 * 33]);
        *(u32x4*)(WT0 + (size_t)(dst_row0 + n) * D + k0 + 8 * c) = o;
        o.x = pk2(p1[0 * 33], p1[1 * 33]); o.y = pk2(p1[2 * 33], p1[3 * 33]); o.z = pk2(p1[4 * 33], p1[5 * 33]); o.w = pk2(p1[6 * 33], p1[7 * 33]);
        *(u32x4*)(WT1 + (size_t)(dst_row0 + n) * D + k0 + 8 * c) = o; }
    LDS_WAIT(); asm volatile("" ::: "memory");
}
template <bool SCALED>
__device__ __forceinline__ void tr64(const float* W, int Nsrc, int K, bf16* WT0, bf16* WT1, int k0, int n_src0, int dst_row0, const LAS float* tab, f32x4& a0, f32x4& a1, int lane) {
    const int n4 = lane & 15, kr = lane >> 4;
    const float* src = W + (size_t)(k0 + 16 * kr) * Nsrc + n_src0 + 4 * n4;
    f32x4 v[16];
#pragma unroll
    for (int i = 0; i < 16; ++i) v[i] = *(const f32x4*)(src + (size_t)i * Nsrc);
    if constexpr (!SCALED) {
#pragma unroll
        for (int j = 0; j < 4; ++j) { bf16* drow = WT0 + (size_t)(dst_row0 + 4 * n4 + j) * K + k0 + 16 * kr;
#pragma unroll
            for (int h = 0; h < 2; ++h) { u32x4 o; o.x = pk2(v[8 * h][j], v[8 * h + 1][j]); o.y = pk2(v[8 * h + 2][j], v[8 * h + 3][j]); o.z = pk2(v[8 * h + 4][j], v[8 * h + 5][j]); o.w = pk2(v[8 * h + 6][j], v[8 * h + 7][j]);
                *(u32x4*)(drow + 8 * h) = o; } }
    } else {
        float s0[16], s1[16];
#pragma unroll
        for (int i = 0; i < 16; ++i) { const int k = k0 + 16 * kr + i; s0[i] = tab[k]; s1[i] = tab[1024 + k]; a0 += v[i] * tab[2048 + k]; a1 += v[i] * tab[3072 + k]; }
#pragma unroll
        for (int j = 0; j < 4; ++j) { bf16* d0 = WT0 + (size_t)(dst_row0 + 4 * n4 + j) * K + k0 + 16 * kr; bf16* d1 = WT1 + (size_t)(dst_row0 + 4 * n4 + j) * K + k0 + 16 * kr;
#pragma unroll
            for (int h = 0; h < 2; ++h) { u32x4 o;
                o.x = pk2(v[8 * h][j] * s0[8 * h], v[8 * h + 1][j] * s0[8 * h + 1]); o.y = pk2(v[8 * h + 2][j] * s0[8 * h + 2], v[8 * h + 3][j] * s0[8 * h + 3]);
                o.z = pk2(v[8 * h + 4][j] * s0[8 * h + 4], v[8 * h + 5][j] * s0[8 * h + 5]); o.w = pk2(v[8 * h + 6][j] * s0[8 * h + 6], v[8 * h + 7][j] * s0[8 * h + 7]);
                *(u32x4*)(d0 + 8 * h) = o;
                o.x = pk2(v[8 * h][j] * s1[8 * h], v[8 * h + 1][j] * s1[8 * h + 1]); o.y = pk2(v[8 * h + 2][j] * s1[8 * h + 2], v[8 * h + 3][j] * s1[8 * h + 3]);
                o.z = pk2(v[8 * h + 4][j] * s1[8 * h + 4], v[8 * h + 5][j] * s1[8 * h + 5]); o.w = pk2(v[8 * h + 6][j] * s1[8 * h + 6], v[8 * h + 7][j] * s1[8 * h + 7]);
                *(u32x4*)(d1 + 8 * h) = o; } }
    }
}
__device__ __forceinline__ int map_qkvg(int np) {
    if (np < 2048) { const int qk = np >> 10, h = (np >> 8) & 3, cp = np & 255; const int d = 128 * ((cp >> 6) & 1) + 64 * (cp >> 7) + (cp & 63); return qk * 1024 + h * 256 + d; }
    if (np < 4096) return 4096 + (np - 2048);
    return 2048 + (np - 4096);
}
__device__ __forceinline__ int map_wci(int np) { const int tile = np >> 8, cp = np & 255; if (tile < 8) return (cp < 128) ? (1024 + 128 * tile + cp) : (2048 + 128 * tile + cp - 128); return 256 * (tile - 8) + cp; }
__device__ __forceinline__ void unpack8(const u32x4 w, float (&f)[8]) { f[0] = bflo(w.x); f[1] = bfhi(w.x); f[2] = bflo(w.y); f[3] = bfhi(w.y); f[4] = bflo(w.z); f[5] = bfhi(w.z); f[6] = bflo(w.w); f[7] = bfhi(w.w); }

template <int RB>
__device__ __forceinline__ void modrows(const float* xrow0, const float* gain, const float* scale, bf16* orow0, float* rstd0, int lane) {
    f32x4 v[RB][4]; float ss[RB];
#pragma unroll
    for (int r = 0; r < RB; ++r)
#pragma unroll
        for (int j = 0; j < 4; ++j) v[r][j] = ((const f32x4*)(xrow0 + (size_t)r * D) + lane)[64 * j];
    f32x4 w[4];
#pragma unroll
    for (int j = 0; j < 4; ++j) w[j] = ((const f32x4*)gain + lane)[64 * j] * (((const f32x4*)scale + lane)[64 * j] + 1.0f);
#pragma unroll
    for (int r = 0; r < RB; ++r) { float s_ = 0.f;
#pragma unroll
        for (int j = 0; j < 4; ++j) s_ += (v[r][j][0] * v[r][j][0] + v[r][j][1] * v[r][j][1]) + (v[r][j][2] * v[r][j][2] + v[r][j][3] * v[r][j][3]);
        ss[r] = wave_sum(s_); }
#pragma unroll
    for (int r = 0; r < RB; ++r) { if (lane == 0) rstd0[r] = 1.0f / sqrtf(ss[r] * (1.0f / D) + EPS);
        unsigned long long* o8 = (unsigned long long*)(orow0 + (size_t)r * D) + lane;
#pragma unroll
        for (int j = 0; j < 4; ++j) { const f32x4 o = v[r][j] * w[j]; o8[64 * j] = (unsigned long long)pk2(o[0], o[1]) | ((unsigned long long)pk2(o[2], o[3]) << 32); } }
}
template <int RB>
__device__ __forceinline__ void biasrows(const bf16* wrow0, const float* sh, int q_lo, int q_hi, float* out0, int lane) {
    u32x4 wv[RB][2];
#pragma unroll
    for (int r = 0; r < RB; ++r)
#pragma unroll
        for (int j = 0; j < 2; ++j) wv[r][j] = *(const u32x4*)(wrow0 + (size_t)r * D + j * 512 + lane * 8);
#pragma unroll
    for (int q = 0; q < 3; ++q) if (q >= q_lo && q < q_hi) {
        float a[RB];
#pragma unroll
        for (int r = 0; r < RB; ++r) a[r] = 0.f;
#pragma unroll
        for (int j = 0; j < 2; ++j) { const float* s_ = sh + q * NQ + j * 512 + lane * 8; const f32x4 s0 = *(const f32x4*)s_, s1 = *(const f32x4*)(s_ + 4);
#pragma unroll
            for (int r = 0; r < RB; ++r) { float wf[8]; unpack8(wv[r][j], wf);
                a[r] += (wf[0] * s0[0] + wf[1] * s0[1]) + (wf[2] * s0[2] + wf[3] * s0[3]) + (wf[4] * s1[0] + wf[5] * s1[1]) + (wf[6] * s1[2] + wf[7] * s1[3]); } }
#pragma unroll
        for (int r = 0; r < RB; ++r) { const float t = wave_sum(a[r]); if (lane == 0) out0[q * NQ + r] = t; }
    }
}

#define BUILD_TABS(S_, RS_, BS_) do { LAS float* rt_ = (LAS float*)(lds + RSTD_LDS); LAS float* bt_ = (LAS float*)(lds + BIAS_LDS); pg8::Unit u_; \
        for (int i_ = (tid >> 8); S_.next(i_, u_); i_ += 2) { const int t_ = tid & 255; rt_[i_ * 256 + t_] = RS_(u_.pm * 256 + t_); bt_[i_ * 256 + t_] = BS_(u_, t_); } \
        __syncthreads(); } while (0)
__device__ __forceinline__ float bias_sum(const float* slab, int ncol, int col) { float t = slab[col];
#pragma unroll
    for (int q = 1; q < NKQ; ++q) t += slab[q * ncol + col];
    return t; }
#define RS_SSQ(r) rstd_from_ssq(SSQ, (r))
#define RS_X(r) RSTDX[(r)]

#define WPREP_JOBS(job_lo, job_hi, gwq, ngwq) do { LAS float* tab = (LAS float*)lds; \
                for (int job = (job_lo); job < (job_hi); ++job) { \
                    const int jl = (job == 0) ? 0 : 1; const bool isci = (job == 1); \
                    const float* gain_ = (isci ? args.in[IN_NMIX] : args.in[IN_NFFN]) + jl * D; const float* ad = ADA + jl * 3 * NQ + (isci ? 0 : 3 * D); \
                    __syncthreads(); \
                    for (int i = tid; i < 2 * D; i += NTHR) { const int b_ = i >> 10, k = i & (D - 1); tab[i] = gain_[k] * (1.0f + ad[b_ * NQ + D + k]); tab[2 * D + i] = ad[b_ * NQ + k]; } \
                    __syncthreads(); \
                    const int nnb = isci ? 48 : 88, ncol = isci ? 3072 : 5632; \
                    float* bslab = isci ? BIAS5 : BIAS3 + jl * 2 * NKQ * 5632; \
                    for (int it = (gwq); it < nnb * NKQ; it += (ngwq)) { const int nb = it / NKQ, kq = it % NKQ, np = nb * 64; f32x4 a0 = {0.f, 0.f, 0.f, 0.f}, a1 = a0; \
                        for (int kb = kq * (16 / NKQ); kb < (kq + 1) * (16 / NKQ); ++kb) { \
                            if (isci) tr64<true>(args.in[IN_WCI], 3072, D, WCI, WCI + (size_t)3072 * D, kb * 64, map_wci(np), np, tab, a0, a1, lane); \
                            else { const int tile = np >> 8, cp = np & 255; const float* src = (cp < 128 ? args.in[IN_W1] : args.in[IN_W3]) + (size_t)jl * D * FF; \
                                tr64<true>(src, FF, D, W13[jl], W13[jl] + (size_t)5632 * D, kb * 64, 128 * tile + (cp & 127), np, tab, a0, a1, lane); } } \
                        _Pragma("unroll") for (int e = 0; e < 4; ++e) { a0[e] += __shfl_xor(a0[e], 16); a0[e] += __shfl_xor(a0[e], 32); a1[e] += __shfl_xor(a1[e], 16); a1[e] += __shfl_xor(a1[e], 32); } \
                        if (lane < 16) { *(f32x4*)(bslab + (0 * NKQ + kq) * ncol + np + 4 * lane) = a0; *(f32x4*)(bslab + (1 * NKQ + kq) * ncol + np + 4 * lane) = a1; } \
                    } } \
                __syncthreads(); } while (0)

__global__ void __launch_bounds__(NTHR, 2) fwd_kernel(Args args) {
    extern __shared__ __attribute__((aligned(16))) unsigned char lds_raw[];
    LAS unsigned char* lds = (LAS unsigned char*)lds_raw;
    volatile LAS unsigned* MISC = (volatile LAS unsigned*)(lds + MISC_OFF);
    const int tid0 = threadIdx.x, wave = __builtin_amdgcn_readfirstlane(tid0 >> 6);
    const int G = gridDim.x, bx = blockIdx.x;
    const int vcu = (G % 8 == 0) ? (bx % 8) * (G / 8) + bx / 8 : bx;
    const int gw = vcu * NWAVES + wave, NGW = G * NWAVES;
    unsigned char* ws = args.ws;
    unsigned* ctl = (unsigned*)(ws + WS_CTL);
    float* ADA = (float*)(ws + CTL_ADA);
    float* ROPE = (float*)(ws + MS_ROPE); float* RSTDX = (float*)(ws + MS_RSTDX); float* RSTDC = (float*)(ws + MS_RSTDC);
    float* BIAS1 = (float*)(ws + MS_BIAS1); float* BIAS3 = (float*)(ws + MS_BIAS3); float* BIAS5 = (float*)(ws + MS_BIAS5);
    float* SSQ = (float*)(ws + WS_SSQ);
    bf16* WQKVG = (bf16*)(ws + WS_WQKVG); bf16* WO = (bf16*)(ws + WS_WO); bf16* WCI = (bf16*)(ws + WS_WCI); bf16* WCO = (bf16*)(ws + WS_WCO);
    bf16* W13[2] = {(bf16*)(ws + WS_W13_0), (bf16*)(ws + WS_W13_1)};
    bf16* XB = (bf16*)(ws + WS_XB); bf16* QB = (bf16*)(ws + WS_Q); bf16* KB = (bf16*)(ws + WS_K); bf16* VT = (bf16*)(ws + WS_VT);
    bf16* SFB = (bf16*)(ws + WS_SF); bf16* SBB = (bf16*)(ws + WS_SB); bf16* KC = (bf16*)(ws + WS_KC); bf16* VCT = (bf16*)(ws + WS_VCT); bf16* ACB = (bf16*)(ws + WS_ACB);
    bf16* HID = (bf16*)(ws + WS_HID); bf16* CU = (bf16*)(ws + WS_CU); bf16* CB = (bf16*)(ws + WS_CB); bf16* ACV = (bf16*)(ws + WS_ACV);
    bf16* GB = (bf16*)args.out;
    const float* x = args.in[IN_X];

    for (int u = tid0; u < (LDS_BYTES - 131072) / 4; u += NTHR) ((LAS unsigned*)(lds + 131072))[u] = 0u;
    __syncthreads();
    const bool multi = (args.ph_hi - args.ph_lo) > 1;
    XcdBarrier bar; bar.bar = ctl + CW_BAR; bar.x = 0; bar.st = nullptr;
    if (multi) bar = xcd_barrier_post(ctl + CW_BAR, MISC + 8);

#ifndef PROBE_DUP
#define PROBE_DUP -1
#endif
#ifndef SSVAR
#define SSVAR 0
#endif
    for (int ph0 = args.ph_lo; ph0 < args.ph_hi; ) {
        const int sq_ = ph0++; const int ph = (sq_ < 4) ? sq_ : (sq_ == 4 ? 13 : sq_ - 1); constexpr int rep = 0;
        const int tid = opaque((int)threadIdx.x), lane = tid & 63;
        switch (ph) {
        case 0: if (PHMASK & (1<<0)) {
            { LAS float* sl = (LAS float*)(lds + 131072); LAS f32x4* red = (LAS f32x4*)lds;
              for (int i = tid; i < 3 * D; i += NTHR) { const int r = i >> 10, k = i & (D - 1); sl[i] = siluf(r < 2 ? args.in[IN_C][r * D + k] : args.in[IN_CCTX][k]); }
              __syncthreads();
              for (int it = bx; it < 256; it += G) {
                  const int l = it >> 7, c0 = (it & 127) * 48, cg = tid % 12, kg = tid / 12;
                  if (tid < 504) {
                      const float* W = args.in[IN_ADAW] + (size_t)l * D * NQ + c0 + 4 * cg;
                      f32x4 a0 = {0.f, 0.f, 0.f, 0.f}, a1 = a0, a2 = a0;
#pragma unroll 5
                      for (int k = kg; k < D; k += 42) { const f32x4 w = *(const f32x4*)(W + (size_t)k * NQ); a0 += w * sl[k]; a1 += w * sl[D + k]; a2 += w * sl[2 * D + k]; }
                      red[(kg * 12 + cg) * 3 + 0] = a0; red[(kg * 12 + cg) * 3 + 1] = a1; red[(kg * 12 + cg) * 3 + 2] = a2;
                  }
                  __syncthreads();
                  if (tid < 36) { const int cg2 = tid / 3, r = tid % 3; f32x4 t = *(const f32x4*)(args.in[IN_ADAB] + l * NQ + c0 + 4 * cg2);
                      for (int q = 0; q < 42; ++q) t += red[(q * 12 + cg2) * 3 + r];
                      *(f32x4*)(ADA + (l * 3 + r) * NQ + c0 + 4 * cg2) = t; }
                  __syncthreads();
              }
            }
            { constexpr int I_QKVG = 16 * 96, I_WO = 32 * 16, I_W2 = 44 * 16, I_WCO = 16 * 16;
              constexpr int NIT = I_QKVG + I_WO + 2 * I_W2 + I_WCO;
              f32x4 d0, d1;
              for (int it = gw; it < NIT; it += NGW) {
                  int r = it;
                  if (r < I_QKVG) { const int kb = r / 96, nb = r % 96; tr64<false>(args.in[IN_WQKVG], NQ, D, WQKVG, nullptr, kb * 64, map_qkvg(nb * 64), nb * 64, nullptr, d0, d1, lane); continue; } r -= I_QKVG;
                  if (r < I_WO) { const int kb = r / 16, nb = r % 16; tr64<false>(args.in[IN_WO], D, 2048, WO, nullptr, kb * 64, nb * 64, nb * 64, nullptr, d0, d1, lane); continue; } r -= I_WO;
                  if (r < 2 * I_W2) { const int l = r / I_W2; r %= I_W2; const int kb = r / 16, nb = r % 16;
                      tr64<false>(args.in[IN_W2] + (size_t)l * FF * D, D, FF, (bf16*)(ws + (l ? WS_W2_1 : WS_W2_0)), nullptr, kb * 64, nb * 64, nb * 64, nullptr, d0, d1, lane); continue; } r -= 2 * I_W2;
                  { const int kb = r / 16, nb = r % 16; tr64<false>(args.in[IN_WCO], D, D, WCO, nullptr, kb * 64, nb * 64, nb * 64, nullptr, d0, d1, lane); }
              }
            }
        } break;
        case 1: if (PHMASK & (1<<1)) {
            const float* gain = args.in[IN_NMIX];
            const bool hasctx = vcu < 192;
            const bool isv = vcu >= 64; const int tl = isv ? vcu - 64 : vcu, rb = tl & 7, cbk = tl >> 3, row0 = 64 * rb, col0 = 128 * cbk;
            const int wt0 = (isv ? 4096 : 1024) + col0;
            if (hasctx) {
                LAS float* wt_ = (LAS float*)lds; LAS float* sh_ = wt_ + D; LAS float* rs_ = (LAS float*)(lds + 8192); LAS float* bs_ = rs_ + 64;
                LAS unsigned char* abuf = lds + 16384; LAS unsigned char* bbuf = lds + 16384 + 2 * 9216;
                for (int k = tid; k < D; k += NTHR) { wt_[k] = gain[k] * (1.0f + ADA[2 * NQ + D + k]); sh_[k] = ADA[2 * NQ + k]; }
                __syncthreads();
                const int arow = tid >> 3, aseg = tid & 7, brow = tid >> 2, bseg = tid & 3;
                const float* ap = args.in[IN_CTX] + (size_t)(row0 + arow) * D + 8 * aseg; const bf16* bp = WQKVG + (size_t)(wt0 + brow) * D + 16 * bseg;
                const int w4 = wave & 3, wr2 = wave >> 2, fr = lane & 15, fq = lane >> 4;
                const unsigned awr = (unsigned)(arow * 144 + aseg * 16), bwr = (unsigned)(brow * 144 + bseg * 32);
                const unsigned ard = (unsigned)((32 * wr2 + fr) * 144 + fq * 16), brd = (unsigned)((32 * w4 + fr) * 144 + fq * 16);
                f32x4 a_r[2][2]; u32x4 b_r[2][2]; float ssq = 0.f, bsum = 0.f;
                f32x4 acc[2][2];
#pragma unroll
                for (int m = 0; m < 2; ++m)
#pragma unroll
                    for (int n = 0; n < 2; ++n) acc[m][n] = (f32x4){0.f, 0.f, 0.f, 0.f};
#pragma unroll
                for (int c = 0; c < 2; ++c) { a_r[c][0] = *(const f32x4*)(ap + 64 * c); a_r[c][1] = *(const f32x4*)(ap + 64 * c + 4); b_r[c][0] = *(const u32x4*)(bp + 64 * c); b_r[c][1] = *(const u32x4*)(bp + 64 * c + 8); }
#pragma unroll 1
                for (int c2 = 0; c2 < 16; c2 += 2)
#pragma unroll
                for (int cur = 0; cur < 2; ++cur) { const int c = c2 + cur;
                    { const int k0 = 64 * c + 8 * aseg; const f32x4 w0 = *(const LAS f32x4*)(wt_ + k0), w1 = *(const LAS f32x4*)(wt_ + k0 + 4); const f32x4 x0 = a_r[cur][0], x1 = a_r[cur][1];
                      ssq += (x0[0] * x0[0] + x0[1] * x0[1]) + (x0[2] * x0[2] + x0[3] * x0[3]) + (x1[0] * x1[0] + x1[1] * x1[1]) + (x1[2] * x1[2] + x1[3] * x1[3]);
                      *(LAS u32x4*)(abuf + cur * 9216 + awr) = pack8(x0 * w0, x1 * w1); }
                    { const int kb = 64 * c + 16 * bseg;
#pragma unroll
                      for (int h = 0; h < 2; ++h) { float f[8]; unpack8(b_r[cur][h], f); const f32x4 s0 = *(const LAS f32x4*)(sh_ + kb + 8 * h), s1 = *(const LAS f32x4*)(sh_ + kb + 8 * h + 4);
                          bsum += (f[0] * s0[0] + f[1] * s0[1]) + (f[2] * s0[2] + f[3] * s0[3]) + (f[4] * s1[0] + f[5] * s1[1]) + (f[6] * s1[2] + f[7] * s1[3]);
                          *(LAS u32x4*)(bbuf + cur * 18432 + bwr + 16 * h) = b_r[cur][h]; } }
                    { const int cn = (c + 2 < 16) ? c + 2 : 15;
                      a_r[cur][0] = *(const f32x4*)(ap + 64 * cn); a_r[cur][1] = *(const f32x4*)(ap + 64 * cn + 4); b_r[cur][0] = *(const u32x4*)(bp + 64 * cn); b_r[cur][1] = *(const u32x4*)(bp + 64 * cn + 8); }
                    __syncthreads();
#pragma unroll
                    for (int ks = 0; ks < 2; ++ks) { bf16x8 af[2], bfg[2];
#pragma unroll
                        for (int m = 0; m < 2; ++m) af[m] = *(const LAS bf16x8*)(abuf + cur * 9216 + ard + m * (16 * 144) + ks * 64);
#pragma unroll
                        for (int n = 0; n < 2; ++n) bfg[n] = *(const LAS bf16x8*)(bbuf + cur * 18432 + brd + n * (16 * 144) + ks * 64);
#pragma unroll
                        for (int m = 0; m < 2; ++m)
#pragma unroll
                            for (int n = 0; n < 2; ++n) acc[m][n] = isv ? __builtin_amdgcn_mfma_f32_16x16x32_bf16(af[m], bfg[n], acc[m][n], 0, 0, 0) : __builtin_amdgcn_mfma_f32_16x16x32_bf16(bfg[n], af[m], acc[m][n], 0, 0, 0); }
                }
                { float t = ssq; t += __shfl_xor(t, 1); t += __shfl_xor(t, 2); t += __shfl_xor(t, 4); if (aseg == 0) rs_[arow] = 1.0f / sqrtf(t * (1.0f / D) + EPS);
                  float u_ = bsum; u_ += __shfl_xor(u_, 1); u_ += __shfl_xor(u_, 2); if (bseg == 0) bs_[brow] = u_; }
                __syncthreads();
                const int b = rb >> 2;
                if (!isv) {
#pragma unroll
                    for (int m = 0; m < 2; ++m) { const int rl = 32 * wr2 + 16 * m + fr; const float rsd = rs_[rl];
#pragma unroll
                        for (int n = 0; n < 2; ++n) { const int cl = 32 * w4 + 16 * n + 4 * fq; const f32x4 bb = *(const LAS f32x4*)(bs_ + cl);
                            const f32x4 o = (acc[m][n] * rsd + bb) * 0.0625f;
                            u32x2 w; w.x = pk2(o[0], o[1]); w.y = pk2(o[2], o[3]); *(u32x2*)(KC + (size_t)(row0 + rl) * D + col0 + cl) = w; } }
                } else {
#pragma unroll
                    for (int m = 0; m < 2; ++m) { const int tl0 = 32 * wr2 + 16 * m + 4 * fq; const f32x4 rs = *(const LAS f32x4*)(rs_ + tl0);
#pragma unroll
                        for (int n = 0; n < 2; ++n) { const int cl = 32 * w4 + 16 * n + fr, c = col0 + cl, h = c >> 9, e = c & 511; const f32x4 o = acc[m][n] * rs + bs_[cl];
                            u32x2 w; w.x = pk2(o[0], o[1]); w.y = pk2(o[2], o[3]); *(u32x2*)(VCT + (size_t)((b * NH + h) * DV + e) * CTXL + ((row0 + tl0) & (CTXL - 1))) = w; } }
                }
                biasrows<4>(WQKVG + (size_t)(4 * (vcu * 8 + wave)) * D, ADA, 0, 2, BIAS1 + 4 * (vcu * 8 + wave), lane);
            } else {
                const int wk = (vcu - 192) * 8 + wave, NWK = (G - 192) * 8;
                for (int r = 4 * wk; r < P1_R1; r += 4 * NWK) modrows<4>(x + (size_t)r * D, gain, ADA + (r >> 13) * NQ + D, XB + (size_t)r * D, RSTDX + r, lane);
            }
            { const int r = P1_R1 + 4 * (vcu * 8 + wave); modrows<4>(x + (size_t)r * D, gain, ADA + (r >> 13) * NQ + D, XB + (size_t)r * D, RSTDX + r, lane); }
            if constexpr (P1_RW > 4) { const int r = P1_R1 + 8192 + (P1_RW - 4) * (vcu * 8 + wave); modrows<P1_RW - 4>(x + (size_t)r * D, gain, ADA + (r >> 13) * NQ + D, XB + (size_t)r * D, RSTDX + r, lane); }
        } break;
        case 2: if (PHMASK & (1<<2)) {
            if (G1SEL & 1) { pg8::Gemm g{XB, WQKVG, M, 4096, D, 0}; pg8::StaticOrder S; S.init(M, 4096, G, bx);
              EpiQKG E{QB, KB, GB, RSTDX, BIAS1};
              pg8::gemm_phase<EpiQKG, pg8::StaticOrder, true, true, false>(lds, g, S, E, tid); }
            { pg8::Gemm g{XB, WQKVG + (size_t)4096 * D, M, 2048, D, 0}; pg8::StaticOrder S; S.init(M, 2048, G, bx);
              EpiVT E{VT, RSTDX, BIAS1 + 4096, SEQ, 32, -1};
              pg8::gemm_phase<EpiVT, pg8::StaticOrder, true, true, true>(lds, g, S, E, tid); }
        } break;
        case 3: if (PHMASK & (1<<3)) {
            constexpr int KP = 136, BUFB = (64 + 64 + 128) * KP * 2, NST = 34;
            static_assert(2 * BUFB <= MISC_OFF, "SS LDS map");
            for (int u = bx; u < 256; u += G) {
                const int grp = u & 1, bh = (u >> 1) & 7, dkt = (u >> 4) & 3, dvt = u >> 6, b = bh >> 2, h = bh & 3, dk0 = 64 * dkt, dv0 = 128 * dvt;
                const float lgf = __builtin_bit_cast(float, __builtin_amdgcn_readfirstlane(__builtin_bit_cast(int, __builtin_amdgcn_logf(1.0f - __builtin_amdgcn_exp2f(-5.0f - (float)h)))));
                const float lgb = __builtin_bit_cast(float, __builtin_amdgcn_readfirstlane(__builtin_bit_cast(int, __builtin_amdgcn_logf(1.0f - __builtin_amdgcn_exp2f(-5.5f - (float)h)))));
                __syncthreads();
#define SS_DEC(s_) const bool ic_ = (s_) < 2; const int c_ = grp ? (ic_ ? 1 - (s_) : 65 - (s_)) : (ic_ ? (s_) : (s_) - 2); const int q_ = ic_ ? c_ : (c_ & 3), nq_ = ic_ ? 2 : 4
                if (wave >= 4) {
                    const int pt = tid - 256;
                    float wKf[4], wKb[4];
#pragma unroll
                    for (int p = 0; p < 4; ++p) { const int t = 4 * (pt >> 3) + p; wKf[p] = __builtin_amdgcn_exp2f((float)(127 - t) * lgf); wKb[p] = __builtin_amdgcn_exp2f((float)t * lgb); }
                    u32x4 kr0[4], vr0[8], kr1[4], vr1[8], kr2[4], vr2[8];
#define SSP_LOAD(step, kr, vr) do { const int s_ = (step); SS_DEC(s_); (void)q_; (void)nq_; const int t_ = opaque(pt); \
                        const bf16* ks_ = (ic_ ? KC + (size_t)(b * CTXL + c_ * 128) * D : KB + (size_t)(b * SEQ + c_ * 128) * D) + h * DK + dk0; \
                        const int ld_ = ic_ ? CTXL : 128; const bf16* vs_ = ic_ ? VCT + (size_t)(bh * DV + dv0) * CTXL + c_ * 128 : VT + ((size_t)((bh * 64 + c_) * DV + dv0)) * 128; \
                        _Pragma("unroll") for (int p = 0; p < 4; ++p) kr[p] = *(const u32x4*)(ks_ + (unsigned)((4 * (t_ >> 3) + p) * D + 8 * (t_ & 7))); \
                        _Pragma("unroll") for (int q = 0; q < 8; ++q) vr[q] = *(const u32x4*)(vs_ + (unsigned)(((t_ >> 4) + 16 * q) * ld_ + 8 * (t_ & 15))); } while (0)
#define SSP_WRITE(step, kr, vr) do { const int sw_ = (step); SS_DEC(sw_); (void)c_; LAS bf16* kf_ = (LAS bf16*)(lds + (sw_ & 1) * BUFB); LAS bf16* kb_ = kf_ + 64 * KP; LAS bf16* vt_ = kb_ + 64 * KP; const int t_ = opaque(pt); \
                        const float cf_ = __builtin_amdgcn_exp2f((float)(128 * (nq_ - 1 - q_)) * lgf), cb_ = __builtin_amdgcn_exp2f((float)(128 * q_) * lgb); \
                        { float f0_[8], f1_[8], f2_[8], f3_[8]; unpack8(kr[0], f0_); unpack8(kr[1], f1_); unpack8(kr[2], f2_); unpack8(kr[3], f3_); \
                          const int c8_ = t_ & 7, tg_ = t_ >> 3, pos_ = (((tg_ >> 1) ^ c8_) << 3) | (4 * (tg_ & 1)); \
                          const float wf0_ = wKf[0] * cf_, wf1_ = wKf[1] * cf_, wf2_ = wKf[2] * cf_, wf3_ = wKf[3] * cf_, wb0_ = wKb[0] * cb_, wb1_ = wKb[1] * cb_, wb2_ = wKb[2] * cb_, wb3_ = wKb[3] * cb_; \
                          _Pragma("unroll") for (int e = 0; e < 8; ++e) { u32x2 wf_, wb_; wf_.x = pk2(f0_[e] * wf0_, f1_[e] * wf1_); wf_.y = pk2(f2_[e] * wf2_, f3_[e] * wf3_); wb_.x = pk2(f0_[e] * wb0_, f1_[e] * wb1_); wb_.y = pk2(f2_[e] * wb2_, f3_[e] * wb3_); \
                              *(LAS u32x2*)(kf_ + (8 * c8_ + e) * KP + pos_) = wf_; *(LAS u32x2*)(kb_ + (8 * c8_ + e) * KP + pos_) = wb_; } } \
                        _Pragma("unroll") for (int q = 0; q < 8; ++q) *(LAS u32x4*)(vt_ + ((t_ >> 4) + 16 * q) * KP + 8 * (t_ & 15)) = vr[q]; } while (0)
#define SSP_STEP(s, krN, vrN, krF, vrF) do { const int s__ = (s); SSP_LOAD(s__ + 3 <= NST - 1 ? s__ + 3 : NST - 1, krF, vrF); SSP_WRITE(s__ + 1, krN, vrN); __syncthreads(); } while (0)
                    SSP_LOAD(0, kr0, vr0); SSP_LOAD(1, kr1, vr1); SSP_LOAD(2, kr2, vr2); SSP_WRITE(0, kr0, vr0); __syncthreads();
                    static_assert(NST % 3 == 1, "tail step below");
                    for (int s3 = 0; s3 < NST - 1; s3 += 3) { SSP_STEP(s3, kr1, vr1, kr0, vr0); SSP_STEP(s3 + 1, kr2, vr2, kr1, vr1); SSP_STEP(s3 + 2, kr0, vr0, kr2, vr2); }
                    SSP_STEP(NST - 1, kr1, vr1, kr0, vr0);
#undef SSP_LOAD
#undef SSP_WRITE
#undef SSP_STEP
                } else {
                    const int wr = wave >> 1, wc = wave & 1, fr = lane & 15, fq = lane >> 4;
                    f32x4 accf[2][4], accb[2][4];
#pragma unroll
                    for (int i = 0; i < 2; ++i)
#pragma unroll
                        for (int j = 0; j < 4; ++j) { accf[i][j] = (f32x4){0.f, 0.f, 0.f, 0.f}; accb[i][j] = (f32x4){0.f, 0.f, 0.f, 0.f}; }
                    __syncthreads();
                    for (int s = 0; s < NST; ++s) {
                        { const LAS bf16* kf = (const LAS bf16*)(lds + (s & 1) * BUFB); const LAS bf16* kb = kf + 64 * KP; const LAS bf16* vt = kb + 64 * KP;
#pragma unroll
                          for (int ks = 0; ks < 4; ++ks) { bf16x8 XF[2], XB_[2], Y[4];
#pragma unroll
                              for (int i = 0; i < 2; ++i) { const int o_ = (32 * wr + 16 * i + fr) * KP + (((4 * ks + fq) ^ (4 * wr + 2 * i + (fr >> 3))) & 7) * 8 + 64 * (ks >> 1);
                                  XF[i] = *(const LAS bf16x8*)(kf + o_); XB_[i] = *(const LAS bf16x8*)(kb + o_); }
#pragma unroll
                              for (int j = 0; j < 4; ++j) Y[j] = *(const LAS bf16x8*)(vt + (64 * wc + 16 * j + fr) * KP + 32 * ks + 8 * fq);
#pragma unroll
                              for (int i = 0; i < 2; ++i)
#pragma unroll
                                  for (int j = 0; j < 4; ++j) { accf[i][j] = __builtin_amdgcn_mfma_f32_16x16x32_bf16(XF[i], Y[j], accf[i][j], 0, 0, 0); accb[i][j] = __builtin_amdgcn_mfma_f32_16x16x32_bf16(XB_[i], Y[j], accb[i][j], 0, 0, 0); } } }
                        __syncthreads();
                        SS_DEC(s);
                        if (grp ? (q_ == 0) : (q_ == nq_ - 1)) {
                            const int sc = c_ >> 2;
                            const int fslot = grp ? ((!ic_ && sc <= 14) ? sc + 1 : -1) : (ic_ ? 0 : sc + 1), bslot = grp ? (ic_ ? 15 : sc - 1) : ((!ic_ && sc >= 1) ? sc - 1 : -1);
                            const size_t eo = (size_t)(dv0 + 64 * wc + fr) * DK + dk0 + 32 * wr + 4 * fq;
                            if (fslot >= 0) { bf16* dst = SFB + (size_t)(bh * NSC + fslot) * DV * DK + eo;
#pragma unroll
                                for (int i = 0; i < 2; ++i)
#pragma unroll
                                    for (int j = 0; j < 4; ++j) { u32x2 w; w.x = pk2(accf[i][j][0], accf[i][j][1]); w.y = pk2(accf[i][j][2], accf[i][j][3]); *(u32x2*)(dst + (size_t)(16 * j) * DK + 16 * i) = w; } }
                            if (bslot >= 0) { bf16* dst = SBB + (size_t)(bh * NSC + bslot) * DV * DK + eo;
#pragma unroll
                                for (int i = 0; i < 2; ++i)
#pragma unroll
                                    for (int j = 0; j < 4; ++j) { u32x2 w; w.x = pk2(accb[i][j][0], accb[i][j][1]); w.y = pk2(accb[i][j][2], accb[i][j][3]); *(u32x2*)(dst + (size_t)(16 * j) * DK + 16 * i) = w; } }
                            const float mf = grp ? 0.f : __builtin_amdgcn_exp2f(512.0f * lgf), mb = grp ? __builtin_amdgcn_exp2f(512.0f * lgb) : 0.f;
#pragma unroll
                            for (int i = 0; i < 2; ++i)
#pragma unroll
                                for (int j = 0; j < 4; ++j) { accf[i][j] *= mf; accb[i][j] *= mb; }
                        }
                    }
                }
#undef SS_DEC
            }
        } break;
        case 4: if (PHMASK & (1<<4)) {
            constexpr int SLOT = 40960, PBUF = 3 * SLOT, REDB = PBUF + 32768;
            static_assert(REDB + 2048 <= MISC_OFF, "B' LDS map");
            const int wr = wave >> 2, wc = wave & 3;
#define BP_WAITV(n) do { switch (n) { case 0: asm volatile("s_waitcnt vmcnt(0)" ::: "memory"); break; case 4: asm volatile("s_waitcnt vmcnt(4)" ::: "memory"); break; \
                    case 5: asm volatile("s_waitcnt vmcnt(5)" ::: "memory"); break; default: asm volatile("s_waitcnt vmcnt(0)" ::: "memory"); break; } } while (0)
#define BP_GLDS(srcp, dstoff) __builtin_amdgcn_global_load_lds((const unsigned*)(srcp), (LAS unsigned*)(lds + (dstoff)), 16, 0, 0)
            for (int unit = vcu; unit < 512; unit += G) {
                const int bh = unit >> 6, c = unit & 63, b = bh >> 2, h = bh & 3, sc = c >> 2, cq = c & 3;
                const float lgf = __builtin_amdgcn_logf(1.0f - __builtin_amdgcn_exp2f(-5.0f - (float)h)), lgb = __builtin_amdgcn_logf(1.0f - __builtin_amdgcn_exp2f(-5.5f - (float)h));
                const bf16* Qsrc = QB + (size_t)(b * SEQ + c * 128) * D + h * DK;
                const bf16* Ksrc = KB + (size_t)(b * SEQ + sc * SC) * D + h * DK;
                const bf16* SFsrc = SFB + (size_t)((bh * NSC + sc) * DV) * DK; const bf16* SBsrc = SBB + (size_t)((bh * NSC + sc) * DV) * DK;
                const bf16* Vsrc = VT + (size_t)((bh * 64 + sc * 4) * DV) * 128;
                f32x4 acc[4][8], sacc[4][2];
#pragma unroll
                for (int m = 0; m < 4; ++m)
#pragma unroll
                    for (int n = 0; n < 8; ++n) acc[m][n] = (f32x4){0.f, 0.f, 0.f, 0.f};
#define BP_ISSUE(idx) do { const int i_ = (idx); const int so_ = (i_ % 3) * SLOT; const int l_ = opaque(lane); \
                    if (i_ < 16) { const int s_ = i_ & 7; const bf16* bs_ = (i_ < 8 ? SFsrc : SBsrc) + 32 * s_; const int rr_ = l_ >> 2, ch_ = (l_ & 3) ^ ((l_ >> 4) & 3); \
                        BP_GLDS(Qsrc + (unsigned)((16 * wave + rr_) * D + 32 * s_ + 8 * ch_), so_ + wave * 1024); \
                        _Pragma("unroll") for (int q = 0; q < 4; ++q) BP_GLDS(bs_ + (unsigned)((16 * (wave + 8 * q) + rr_) * DK + 8 * ch_), so_ + 8192 + (wave + 8 * q) * 1024); } \
                    else { const int j_ = (i_ - 16) >> 3, r8_ = (i_ - 16) & 7; \
                        if (r8_ < 4) { const int rr_ = l_ >> 3, ch_ = (l_ & 7) ^ ((l_ >> 4) & 3) ^ (4 * (wave & 1)); \
                            _Pragma("unroll") for (int q = 0; q < 2; ++q) { const int row_ = 8 * (wave + 8 * q) + rr_; \
                                BP_GLDS(Qsrc + (unsigned)(row_ * D + 64 * r8_ + 8 * ch_), so_ + (wave + 8 * q) * 1024); \
                                BP_GLDS(Ksrc + (unsigned)((128 * j_ + row_) * D + 64 * r8_ + 8 * ch_), so_ + 16384 + (wave + 8 * q) * 1024); } } \
                        else { const int rr_ = l_ >> 2, ch_ = (l_ & 3) ^ ((l_ >> 4) & 3); const bf16* bs_ = Vsrc + (size_t)j_ * (DV * 128) + 32 * (r8_ - 4); \
                            _Pragma("unroll") for (int q = 0; q < 4; ++q) BP_GLDS(bs_ + (unsigned)((16 * (wave + 8 * q) + rr_) * 128 + 8 * ch_), so_ + 8192 + (wave + 8 * q) * 1024); } } } while (0)
#define BP_NLOADS(idx) (((idx) >= 48) ? 0 : ((idx) < 16 ? 5 : 4))
#define BP_TOP(idx) do { BP_WAITV(BP_NLOADS((idx) + 1)); asm volatile("s_waitcnt lgkmcnt(0)" ::: "memory"); __builtin_amdgcn_s_barrier(); asm volatile("" ::: "memory"); \
                    if ((idx) + 2 < 48) BP_ISSUE((idx) + 2); } while (0)
#define BP_MMA_FULL(AADDR, so) do { bf16x8 af_[4]; const int l_ = opaque(lane), fr = l_ & 15, fq = l_ >> 4; \
                    _Pragma("unroll") for (int m = 0; m < 4; ++m) af_[m] = *(const LAS bf16x8*)(lds + AADDR(64 * wr + 16 * m + fr, fr, fq)); \
                    _Pragma("unroll") for (int nh = 0; nh < 4; ++nh) { bf16x8 bf_[2]; \
                        _Pragma("unroll") for (int n = 0; n < 2; ++n) bf_[n] = *(const LAS bf16x8*)(lds + (so) + 8192 + (128 * wc + 32 * nh + 16 * n + fr) * 64 + ((fq ^ (fr >> 2)) & 3) * 16); \
                        _Pragma("unroll") for (int m = 0; m < 4; ++m) _Pragma("unroll") for (int n = 0; n < 2; ++n) \
                            acc[m][2 * nh + n] = __builtin_amdgcn_mfma_f32_16x16x32_bf16(bf_[n], af_[m], acc[m][2 * nh + n], 0, 0, 0); } } while (0)
                __builtin_amdgcn_s_barrier();
                BP_ISSUE(0); BP_ISSUE(1);
                for (int idx = 0; idx < 16; ++idx) {
                    BP_TOP(idx);
                    const int so = (idx % 3) * SLOT;
#define AADDR_X(row, fr, fq) (so + (row) * 64 + (((fq) ^ ((fr) >> 2)) & 3) * 16)
                    BP_MMA_FULL(AADDR_X, so);
#undef AADDR_X
                    if (idx == 7 || idx == 15) { const int fr = opaque(lane) & 15;
#pragma unroll
                        for (int m = 0; m < 4; ++m) { const int il = 128 * cq + 64 * wr + 16 * m + fr;
                            const float sc_ = (idx == 7) ? __builtin_amdgcn_exp2f((float)(il + 1) * lgf - (float)(SC - il) * lgb) : __builtin_amdgcn_exp2f((float)(SC - il) * lgb);
#pragma unroll
                            for (int n = 0; n < 8; ++n) acc[m][n] *= sc_; }
                    }
                }
                for (int j = 0; j < 4; ++j) {
#pragma unroll
                    for (int m = 0; m < 4; ++m) { sacc[m][0] = (f32x4){0.f, 0.f, 0.f, 0.f}; sacc[m][1] = (f32x4){0.f, 0.f, 0.f, 0.f}; }
                    for (int r = 0; r < 4; ++r) {
                        const int idx = 16 + 8 * j + r;
                        BP_TOP(idx);
                        const int so = (idx % 3) * SLOT;
                        { const int l_ = opaque(lane), fr = l_ & 15, fq = l_ >> 4;
#pragma unroll
                          for (int ks = 0; ks < 2; ++ks) { bf16x8 af_[4], kf_[2]; const int cx = ((4 * ks + fq) ^ (fr >> 1)) & 7;
#pragma unroll
                              for (int m = 0; m < 4; ++m) af_[m] = *(const LAS bf16x8*)(lds + so + (64 * wr + 16 * m + fr) * 128 + cx * 16);
#pragma unroll
                              for (int n = 0; n < 2; ++n) kf_[n] = *(const LAS bf16x8*)(lds + so + 16384 + (32 * wc + 16 * n + fr) * 128 + cx * 16);
#pragma unroll
                              for (int m = 0; m < 4; ++m)
#pragma unroll
                                  for (int n = 0; n < 2; ++n) sacc[m][n] = __builtin_amdgcn_mfma_f32_16x16x32_bf16(kf_[n], af_[m], sacc[m][n], 0, 0, 0); } }
                        if (r == 3) {
                            const int l_ = opaque(lane), fr = l_ & 15, fq = l_ >> 4;
#pragma unroll
                            for (int m = 0; m < 4; ++m)
#pragma unroll
                                for (int n = 0; n < 2; ++n) { const int il = 128 * cq + 64 * wr + 16 * m + fr, jl0 = 128 * j + 32 * wc + 16 * n + 4 * fq; float pv[4];
#pragma unroll
                                    for (int e = 0; e < 4; ++e) { const int dl = il - (jl0 + e);
                                        const float dec = dl > 0 ? __builtin_amdgcn_exp2f((float)dl * lgf) : (dl < 0 ? __builtin_amdgcn_exp2f((float)(-dl) * lgb) : 2.0f); pv[e] = sacc[m][n][e] * dec; }
                                    u32x2 w; w.x = pk2(pv[0], pv[1]); w.y = pk2(pv[2], pv[3]);
                                    *(LAS u32x2*)(lds + PBUF + (64 * wr + 16 * m + fr) * 256 + (((4 * wc + 2 * n + (fq >> 1)) ^ fr) & 15) * 16 + (fq & 1) * 8) = w; }
                        }
                    }
                    for (int r = 0; r < 4; ++r) {
                        const int idx = 16 + 8 * j + 4 + r;
                        BP_TOP(idx);
                        const int so = (idx % 3) * SLOT;
#define AADDR_P(row, fr, fq) (PBUF + (row) * 256 + (((4 * r + (fq)) ^ (fr)) & 15) * 16)
                        BP_MMA_FULL(AADDR_P, so);
#undef AADDR_P
                    }
                }
                asm volatile("s_waitcnt vmcnt(0) lgkmcnt(0)" ::: "memory"); __builtin_amdgcn_s_barrier(); asm volatile("" ::: "memory");
                { LAS float* red = (LAS float*)(lds + REDB); const int l_ = opaque(lane), fr = l_ & 15, fq = l_ >> 4;
#pragma unroll
                  for (int m = 0; m < 4; ++m) { float ss = 0.f;
#pragma unroll
                      for (int n = 0; n < 8; ++n) ss += (acc[m][n][0] * acc[m][n][0] + acc[m][n][1] * acc[m][n][1]) + (acc[m][n][2] * acc[m][n][2] + acc[m][n][3] * acc[m][n][3]);
                      ss += __shfl_xor(ss, 16); ss += __shfl_xor(ss, 32);
                      if (fq == 0) red[(64 * wr + 16 * m + fr) * 4 + wc] = ss; }
                  __syncthreads();
                  bf16* gp0 = GB + (size_t)(b * SEQ + c * 128 + 64 * wr + fr) * 2048 + h * DV + 128 * wc + 4 * fq;
#pragma unroll
                  for (int mh = 0; mh < 4; mh += 2) {
                      u32x2 gw[2][8];
#pragma unroll
                      for (int q = 0; q < 2; ++q)
#pragma unroll
                          for (int n = 0; n < 8; ++n) gw[q][n] = *(const u32x2*)(gp0 + (size_t)(16 * (mh + q)) * 2048 + 16 * n);
#pragma unroll
                      for (int q = 0; q < 2; ++q) { const int m = mh + q, row = 64 * wr + 16 * m + fr; const f32x4 t4 = *(const LAS f32x4*)(red + row * 4);
                          const float rs = 1.0f / sqrtf(((t4[0] + t4[1]) + (t4[2] + t4[3])) * (1.0f / DV) + EPS);
                          bf16* gp = gp0 + (size_t)(16 * m) * 2048;
#pragma unroll
                          for (int n = 0; n < 8; ++n) {
                              const float o0 = siluf(bflo(gw[q][n].x)) * acc[m][n][0] * rs, o1 = siluf(bfhi(gw[q][n].x)) * acc[m][n][1] * rs, o2 = siluf(bflo(gw[q][n].y)) * acc[m][n][2] * rs, o3 = siluf(bfhi(gw[q][n].y)) * acc[m][n][3] * rs;
                              u32x2 w; w.x = pk2(o0, o1); w.y = pk2(o2, o3); if (!(PROBE_DUP == 4 && rep == 1)) *(u32x2*)(gp + 16 * n) = w; } } }
                  __syncthreads();
                }
            }
#undef BP_WAITV
#undef BP_GLDS
#undef BP_ISSUE
#undef BP_NLOADS
#undef BP_TOP
#undef BP_MMA_FULL
        } break;
        case 5: case 7: case 10: case 12: if (PHMASK & (1<<5)) {
            const int l = (ph >= 10) ? 1 : 0; const float* adal = ADA + l * 3 * NQ;
            if (ph == 5) WPREP_JOBS(0, 1, gw, NGW);
            pg8::StaticOrder S; S.init(M, D, G, bx);
            if (ph == 12) {
                pg8::Gemm g{HID, (const bf16*)(ws + WS_W2_1), M, D, FF, 0};
                EpiResFinal E{XB, args.out, adal + 5 * D, args.in[IN_FN], (float*)(ws + MS_XPART), ctl, lds + RSTD_LDS};
                pg8::gemm_phase<EpiResFinal, pg8::StaticOrder, true, true, false>(lds, g, S, E, tid);
            } else {
                pg8::Gemm g; EpiRes E;
                if (ph == 5) { g = pg8::Gemm{GB, WO, M, D, 2048, 0}; E = EpiRes{x, nullptr, XB, adal + 2 * D, SSQ, 0}; }
                else if (ph == 7) { g = pg8::Gemm{HID, (const bf16*)(ws + WS_W2_0), M, D, FF, 0}; E = EpiRes{nullptr, XB, XB, adal + 5 * D, SSQ, 0}; }
                else { g = pg8::Gemm{ACV, WCO, M, D, D, 0}; E = EpiRes{nullptr, XB, XB, adal + 2 * D, SSQ, 0}; }
                E.dry = (PROBE_DUP == ph && rep == 1) ? 1 : 0;
                pg8::gemm_phase<EpiRes, pg8::StaticOrder, true, true, false>(lds, g, S, E, tid);
            }
        } break;
        case 6: case 11: if (PHMASK & (1<<6)) {
            const int l = (ph == 11) ? 1 : 0;
            pg8::Gemm g{XB, W13[l], M, 5632, D, (size_t)5632 * D * 2}; pg8::StaticOrder S; S.init(M, 5632, G, bx);
#define BS_FFN(u, t) bias_sum(BIAS3 + (l * 2 + ((u).pm >> 5)) * NKQ * 5632, 5632, (u).pn * 256 + (t))
            BUILD_TABS(S, RS_SSQ, BS_FFN);
#undef BS_FFN
            EpiSwiGLU E{HID, (const LAS float*)(lds + RSTD_LDS), (const LAS float*)(lds + BIAS_LDS), (PROBE_DUP == ph && rep == 1 && SSVAR == 21) ? 1 : 0};
            pg8::gemm_phase<EpiSwiGLU, pg8::StaticOrder, true, true, false>(lds, g, S, E, tid);
            if (ph == 6 && bx >= 128) WPREP_JOBS(1, 3, (bx - 128) * NWAVES + wave, (G - 128) * NWAVES);
        } break;
        case 8: if (PHMASK & (1<<8)) {
            pg8::Gemm g{XB, WCI, M, 3072, D, (size_t)3072 * D * 2}; pg8::StaticOrder S; S.init(M, 3072, G, bx);
#define BS_CI(u, t) bias_sum(BIAS5 + ((u).pm >> 5) * NKQ * 3072, 3072, (u).pn * 256 + (t))
            BUILD_TABS(S, RS_SSQ, BS_CI);
#undef BS_CI
            EpiConvIn E{CU, CB, (const LAS float*)(lds + RSTD_LDS), (const LAS float*)(lds + BIAS_LDS)};
            pg8::gemm_phase<EpiConvIn, pg8::StaticOrder, true, true, false>(lds, g, S, E, tid);
        } break;
        case 9: if (PHMASK & (1<<9)) {
            const float* cw = args.in[IN_CW];
            for (int it = bx * NTHR + tid; it < M * (D / 8); it += G * NTHR) {
                const int r = it >> 7, k = (it & 127) * 8, t = r & (SEQ - 1);
                float u0[8], um[8], up[8], bb[8];
                unpack8(*(const u32x4*)(CU + (size_t)r * D + k), u0); unpack8(*(const u32x4*)(CB + (size_t)r * D + k), bb);
                if (t > 0) unpack8(*(const u32x4*)(CU + (size_t)(r - 1) * D + k), um); else { for (int q = 0; q < 8; ++q) um[q] = 0.f; }
                if (t < SEQ - 1) unpack8(*(const u32x4*)(CU + (size_t)(r + 1) * D + k), up); else { for (int q = 0; q < 8; ++q) up[q] = 0.f; }
                float o[8];
#pragma unroll
                for (int q = 0; q < 8; ++q) o[q] = bb[q] * (cw[k + q] * um[q] + cw[D + k + q] * u0[q] + cw[2 * D + k + q] * up[q]);
                u32x4 w; w.x = pk2(o[0], o[1]); w.y = pk2(o[2], o[3]); w.z = pk2(o[4], o[5]); w.w = pk2(o[6], o[7]);
                *(u32x4*)(ACV + (size_t)r * D + k) = w;
            }
        } break;
        case 13: if (PHMASK & (1<<13)) {
            for (int v = bx * NTHR + tid; v < 2 * 131072; v += G * NTHR) {
                const int dir = v >> 17, w = v & 131071, bh_ = w >> 14, h = bh_ & 3;
                bf16* base = (dir ? SBB : SFB) + (size_t)bh_ * NSC * DV * DK + (size_t)(w & 16383) * 8;
                const float g512 = __builtin_amdgcn_exp2f(512.0f * __builtin_amdgcn_logf(1.0f - __builtin_amdgcn_exp2f(-(dir ? 5.5f : 5.0f) - (float)h)));
                u32x4 r[8];
#pragma unroll
                for (int k = 0; k < 8; ++k) r[k] = *(const u32x4*)(base + (size_t)(dir ? 7 - k : 8 + k) * DV * DK);
                float S[8]; unpack8(r[0], S);
#pragma unroll
                for (int k = 1; k < 8; ++k) { float f[8]; unpack8(r[k], f);
#pragma unroll
                    for (int e = 0; e < 8; ++e) S[e] = S[e] * g512 + f[e];
                    u32x4 o; o.x = pk2(S[0], S[1]); o.y = pk2(S[2], S[3]); o.z = pk2(S[4], S[5]); o.w = pk2(S[6], S[7]);
                    *(u32x4*)(base + (size_t)(dir ? 7 - k : 8 + k) * DV * DK) = o; }
            }
        } break;
        default: break;
        }
        if (ph0 < args.ph_hi) xcd_barrier(bar);
        if (SSVAR == 6 && ph == 6) { for (int e_ = 0; e_ < 10; ++e_) xcd_barrier(bar); }
    }
}

#ifndef MK_PER_PHASE
#define MK_PER_PHASE 0
#endif
extern "C" void kernel_launch(void* const* d_in, const int* in_sizes, int n_in, void* d_out, int out_size, void* d_ws, size_t ws_size, hipStream_t stream) {
    static int grid = 0;
    if (grid == 0) {
        if (n_in != N_IN || out_size != M * D || ws_size < WS_END) { fprintf(stderr, "kernel_launch: unexpected shapes (n_in %d, out %d, ws %zu); nothing launched\n", n_in, out_size, ws_size); grid = -1; return; }
        int dev = 0, cus = 0, per_cu = 0;
        if (hipGetDevice(&dev) != hipSuccess || hipDeviceGetAttribute(&cus, hipDeviceAttributeMultiprocessorCount, dev) != hipSuccess) { grid = -1; return; }
        if (hipFuncSetAttribute((const void*)fwd_kernel, hipFuncAttributeMaxDynamicSharedMemorySize, LDS_BYTES) != hipSuccess) { fprintf(stderr, "kernel_launch: hipFuncSetAttribute failed\n"); grid = -1; return; }
        if (hipOccupancyMaxActiveBlocksPerMultiprocessor(&per_cu, (const void*)fwd_kernel, NTHR, LDS_BYTES) != hipSuccess || per_cu < 1) { fprintf(stderr, "kernel_launch: occupancy query says %d blocks per CU\n", per_cu); }
        (void)hipGetLastError();
        grid = cus;
    }
    if (grid < 0) return;
    (void)hipMemsetAsync((char*)d_ws + WS_CTL, 0, CTL_ZERO_BYTES, stream);
    Args a{};
    for (int i = 0; i < N_IN; ++i) a.in[i] = (const float*)d_in[i];
    a.out = (float*)d_out; a.ws = (unsigned char*)d_ws;
#if MK_PER_PHASE
    for (int p = 0; p < NPH; ++p) { a.ph_lo = p; a.ph_hi = p + 1; hipLaunchKernelGGL(fwd_kernel, dim3(grid), dim3(NTHR), LDS_BYTES, stream, a); }
#else
    a.ph_lo = 0; a.ph_hi = NPH; hipLaunchKernelGGL(fwd_kernel, dim3(grid), dim3(NTHR), LDS_BYTES, stream, a);
#if SSVAR == 7
    (void)hipMemsetAsync((char*)d_ws + WS_CTL, 0, CTL_ZERO_BYTES, stream); hipLaunchKernelGGL(fwd_kernel, dim3(grid), dim3(NTHR), LDS_BYTES, stream, a);
#endif
#endif
}
```

```cpp
#include <hip/hip_runtime.h>
#include <cstdio>
#include <cstdint>

#define LAS __attribute__((address_space(3)))
#define GAS __attribute__((address_space(1)))
typedef unsigned short bf16;
typedef short bf16x8 __attribute__((ext_vector_type(8)));
typedef float f32x4 __attribute__((ext_vector_type(4)));
typedef float f32x2 __attribute__((ext_vector_type(2)));
typedef unsigned u32x4 __attribute__((ext_vector_type(4)));
typedef unsigned u32x2 __attribute__((ext_vector_type(2)));

__device__ __forceinline__ int opaque(int v) { asm volatile("" : "+v"(v)); return v; }
constexpr int D = 1024, BATCH = 2, SEQ = 8192, M = BATCH * SEQ, CTXL = 256, MC = BATCH * CTXL, NH = 4, DK = 256, DV = 512, FF = 2816, NQ = 6 * D;
constexpr int SC = 512, NSC = SEQ / SC;
constexpr float EPS = 1e-6f;
constexpr int NWAVES = 8, NTHR = 512;

constexpr size_t MiB = 1u << 20, HMiB = 1u << 19;
constexpr size_t WS_CTL = 0, CTL_ZERO_BYTES = 1 * MiB;
constexpr size_t CTL_ADA = 65536;
constexpr size_t WS_MISC = 1 * MiB;
constexpr size_t MS_ROPE = WS_MISC;
constexpr size_t MS_RSTDX = MS_ROPE + 65536;
constexpr size_t MS_RSTDC = MS_RSTDX + 65536;
constexpr size_t MS_BIAS1 = MS_RSTDC + 4096;
constexpr int NKQ = 8;
constexpr size_t MS_BIAS3 = 262144;
constexpr size_t MS_BIAS5 = MS_BIAS1 + 3 * 6144 * 4;
static_assert(MS_BIAS3 + 4 * NKQ * 5632 * 4 <= 1 * MiB && MS_BIAS5 + 2 * NKQ * 3072 * 4 <= 1 * MiB + 512 * 1024, "misc region");
constexpr size_t MS_XPART = 1 * MiB + 512 * 1024;
constexpr size_t WS_SSQ = 2 * MiB;
constexpr size_t WS_WQKVG = 3 * MiB;
constexpr size_t WS_WO = 15 * MiB;
constexpr size_t WS_W2_0 = 19 * MiB;
constexpr size_t WS_W2_1 = 24 * MiB + HMiB;
constexpr size_t WS_WCO = 30 * MiB;
constexpr size_t WS_ACB = 60 * MiB;
constexpr size_t WS_XB = 61 * MiB;
constexpr size_t WS_Q = 93 * MiB;
constexpr size_t WS_K = 125 * MiB;
constexpr size_t WS_VT = 157 * MiB;
constexpr size_t WS_SB = 221 * MiB;
constexpr size_t WS_KC = 253 * MiB;
constexpr size_t WS_VCT = 254 * MiB;
constexpr size_t WS_SF = WS_XB;
constexpr size_t WS_HID = 93 * MiB;
constexpr size_t WS_CU = 93 * MiB, WS_CB = 125 * MiB, WS_ACV = 157 * MiB;
constexpr size_t WS_W13_0 = 181 * MiB;
constexpr size_t WS_WCI = 203 * MiB;
constexpr size_t WS_W13_1 = 215 * MiB;
constexpr size_t WS_END = 256 * MiB;

namespace pg8 {
typedef unsigned short bf16_t;
constexpr int BM = 256, BK = 64, HALF = 128, HTB = HALF * BK * 2, STAGE_BYTES = 8 * HTB, NXCD = 8, WGM = 8;
__host__ __device__ __forceinline__ int lds_byte(int r, int c) { const int st = (r >> 4) * 2 + (c >> 5), rr = r & 15, cc = c & 31, ob = rr * 64 + cc * 2; return st * 1024 + (ob ^ (((ob >> 9) & 1) << 5)); }
__host__ __device__ __forceinline__ void stage_rc(int b, int& R, int& C) { const int st = b / 1024, sb = b % 1024, swz = sb ^ (((sb >> 9) & 1) << 5); R = (st >> 1) * 16 + swz / 64; C = (st & 1) * 32 + (swz % 64) / 2; }
__host__ __device__ __forceinline__ int perm32(int rho) { const int n = rho >> 4, i = rho & 15; return 8 * (i >> 2) + 4 * n + (i & 3); }
struct Unit { int pm, pn; };
struct Gemm { const bf16_t* A; const bf16_t* Bt; int M, N, K; size_t bstride; };
struct StaticOrder {
    int nM, nN, nwg, G, c;
    __host__ __device__ void init(int M_, int N_, int G_, int c_) { nM = M_ / BM; nN = N_ / BM; nwg = nM * nN; G = G_; c = c_; }
    __host__ __device__ bool next(int i, Unit& u) const {
        const long L = (long)i * G + c; if (L >= nwg) return false;
        int wgid = (int)L; { const int q = nwg / NXCD, r = nwg % NXCD, xcd = wgid % NXCD, off = wgid / NXCD; wgid = (xcd < r ? xcd * (q + 1) : r * (q + 1) + (xcd - r) * q) + off; }
        const int nig = WGM * nN, gid = wgid / nig, fm = gid * WGM, gsz = (nM - fm) < WGM ? (nM - fm) : WGM;
        u.pm = fm + ((wgid % nig) % gsz); u.pn = (wgid % nig) / gsz; return true;
    }
    __device__ __forceinline__ void a_ready(const Unit&) const {}
    __device__ __forceinline__ void done(const Unit&) const {}
};
struct OneUnit { int pm, pn; bool have;
    __device__ __forceinline__ bool next(int i, Unit& u) const { if (i != 0 || !have) return false; u.pm = pm; u.pn = pn; return true; }
    __device__ __forceinline__ void a_ready(const Unit&) const {}
    __device__ __forceinline__ void done(const Unit&) const {}
};
template <class Epi, class Sched, bool ALIGN_EPI, bool SP2, bool SWAP>
__device__ __forceinline__ void gemm_phase(LAS unsigned char* lds, const Gemm g, const Sched& S, const Epi& E, const int tid) {
    const int wid = __builtin_amdgcn_readfirstlane(tid >> 6), wr = wid >> 2, wc = wid & 3;
    int lane = tid & 63, fr = lane & 15, fq = lane >> 4;
    const int K = g.K, nt = K / BK;
    unsigned voffA[2], voffB[2]; int aoff, boff;
#define PG8_SETUP() do { const int t_ = opaque(tid); lane = t_ & 63; fr = lane & 15; fq = lane >> 4; \
        _Pragma("unroll") for (int i = 0; i < 2; ++i) { int R, C; stage_rc(t_ * 16 + i * 8192, R, C); const int Rp = (R & ~31) + perm32(R & 31); \
            voffA[i] = (unsigned)((SWAP ? Rp : R) * K + C) * 2u; voffB[i] = (unsigned)((SWAP ? R : Rp) * K + C) * 2u; } \
        aoff = lds_byte(wr * 64 + fr, fq * 8); boff = lds_byte(wc * 32 + fr, fq * 8); } while (0)
    PG8_SETUP();
    const size_t kstep = (size_t)(BK * 2);
    const size_t hstep = (size_t)HALF * K * 2;
    const size_t tstep = 2 * hstep;
    const unsigned ldsw = (unsigned)wid * 1024u;
#define PG8_SA(b, h) (((b) * 2 + (h)) * HTB)
#define PG8_SB(b, h) ((4 + (b) * 2 + (h)) * HTB)
#define PG8_STAGE(bufoff, gbase, voff) do { _Pragma("unroll") for (int _i = 0; _i < 2; ++_i) \
        __builtin_amdgcn_global_load_lds((const unsigned*)((const char*)(gbase) + (voff)[_i]), (LAS unsigned*)(lds + (bufoff) + ldsw + _i * 8192), 16, 0, 0); } while (0)
#define PG8_LDA(dst, b, h) do { _Pragma("unroll") for (int m = 0; m < 4; ++m) _Pragma("unroll") for (int k = 0; k < 2; ++k) dst[m][k] = *(const LAS bf16x8*)(lds + PG8_SA(b, h) + aoff + m * 2048 + k * 1024); } while (0)
#define PG8_LDB(dst, b, h) do { _Pragma("unroll") for (int n = 0; n < 2; ++n) _Pragma("unroll") for (int k = 0; k < 2; ++k) dst[n][k] = *(const LAS bf16x8*)(lds + PG8_SB(b, h) + boff + n * 2048 + k * 1024); } while (0)
#define PG8_MMA(ai, bj, At, Bt) do { __builtin_amdgcn_s_setprio(1); _Pragma("unroll") for (int m = 0; m < 4; ++m) _Pragma("unroll") for (int n = 0; n < 2; ++n) _Pragma("unroll") for (int k = 0; k < 2; ++k) \
        acc[ai][bj][m][n] = SWAP ? __builtin_amdgcn_mfma_f32_16x16x32_bf16(At[m][k], Bt[n][k], acc[ai][bj][m][n], 0, 0, 0) \
                                 : __builtin_amdgcn_mfma_f32_16x16x32_bf16(Bt[n][k], At[m][k], acc[ai][bj][m][n], 0, 0, 0); __builtin_amdgcn_s_setprio(0); } while (0)
#define PG8_WAIT_V(n) asm volatile("s_waitcnt vmcnt(" #n ")" ::: "memory")
#define PG8_WAIT_L(n) asm volatile("s_waitcnt lgkmcnt(" #n ")" ::: "memory")
#define PG8_BAR __builtin_amdgcn_s_barrier()
#define PG8_SCHED __builtin_amdgcn_sched_barrier(0)
    Unit cur, nxt; int ui = 0;
    if (!S.next(0, cur)) return;
    f32x4 acc[2][2][4][2];
#pragma unroll
    for (int a = 0; a < 2; ++a)
#pragma unroll
        for (int b = 0; b < 2; ++b)
#pragma unroll
            for (int m = 0; m < 4; ++m)
#pragma unroll
                for (int n = 0; n < 2; ++n) acc[a][b][m][n] = (f32x4){0.f, 0.f, 0.f, 0.f};
    bf16x8 At[4][2], B0[2][2], B1[2][2];
    const char* cA = (const char*)g.A + (size_t)cur.pm * tstep; const char* cB = (const char*)g.Bt + (size_t)cur.pn * tstep + (cur.pm >= 32 ? g.bstride : 0);
    S.a_ready(cur);
    if constexpr (SP2) {
        PG8_STAGE(PG8_SB(0, 0), cB, voffB); PG8_STAGE(PG8_SB(0, 1), cB + hstep, voffB); PG8_STAGE(PG8_SA(0, 0), cA, voffA); PG8_STAGE(PG8_SA(0, 1), cA + hstep, voffA);
        if (wr == 1) PG8_BAR;
        PG8_WAIT_V(2); PG8_BAR;
        PG8_STAGE(PG8_SB(1, 0), cB + kstep, voffB); PG8_STAGE(PG8_SA(1, 0), cA + kstep, voffA); PG8_STAGE(PG8_SB(1, 1), cB + hstep + kstep, voffB);
        PG8_WAIT_V(6); PG8_BAR;
    } else {
        PG8_STAGE(PG8_SB(0, 0), cB, voffB); PG8_STAGE(PG8_SA(0, 0), cA, voffA); PG8_STAGE(PG8_SB(0, 1), cB + hstep, voffB); PG8_STAGE(PG8_SA(0, 1), cA + hstep, voffA);
        if (wr == 1) PG8_BAR;
        PG8_WAIT_V(4); PG8_BAR;
        PG8_STAGE(PG8_SB(1, 0), cB + kstep, voffB); PG8_STAGE(PG8_SA(1, 0), cA + kstep, voffA); PG8_STAGE(PG8_SB(1, 1), cB + hstep + kstep, voffB);
        PG8_WAIT_V(6); PG8_BAR;
    }
    for (;;) {
        const bool has_next = S.next(ui + 1, nxt);
        const char* nA = has_next ? (const char*)g.A + (size_t)nxt.pm * tstep : cA; const char* nB = has_next ? (const char*)g.Bt + (size_t)nxt.pn * tstep + (nxt.pm >= 32 ? g.bstride : 0) : cB;
        for (int t = 0; t < nt; t += 2) {
            const bool last = (t == nt - 2);
            const char* a1 = cA + (size_t)(t + 1) * kstep;
            const char* a2 = last ? nA : cA + (size_t)(t + 2) * kstep; const char* b2 = last ? nB : cB + (size_t)(t + 2) * kstep;
            const char* a3 = a2 + kstep; const char* b3 = b2 + kstep;
            if (last && has_next) S.a_ready(nxt);
            if constexpr (SP2) {
            PG8_LDB(B0, 0, 0); PG8_LDB(B1, 0, 1); PG8_SCHED; PG8_LDA(At, 0, 0); PG8_STAGE(PG8_SA(1, 1), a1 + hstep, voffA);
            PG8_WAIT_V(8); PG8_WAIT_L(0); PG8_BAR; PG8_MMA(0, 0, At, B0); PG8_MMA(0, 1, At, B1); PG8_BAR; PG8_SCHED;
            PG8_LDA(At, 0, 1); PG8_STAGE(PG8_SB(0, 0), b2, voffB); PG8_STAGE(PG8_SB(0, 1), b2 + hstep, voffB); PG8_STAGE(PG8_SA(0, 0), a2, voffA);
            PG8_WAIT_V(8); PG8_WAIT_L(0); PG8_BAR; PG8_MMA(1, 0, At, B0); PG8_MMA(1, 1, At, B1); PG8_BAR; PG8_SCHED;
            PG8_LDB(B0, 1, 0); PG8_LDB(B1, 1, 1); PG8_SCHED; PG8_LDA(At, 1, 0); PG8_STAGE(PG8_SA(0, 1), a2 + hstep, voffA);
            PG8_WAIT_V(8); PG8_WAIT_L(0); PG8_BAR; PG8_MMA(0, 0, At, B0); PG8_MMA(0, 1, At, B1); PG8_BAR; PG8_SCHED;
            PG8_LDA(At, 1, 1); PG8_STAGE(PG8_SB(1, 0), b3, voffB); PG8_STAGE(PG8_SB(1, 1), b3 + hstep, voffB); PG8_STAGE(PG8_SA(1, 0), a3, voffA);
            PG8_WAIT_V(8); PG8_WAIT_L(0); PG8_BAR; PG8_MMA(1, 0, At, B0); PG8_MMA(1, 1, At, B1); PG8_BAR; PG8_SCHED;
            } else {
            PG8_LDB(B0, 0, 0); PG8_SCHED; PG8_LDA(At, 0, 0); PG8_STAGE(PG8_SA(1, 1), a1 + hstep, voffA);
            PG8_WAIT_L(8); PG8_BAR; PG8_WAIT_L(0); PG8_MMA(0, 0, At, B0); PG8_BAR; PG8_SCHED;
            PG8_LDB(B1, 0, 1); PG8_STAGE(PG8_SB(0, 0), b2, voffB);
            PG8_BAR; PG8_WAIT_L(0); PG8_MMA(0, 1, At, B1); PG8_BAR;
            PG8_LDA(At, 0, 1); PG8_STAGE(PG8_SA(0, 0), a2, voffA);
            PG8_BAR; PG8_WAIT_L(0); PG8_MMA(1, 0, At, B0); PG8_BAR; PG8_SCHED;
            PG8_STAGE(PG8_SB(0, 1), b2 + hstep, voffB);
            PG8_WAIT_V(6); PG8_BAR; PG8_MMA(1, 1, At, B1); PG8_BAR;
            PG8_LDB(B0, 1, 0); PG8_SCHED; PG8_LDA(At, 1, 0); PG8_STAGE(PG8_SA(0, 1), a2 + hstep, voffA);
            PG8_WAIT_L(8); PG8_BAR; PG8_WAIT_L(0); PG8_MMA(0, 0, At, B0); PG8_BAR; PG8_SCHED;
            PG8_LDB(B1, 1, 1); PG8_STAGE(PG8_SB(1, 0), b3, voffB);
            PG8_BAR; PG8_WAIT_L(0); PG8_MMA(0, 1, At, B1); PG8_BAR;
            PG8_LDA(At, 1, 1); PG8_STAGE(PG8_SA(1, 0), a3, voffA);
            PG8_BAR; PG8_WAIT_L(0); PG8_MMA(1, 0, At, B0); PG8_BAR; PG8_SCHED;
            PG8_STAGE(PG8_SB(1, 1), b3 + hstep, voffB);
            PG8_WAIT_V(6); PG8_BAR; PG8_MMA(1, 1, At, B1); PG8_BAR;
            }
        }
        if constexpr (ALIGN_EPI) { if (wr == 0) PG8_BAR; }
        E(acc, cur, wr, wc, fr, fq, ui); S.done(cur);
        PG8_SETUP();
        if (!has_next) break;
#pragma unroll
        for (int a = 0; a < 2; ++a)
#pragma unroll
            for (int b = 0; b < 2; ++b)
#pragma unroll
                for (int m = 0; m < 4; ++m)
#pragma unroll
                    for (int n = 0; n < 2; ++n) acc[a][b][m][n] = (f32x4){0.f, 0.f, 0.f, 0.f};
        cur = nxt; cA = nA; cB = nB; ++ui;
        if constexpr (ALIGN_EPI) { if (wr == 1) PG8_BAR; }
    }
    PG8_WAIT_V(0);
    if constexpr (!ALIGN_EPI) { if (wr == 0) PG8_BAR; }
    PG8_BAR;
#undef PG8_SETUP
#undef PG8_SA
#undef PG8_SB
#undef PG8_STAGE
#undef PG8_LDA
#undef PG8_LDB
#undef PG8_MMA
#undef PG8_WAIT_V
#undef PG8_WAIT_L
#undef PG8_BAR
#undef PG8_SCHED
}
}

#define RLX_AGENT __ATOMIC_RELAXED, __HIP_MEMORY_SCOPE_AGENT
#define LDS_WAIT() asm volatile("s_waitcnt lgkmcnt(0)" ::: "memory")
typedef __bf16 hbf16x2 __attribute__((ext_vector_type(2)));
__device__ __forceinline__ unsigned pk2(float lo, float hi) { const f32x2 v = {lo, hi}; return __builtin_bit_cast(unsigned, __builtin_convertvector(v, hbf16x2)); }
__device__ __forceinline__ unsigned f2bf(float f) { return pk2(f, 0.f) & 0xffffu; }
__device__ __forceinline__ float bf2f(unsigned h) { return __builtin_bit_cast(float, h << 16); }
__device__ __forceinline__ float bflo(unsigned w) { return __builtin_bit_cast(float, w << 16); }
__device__ __forceinline__ float bfhi(unsigned w) { return __builtin_bit_cast(float, w & 0xffff0000u); }
__device__ __forceinline__ float siluf(float x) { return x * __builtin_amdgcn_rcpf(1.0f + __builtin_amdgcn_exp2f(-1.44269504089f * x)); }
__device__ __forceinline__ float wave_sum(float v) {
#pragma unroll
    for (int o = 1; o < 64; o <<= 1) v += __shfl_xor(v, o);
    return v;
}
__device__ __forceinline__ u32x4 pack8(const f32x4 a, const f32x4 b) { u32x4 w; w.x = pk2(a[0], a[1]); w.y = pk2(a[2], a[3]); w.z = pk2(b[0], b[1]); w.w = pk2(b[2], b[3]); return w; }

using pg8::Unit;
typedef f32x4 Acc[2][2][4][2];
struct EpiQKG {
    bf16* Q; bf16* K; bf16* G; const float* rstd; const float* bias;
    __device__ __forceinline__ void operator()(const Acc& acc, const Unit& u, int wr, int wc, int fr_, int fq_, int ui) const {
        const int fr = opaque(fr_), fq = opaque(fq_);
        const int b = u.pm >> 5; const float* bb = bias + b * NQ + u.pn * 256 + wc * 32 + 8 * fq;
        const int row0 = u.pm * 256 + wr * 64 + fr;
        f32x4 bv[2][2]; float rs[2][4];
#pragma unroll
        for (int ai = 0; ai < 2; ++ai)
#pragma unroll
            for (int m = 0; m < 4; ++m) rs[ai][m] = rstd[row0 + ai * 128 + m * 16];
#pragma unroll
        for (int bj = 0; bj < 2; ++bj)
#pragma unroll
            for (int n = 0; n < 2; ++n) bv[bj][n] = *(const f32x4*)(bb + bj * 128 + 4 * n);
        if (u.pn < 8) {
            const bool isk = u.pn >= 4; bf16* O = isk ? K : Q; const float osc = isk ? 0.0625f : 1.0f;
            const int a = wc >> 1, i0 = (wc & 1) * 32 + 8 * fq, colo = (u.pn & 3) * 256 + wc * 32 + 8 * fq;
            f32x4 frv[2];
#pragma unroll
            for (int n = 0; n < 2; ++n)
#pragma unroll
                for (int j = 0; j < 4; ++j) frv[n][j] = __builtin_amdgcn_exp2f(-(float)(i0 + 4 * n + j) * (13.287712379549449f / 64.0f)) * 0.15915494309189535f;
#pragma unroll
            for (int ai = 0; ai < 2; ++ai)
#pragma unroll
                for (int m = 0; m < 4; ++m) {
                    const int r = row0 + ai * 128 + m * 16; const float rsv = rs[ai][m]; const int t = r & (SEQ - 1); const float pos = (float)(a ? (t & 63) : (t >> 6));
                    f32x4 o1[2], o2[2];
#pragma unroll
                    for (int n = 0; n < 2; ++n) {
                        f32x4 cs, sn;
#pragma unroll
                        for (int j = 0; j < 4; ++j) { const float rv = __builtin_amdgcn_fractf(pos * frv[n][j]); cs[j] = __builtin_amdgcn_cosf(rv); sn[j] = __builtin_amdgcn_sinf(rv); }
                        const f32x4 x1 = acc[ai][0][m][n] * rsv + bv[0][n], x2 = acc[ai][1][m][n] * rsv + bv[1][n];
                        o1[n] = (x1 * cs - x2 * sn) * osc; o2[n] = (x1 * sn + x2 * cs) * osc;
                    }
                    bf16* rowp = O + (size_t)r * D + colo;
                    *(u32x4*)(rowp) = pack8(o1[0], o1[1]); *(u32x4*)(rowp + 128) = pack8(o2[0], o2[1]);
                }
        } else {
            const int colo = (u.pn - 8) * 256 + wc * 32 + 8 * fq;
#pragma unroll
            for (int ai = 0; ai < 2; ++ai)
#pragma unroll
                for (int m = 0; m < 4; ++m) {
                    const int r = row0 + ai * 128 + m * 16; const float rsv = rs[ai][m]; bf16* rowp = G + (size_t)r * 2048 + colo;
#pragma unroll
                    for (int bj = 0; bj < 2; ++bj) *(u32x4*)(rowp + bj * 128) = pack8(acc[ai][bj][m][0] * rsv + bv[bj][0], acc[ai][bj][m][1] * rsv + bv[bj][1]);
                }
        }
    }
};
struct EpiVT {
    bf16* VT; const float* rstd; const float* bias; int ldt; int tiles_per_b; int bias_row;
    __device__ __forceinline__ void operator()(const Acc& acc, const Unit& u, int wr, int wc, int fr_, int fq_, int ui) const {
        const int fr = opaque(fr_), fq = opaque(fq_);
        const int b = u.pm / tiles_per_b, t00 = (u.pm % tiles_per_b) * 256 + wr * 64 + 8 * fq, h = u.pn >> 1, e0 = (u.pn & 1) * 256 + wc * 32 + fr;
        const float* bb = bias + (bias_row < 0 ? b : bias_row) * NQ;
        float bs[2][2];
#pragma unroll
        for (int bj = 0; bj < 2; ++bj)
#pragma unroll
            for (int n = 0; n < 2; ++n) bs[bj][n] = bb[u.pn * 256 + bj * 128 + wc * 32 + n * 16 + fr];
        f32x4 rsv[2][2][2];
#pragma unroll
        for (int ai = 0; ai < 2; ++ai)
#pragma unroll
            for (int mp = 0; mp < 2; ++mp) { const float* rp = rstd + b * ldt + t00 + ai * 128 + mp * 32; rsv[ai][mp][0] = *(const f32x4*)rp; rsv[ai][mp][1] = *(const f32x4*)(rp + 4); }
#pragma unroll
        for (int ai = 0; ai < 2; ++ai)
#pragma unroll
            for (int mp = 0; mp < 2; ++mp) {
                const int tl = t00 + ai * 128 + mp * 32;
                const f32x4 r0 = rsv[ai][mp][0], r1 = rsv[ai][mp][1];
#pragma unroll
                for (int bj = 0; bj < 2; ++bj)
#pragma unroll
                    for (int n = 0; n < 2; ++n) {
                        const f32x4 v0 = acc[ai][bj][2 * mp][n] * r0 + bs[bj][n], v1 = acc[ai][bj][2 * mp + 1][n] * r1 + bs[bj][n];
                        bf16* p = VT + ((size_t)(((b * NH + h) * (ldt >> 7) + (tl >> 7)) * DV + e0 + bj * 128 + n * 16)) * 128 + (tl & 127);
                        *(u32x4*)p = pack8(v0, v1);
                    }
            }
    }
};
struct EpiRes {
    const float* res32; const bf16* res16; bf16* hx; const float* gate; float* ssq; int dry;
    __device__ __forceinline__ void operator()(const Acc& acc, const Unit& u, int wr, int wc, int fr_, int fq_, int ui) const {
        const int fr = opaque(fr_), fq = opaque(fq_);
        const int b = u.pm >> 5, col0 = u.pn * 256 + wc * 32 + 8 * fq, row0 = u.pm * 256 + wr * 64 + fr;
        f32x4 gv[2][2];
#pragma unroll
        for (int bj = 0; bj < 2; ++bj)
#pragma unroll
            for (int n = 0; n < 2; ++n) gv[bj][n] = *(const f32x4*)(gate + b * NQ + col0 + bj * 128 + 4 * n);
#pragma unroll
        for (int am = 0; am < 8; am += 2) {
            f32x4 rv[2][2][2];
            if (res32) {
#pragma unroll
                for (int q = 0; q < 2; ++q)
#pragma unroll
                    for (int bj = 0; bj < 2; ++bj) { const float* p = res32 + (size_t)(row0 + ((am + q) >> 2) * 128 + ((am + q) & 3) * 16) * D + col0 + bj * 128; rv[q][bj][0] = *(const f32x4*)p; rv[q][bj][1] = *(const f32x4*)(p + 4); }
            } else {
                u32x4 rw[2][2];
#pragma unroll
                for (int q = 0; q < 2; ++q)
#pragma unroll
                    for (int bj = 0; bj < 2; ++bj) rw[q][bj] = *(const u32x4*)(res16 + (size_t)(row0 + ((am + q) >> 2) * 128 + ((am + q) & 3) * 16) * D + col0 + bj * 128);
#pragma unroll
                for (int q = 0; q < 2; ++q)
#pragma unroll
                    for (int bj = 0; bj < 2; ++bj) { const u32x4 w = rw[q][bj]; rv[q][bj][0] = (f32x4){bflo(w.x), bfhi(w.x), bflo(w.y), bfhi(w.y)}; rv[q][bj][1] = (f32x4){bflo(w.z), bfhi(w.z), bflo(w.w), bfhi(w.w)}; }
            }
#pragma unroll
            for (int q = 0; q < 2; ++q) {
                const int ai = (am + q) >> 2, m = (am + q) & 3;
                const int r = row0 + ai * 128 + m * 16; const size_t off = (size_t)r * D + col0; float ss = 0.f;
#pragma unroll
                for (int bj = 0; bj < 2; ++bj) {
                    const f32x4 o0 = rv[q][bj][0] + gv[bj][0] * acc[ai][bj][m][0], o1 = rv[q][bj][1] + gv[bj][1] * acc[ai][bj][m][1];
                    ss += (o0[0] * o0[0] + o0[1] * o0[1]) + (o0[2] * o0[2] + o0[3] * o0[3]) + (o1[0] * o1[0] + o1[1] * o1[1]) + (o1[2] * o1[2] + o1[3] * o1[3]);
                    if (!dry) *(u32x4*)(hx + off + bj * 128) = pack8(o0, o1);
                }
                ss += __shfl_xor(ss, 16); ss += __shfl_xor(ss, 32);
                if (fq == 0) ssq[(size_t)r * 16 + u.pn * 4 + wc] = ss;
            }
        }
    }
};
constexpr int CW_PANEL = 8192;
struct EpiResFinal {
    const bf16* res16; float* out; const float* gate; const float* fn; float* xpart; unsigned* cnt; LAS unsigned char* ldsb;
    __device__ __forceinline__ void operator()(Acc& acc, const Unit& u, int wr, int wc, int fr_, int fq_, int ui) const {
        const int fr = opaque(fr_), fq = opaque(fq_), tid = opaque((int)threadIdx.x);
        const int b = u.pm >> 5, col0 = u.pn * 256 + wc * 32 + 8 * fq, row0 = u.pm * 256 + wr * 64 + fr;
        LAS float* part = (LAS float*)ldsb;
        LAS float* rtab = (LAS float*)(ldsb + 4096);
        f32x4 gv[2][2];
#pragma unroll
        for (int bj = 0; bj < 2; ++bj)
#pragma unroll
            for (int n = 0; n < 2; ++n) gv[bj][n] = *(const f32x4*)(gate + b * NQ + col0 + bj * 128 + 4 * n);
#pragma unroll
        for (int am = 0; am < 8; am += 2) {
            u32x4 rw[2][2];
#pragma unroll
            for (int q = 0; q < 2; ++q)
#pragma unroll
                for (int bj = 0; bj < 2; ++bj) rw[q][bj] = *(const u32x4*)(res16 + (size_t)(row0 + ((am + q) >> 2) * 128 + ((am + q) & 3) * 16) * D + col0 + bj * 128);
#pragma unroll
            for (int q = 0; q < 2; ++q) { const int ai = (am + q) >> 2, m = (am + q) & 3; float ss = 0.f;
#pragma unroll
                for (int bj = 0; bj < 2; ++bj) { const u32x4 w = rw[q][bj];
                    const f32x4 o0 = (f32x4){bflo(w.x), bfhi(w.x), bflo(w.y), bfhi(w.y)} + gv[bj][0] * acc[ai][bj][m][0], o1 = (f32x4){bflo(w.z), bfhi(w.z), bflo(w.w), bfhi(w.w)} + gv[bj][1] * acc[ai][bj][m][1];
                    ss += (o0[0] * o0[0] + o0[1] * o0[1]) + (o0[2] * o0[2] + o0[3] * o0[3]) + (o1[0] * o1[0] + o1[1] * o1[1]) + (o1[2] * o1[2] + o1[3] * o1[3]);
                    acc[ai][bj][m][0] = o0; acc[ai][bj][m][1] = o1; }
                ss += __shfl_xor(ss, 16); ss += __shfl_xor(ss, 32);
                if (fq == 0) part[(ai * 128 + wr * 64 + m * 16 + fr) * 4 + wc] = ss; }
        }
        asm volatile("s_waitcnt lgkmcnt(0)" ::: "memory"); __builtin_amdgcn_s_barrier(); asm volatile("" ::: "memory");
        if (tid < 256) { const f32x4 p4 = *(const LAS f32x4*)(part + tid * 4);
            __hip_atomic_store(xpart + (size_t)(u.pm * 256 + tid) * 4 + u.pn, (p4[0] + p4[1]) + (p4[2] + p4[3]), __ATOMIC_RELAXED, __HIP_MEMORY_SCOPE_AGENT); }
        asm volatile("s_waitcnt vmcnt(0)" ::: "memory"); __builtin_amdgcn_s_barrier(); asm volatile("" ::: "memory");
        if (tid == 0) { __hip_atomic_fetch_add(cnt + CW_PANEL + 64 * u.pm, 1u, __ATOMIC_RELAXED, __HIP_MEMORY_SCOPE_AGENT);
            unsigned sp = 0; while (__hip_atomic_load(cnt + CW_PANEL + 64 * u.pm, __ATOMIC_RELAXED, __HIP_MEMORY_SCOPE_AGENT) < 4u) { __builtin_amdgcn_s_sleep(2); if (++sp > (1u << 22)) break; } }
        asm volatile("s_waitcnt vmcnt(0) lgkmcnt(0)" ::: "memory"); __builtin_amdgcn_s_barrier(); asm volatile("" ::: "memory");
        if (tid < 256) { const float* xp = xpart + (size_t)(u.pm * 256 + tid) * 4; float t = 0.f;
#pragma unroll
            for (int q = 0; q < 4; ++q) t += __hip_atomic_load(xp + q, __ATOMIC_RELAXED, __HIP_MEMORY_SCOPE_AGENT);
            rtab[tid] = 1.0f / sqrtf(t * (1.0f / D) + EPS); }
        asm volatile("s_waitcnt vmcnt(0) lgkmcnt(0)" ::: "memory"); __builtin_amdgcn_s_barrier(); asm volatile("" ::: "memory");
        f32x4 fv[2][2];
#pragma unroll
        for (int bj = 0; bj < 2; ++bj)
#pragma unroll
            for (int n = 0; n < 2; ++n) fv[bj][n] = *(const f32x4*)(fn + col0 + bj * 128 + 4 * n);
#pragma unroll
        for (int ai = 0; ai < 2; ++ai)
#pragma unroll
            for (int m = 0; m < 4; ++m) { const float rs = rtab[ai * 128 + wr * 64 + m * 16 + fr]; float* op = out + (size_t)(row0 + ai * 128 + m * 16) * D + col0;
#pragma unroll
                for (int bj = 0; bj < 2; ++bj) { *(f32x4*)(op + bj * 128) = acc[ai][bj][m][0] * rs * fv[bj][0]; *(f32x4*)(op + bj * 128 + 4) = acc[ai][bj][m][1] * rs * fv[bj][1]; } }
    }
};
__device__ __forceinline__ float rstd_from_ssq(const float* ssq, int r) {
    const f32x4* p = (const f32x4*)(ssq + (size_t)r * 16); const f32x4 a = p[0], b = p[1], c = p[2], d = p[3];
    const float s = ((a[0] + a[1]) + (a[2] + a[3])) + ((b[0] + b[1]) + (b[2] + b[3])) + ((c[0] + c[1]) + (c[2] + c[3])) + ((d[0] + d[1]) + (d[2] + d[3]));
    return 1.0f / sqrtf(s * (1.0f / D) + EPS);
}
constexpr int RSTD_LDS = 131072, BIAS_LDS = 131072 + 8192;
struct EpiSwiGLU {
    bf16* HID; const LAS float* rtab; const LAS float* btab; int dry;
    __device__ __forceinline__ void operator()(const Acc& acc, const Unit& u, int wr, int wc, int fr_, int fq_, int ui) const {
        const int fr = opaque(fr_), fq = opaque(fq_); if (dry) return;
        f32x4 bv[2][2]; float rs[2][4];
#pragma unroll
        for (int ai = 0; ai < 2; ++ai)
#pragma unroll
            for (int m = 0; m < 4; ++m) rs[ai][m] = rtab[ui * 256 + ai * 128 + wr * 64 + m * 16 + fr];
#pragma unroll
        for (int bj = 0; bj < 2; ++bj)
#pragma unroll
            for (int n = 0; n < 2; ++n) bv[bj][n] = *(const LAS f32x4*)(btab + ui * 256 + bj * 128 + wc * 32 + 8 * fq + 4 * n);
        const int row0 = u.pm * 256 + wr * 64 + fr, colo = u.pn * 128 + wc * 32 + 8 * fq;
#pragma unroll
        for (int ai = 0; ai < 2; ++ai)
#pragma unroll
            for (int m = 0; m < 4; ++m) {
                const int r = row0 + ai * 128 + m * 16;
                f32x4 hv[2];
#pragma unroll
                for (int n = 0; n < 2; ++n) { const f32x4 a1 = acc[ai][0][m][n] * rs[ai][m] + bv[0][n], a3 = acc[ai][1][m][n] * rs[ai][m] + bv[1][n];
#pragma unroll
                    for (int j = 0; j < 4; ++j) hv[n][j] = siluf(a1[j]) * a3[j]; }
                *(u32x4*)(HID + (size_t)r * FF + colo) = pack8(hv[0], hv[1]);
            }
    }
};
struct EpiConvIn {
    bf16* CU; bf16* CB; const LAS float* rtab; const LAS float* btab;
    __device__ __forceinline__ void operator()(const Acc& acc, const Unit& u, int wr, int wc, int fr_, int fq_, int ui) const {
        const int fr = opaque(fr_), fq = opaque(fq_);
        f32x4 bv[2][2]; float rs[2][4];
#pragma unroll
        for (int ai = 0; ai < 2; ++ai)
#pragma unroll
            for (int m = 0; m < 4; ++m) rs[ai][m] = rtab[ui * 256 + ai * 128 + wr * 64 + m * 16 + fr];
#pragma unroll
        for (int bj = 0; bj < 2; ++bj)
#pragma unroll
            for (int n = 0; n < 2; ++n) bv[bj][n] = *(const LAS f32x4*)(btab + ui * 256 + bj * 128 + wc * 32 + 8 * fq + 4 * n);
        const int row0 = u.pm * 256 + wr * 64 + fr;
#pragma unroll
        for (int ai = 0; ai < 2; ++ai)
#pragma unroll
            for (int m = 0; m < 4; ++m) {
                const int r = row0 + ai * 128 + m * 16; const float rs_ = rs[ai][m];
                if (u.pn < 8) {
                    const f32x4 u0 = (acc[ai][0][m][0] * rs_ + bv[0][0]) * (acc[ai][1][m][0] * rs_ + bv[1][0]), u1 = (acc[ai][0][m][1] * rs_ + bv[0][1]) * (acc[ai][1][m][1] * rs_ + bv[1][1]);
                    *(u32x4*)(CU + (size_t)r * D + u.pn * 128 + wc * 32 + 8 * fq) = pack8(u0, u1);
                } else {
#pragma unroll
                    for (int bj = 0; bj < 2; ++bj) *(u32x4*)(CB + (size_t)r * D + (u.pn - 8) * 256 + bj * 128 + wc * 32 + 8 * fq) = pack8(acc[ai][bj][m][0] * rs_ + bv[bj][0], acc[ai][bj][m][1] * rs_ + bv[bj][1]);
                }
            }
    }
};

#define XB_TMO      128
#define XB_XCNT(j)  (256  + 64 * (j))
#define XB_XSUB(j)  (1280 + 64 * (j))
#define XB_XGEN(j)  (2304 + 64 * (j))
#define XB_TOP      3328
#define XB_TOPGEN   3392
#define XCD_BAR_WORDS 3456
#define XB_SPIN_CAP (1u << 20)
__device__ __forceinline__ unsigned xb_ld(unsigned* p)              { return __hip_atomic_load(p, __ATOMIC_RELAXED, __HIP_MEMORY_SCOPE_AGENT); }
__device__ __forceinline__ unsigned xb_add(unsigned* p, unsigned v) { return __hip_atomic_fetch_add(p, v, __ATOMIC_RELAXED, __HIP_MEMORY_SCOPE_AGENT); }
__device__ __forceinline__ unsigned xb_xcc_id() { return (unsigned)__builtin_amdgcn_s_getreg((3 << 11) | 20) & 0xFu; }
#define XB_SPIN(cond, bar) do { unsigned _sp = 0; while (cond) { __builtin_amdgcn_s_sleep(1); \
    if ((++_sp & 255u) == 0u) { if (xb_ld(&(bar)[XB_TMO])) break; if (_sp > XB_SPIN_CAP) { atomicAdd(&(bar)[XB_TMO], 1u); break; } } } } while (0)
struct XcdBarrier { unsigned* bar; unsigned x; volatile LAS unsigned* st; };
__device__ __forceinline__ XcdBarrier xcd_barrier_post(unsigned* bar, volatile LAS unsigned* st) {
    XcdBarrier b; b.bar = bar; b.x = xb_xcc_id(); b.st = st;
    if (threadIdx.x == 0) (void)xb_add(&bar[XB_XCNT(b.x)], 1u);
    return b;
}
__device__ __forceinline__ void xcd_barrier_complete(unsigned* bar, unsigned x, unsigned& nloc, unsigned& nx) {
    const unsigned G = gridDim.x * gridDim.y * gridDim.z;
    unsigned sum, cnt, mine, sp = 0u;
    for (;;) {
        sum = 0u; cnt = 0u; mine = 0u;
#pragma unroll
        for (unsigned j = 0; j < 16; ++j) { const unsigned c = xb_ld(&bar[XB_XCNT(j)]); sum += c; cnt += (c > 0u) ? 1u : 0u; mine = (j == x) ? c : mine; }
        if (sum == G) break;
        __builtin_amdgcn_s_sleep(1);
        if ((++sp & 255u) == 0u) { if (xb_ld(&bar[XB_TMO])) break; if (sp > XB_SPIN_CAP) { atomicAdd(&bar[XB_TMO], 1u); break; } }
    }
    nloc = mine > 0u ? mine : 1u; nx = cnt > 0u ? cnt : 1u;
}
__device__ __forceinline__ void xcd_barrier(const XcdBarrier& b) {
    asm volatile("s_waitcnt vmcnt(0)" ::: "memory");
    __syncthreads();
    if (threadIdx.x == 0) {
        unsigned* bar = b.bar;
        __builtin_amdgcn_s_waitcnt(0);
        unsigned nloc = b.st[0], nx = b.st[1];
        if (nloc == 0u) { xcd_barrier_complete(bar, b.x, nloc, nx); b.st[0] = nloc; b.st[1] = nx; }
        const unsigned old = xb_add(&bar[XB_XSUB(b.x)], 1u);
        const unsigned gen = old / nloc;
        if (old + 1u == (gen + 1u) * nloc) {
            __builtin_amdgcn_fence(__ATOMIC_RELEASE, "agent");
            asm volatile("s_waitcnt vmcnt(0)" ::: "memory");
            const unsigned og = xb_add(&bar[XB_TOP], 1u);
            const unsigned tg = og / nx;
            if (og + 1u == (tg + 1u) * nx) xb_add(&bar[XB_TOPGEN], 1u);
            else XB_SPIN(xb_ld(&bar[XB_TOPGEN]) == tg, bar);
            __builtin_amdgcn_fence(__ATOMIC_ACQUIRE, "agent");
            xb_add(&bar[XB_XGEN(b.x)], 1u);
            asm volatile("s_waitcnt vmcnt(0)" ::: "memory");
        } else {
            XB_SPIN(xb_ld(&bar[XB_XGEN(b.x)]) == gen, bar);
            __builtin_amdgcn_fence(__ATOMIC_ACQUIRE, "agent");
            asm volatile("s_waitcnt vmcnt(0)" ::: "memory");
        }
    }
    __syncthreads();
}

enum { IN_X = 0, IN_C, IN_CTX, IN_CCTX, IN_ADAW, IN_ADAB, IN_NMIX, IN_NFFN, IN_WQKVG, IN_WO, IN_WCI, IN_CW, IN_WCO, IN_W1, IN_W3, IN_W2, IN_FN, N_IN };
struct Args { const float* in[N_IN]; float* out; unsigned char* ws; int ph_lo, ph_hi; };
constexpr int CW_BAR = 4096;
constexpr int LDS_BYTES = 163840, MISC_OFF = 163712;
constexpr int NPH = 14;
#ifndef P1_RW
#define P1_RW 5
#endif
#define P1_R1 (16384 - 2048 * P1_RW)
#ifndef G1SEL
#define G1SEL 7
#endif
#ifndef PHMASK
#define PHMASK 0xFFFF
#endif

__device__ __forceinline__ void transpose_item(const float* W, int Nsrc, int K, bf16* WT, int k0, int n_src0, int dst_row0, LAS float* scr, int lane) {
#pragma unroll
    for (int i = 0; i < 32; ++i) { const int kk = 2 * i + (lane >> 5); scr[kk * 33 + (lane & 31)] = W[(size_t)(k0 + kk) * Nsrc + n_src0 + (lane & 31)]; }
    LDS_WAIT(); asm volatile("" ::: "memory");
    const int c = lane & 7;
#pragma unroll
    for (int j = 0; j < 4; ++j) { const int n = (lane >> 3) + 8 * j; const LAS float* s = scr + (8 * c) * 33 + n;
        u32x4 o; o.x = pk2(s[0 * 33], s[1 * 33]); o.y = pk2(s[2 * 33], s[3 * 33]); o.z = pk2(s[4 * 33], s[5 * 33]); o.w = pk2(s[6 * 33], s[7 * 33]);
        *(u32x4*)(WT + (size_t)(dst_row0 + n) * K + k0 + 8 * c) = o; }
    LDS_WAIT(); asm volatile("" ::: "memory");
}
__device__ __forceinline__ void transpose_item_scaled(const float* W, int Nsrc, bf16* WT0, bf16* WT1, int k0, int n_src0, int dst_row0, LAS float* scr, const LAS float* tab, float& a0, float& a1, int lane) {
    LAS float* s0 = scr; LAS float* s1 = scr + 64 * 33;
#pragma unroll
    for (int i = 0; i < 32; ++i) { const int kk = 2 * i + (lane >> 5); const float w = W[(size_t)(k0 + kk) * Nsrc + n_src0 + (lane & 31)];
        s0[kk * 33 + (lane & 31)] = w * tab[k0 + kk]; s1[kk * 33 + (lane & 31)] = w * tab[1024 + k0 + kk]; a0 += w * tab[2048 + k0 + kk]; a1 += w * tab[3072 + k0 + kk]; }
    LDS_WAIT(); asm volatile("" ::: "memory");
    const int c = lane & 7;
#pragma unroll
    for (int j = 0; j < 4; ++j) { const int n = (lane >> 3) + 8 * j; const LAS float* p0 = s0 + (8 * c) * 33 + n; const LAS float* p1 = s1 + (8 * c) * 33 + n;
        u32x4 o; o.x = pk2(p0[0 * 33], p0[1 * 33]); o.y = pk2(p0[2 * 33], p0[3 * 33]); o.z = pk2(p0[4 * 33], p0[5 * 33]); o.w = pk2(p0[6 * 33], p0[7 * 33]);
        *(u32x4*)(WT0 + (size_t)(dst_row0 + n) * D + k0 + 8 * c) = o;
        o.x = pk2(p1[0 * 33], p1[1 * 33]); o.y = pk2(p1[2 * 33], p1[3 * 33]); o.z = pk2(p1[4 * 33], p1[5 * 33]); o.w = pk2(p1[6 * 33], p1[7 * 33]);
        *(u32x4*)(WT1 + (size_t)(dst_row0 + n) * D + k0 + 8 * c) = o; }
    LDS_WAIT(); asm volatile("" ::: "memory");
}
template <bool SCALED>
__device__ __forceinline__ void tr64(const float* W, int Nsrc, int K, bf16* WT0, bf16* WT1, int k0, int n_src0, int dst_row0, const LAS float* tab, f32x4& a0, f32x4& a1, int lane) {
    const int n4 = lane & 15, kr = lane >> 4;
    const float* src = W + (size_t)(k0 + 16 * kr) * Nsrc + n_src0 + 4 * n4;
    f32x4 v[16];
#pragma unroll
    for (int i = 0; i < 16; ++i) v[i] = *(const f32x4*)(src + (size_t)i * Nsrc);
    if constexpr (!SCALED) {
#pragma unroll
        for (int j = 0; j < 4; ++j) { bf16* drow = WT0 + (size_t)(dst_row0 + 4 * n4 + j) * K + k0 + 16 * kr;
#pragma unroll
            for (int h = 0; h < 2; ++h) { u32x4 o; o.x = pk2(v[8 * h][j], v[8 * h + 1][j]); o.y = pk2(v[8 * h + 2][j], v[8 * h + 3][j]); o.z = pk2(v[8 * h + 4][j], v[8 * h + 5][j]); o.w = pk2(v[8 * h + 6][j], v[8 * h + 7][j]);
                *(u32x4*)(drow + 8 * h) = o; } }
    } else {
        float s0[16], s1[16];
#pragma unroll
        for (int i = 0; i < 16; ++i) { const int k = k0 + 16 * kr + i; s0[i] = tab[k]; s1[i] = tab[1024 + k]; a0 += v[i] * tab[2048 + k]; a1 += v[i] * tab[3072 + k]; }
#pragma unroll
        for (int j = 0; j < 4; ++j) { bf16* d0 = WT0 + (size_t)(dst_row0 + 4 * n4 + j) * K + k0 + 16 * kr; bf16* d1 = WT1 + (size_t)(dst_row0 + 4 * n4 + j) * K + k0 + 16 * kr;
#pragma unroll
            for (int h = 0; h < 2; ++h) { u32x4 o;
                o.x = pk2(v[8 * h][j] * s0[8 * h], v[8 * h + 1][j] * s0[8 * h + 1]); o.y = pk2(v[8 * h + 2][j] * s0[8 * h + 2], v[8 * h + 3][j] * s0[8 * h + 3]);
                o.z = pk2(v[8 * h + 4][j] * s0[8 * h + 4], v[8 * h + 5][j] * s0[8 * h + 5]); o.w = pk2(v[8 * h + 6][j] * s0[8 * h + 6], v[8 * h + 7][j] * s0[8 * h + 7]);
                *(u32x4*)(d0 + 8 * h) = o;
                o.x = pk2(v[8 * h][j] * s1[8 * h], v[8 * h + 1][j] * s1[8 * h + 1]); o.y = pk2(v[8 * h + 2][j] * s1[8 * h + 2], v[8 * h + 3][j] * s1[8 * h + 3]);
                o.z = pk2(v[8 * h + 4][j] * s1[8 * h + 4], v[8 * h + 5][j] * s1[8 * h + 5]); o.w = pk2(v[8 * h + 6][j] * s1[8 * h + 6], v[8 * h + 7][j] * s1[8 * h + 7]);
                *(u32x4*)(d1 + 8 * h) = o; } }
    }
}
__device__ __forceinline__ int map_qkvg(int np) {
    if (np < 2048) { const int qk = np >> 10, h = (np >> 8) & 3, cp = np & 255; const int d = 128 * ((cp >> 6) & 1) + 64 * (cp >> 7) + (cp & 63); return qk * 1024 + h * 256 + d; }
    if (np < 4096) return 4096 + (np - 2048);
    return 2048 + (np - 4096);
}
__device__ __forceinline__ int map_wci(int np) { const int tile = np >> 8, cp = np & 255; if (tile < 8) return (cp < 128) ? (1024 + 128 * tile + cp) : (2048 + 128 * tile + cp - 128); return 256 * (tile - 8) + cp; }
__device__ __forceinline__ void unpack8(const u32x4 w, float (&f)[8]) { f[0] = bflo(w.x); f[1] = bfhi(w.x); f[2] = bflo(w.y); f[3] = bfhi(w.y); f[4] = bflo(w.z); f[5] = bfhi(w.z); f[6] = bflo(w.w); f[7] = bfhi(w.w); }

template <int RB>
__device__ __forceinline__ void modrows(const float* xrow0, const float* gain, const float* scale, bf16* orow0, float* rstd0, int lane) {
    f32x4 v[RB][4]; float ss[RB];
#pragma unroll
    for (int r = 0; r < RB; ++r)
#pragma unroll
        for (int j = 0; j < 4; ++j) v[r][j] = ((const f32x4*)(xrow0 + (size_t)r * D) + lane)[64 * j];
    f32x4 w[4];
#pragma unroll
    for (int j = 0; j < 4; ++j) w[j] = ((const f32x4*)gain + lane)[64 * j] * (((const f32x4*)scale + lane)[64 * j] + 1.0f);
#pragma unroll
    for (int r = 0; r < RB; ++r) { float s_ = 0.f;
#pragma unroll
        for (int j = 0; j < 4; ++j) s_ += (v[r][j][0] * v[r][j][0] + v[r][j][1] * v[r][j][1]) + (v[r][j][2] * v[r][j][2] + v[r][j][3] * v[r][j][3]);
        ss[r] = wave_sum(s_); }
#pragma unroll
    for (int r = 0; r < RB; ++r) { if (lane == 0) rstd0[r] = 1.0f / sqrtf(ss[r] * (1.0f / D) + EPS);
        unsigned long long* o8 = (unsigned long long*)(orow0 + (size_t)r * D) + lane;
#pragma unroll
        for (int j = 0; j < 4; ++j) { const f32x4 o = v[r][j] * w[j]; o8[64 * j] = (unsigned long long)pk2(o[0], o[1]) | ((unsigned long long)pk2(o[2], o[3]) << 32); } }
}
template <int RB>
__device__ __forceinline__ void biasrows(const bf16* wrow0, const float* sh, int q_lo, int q_hi, float* out0, int lane) {
    u32x4 wv[RB][2];
#pragma unroll
    for (int r = 0; r < RB; ++r)
#pragma unroll
        for (int j = 0; j < 2; ++j) wv[r][j] = *(const u32x4*)(wrow0 + (size_t)r * D + j * 512 + lane * 8);
#pragma unroll
    for (int q = 0; q < 3; ++q) if (q >= q_lo && q < q_hi) {
        float a[RB];
#pragma unroll
        for (int r = 0; r < RB; ++r) a[r] = 0.f;
#pragma unroll
        for (int j = 0; j < 2; ++j) { const float* s_ = sh + q * NQ + j * 512 + lane * 8; const f32x4 s0 = *(const f32x4*)s_, s1 = *(const f32x4*)(s_ + 4);
#pragma unroll
            for (int r = 0; r < RB; ++r) { float wf[8]; unpack8(wv[r][j], wf);
                a[r] += (wf[0] * s0[0] + wf[1] * s0[1]) + (wf[2] * s0[2] + wf[3] * s0[3]) + (wf[4] * s1[0] + wf[5] * s1[1]) + (wf[6] * s1[2] + wf[7] * s1[3]); } }
#pragma unroll
        for (int r = 0; r < RB; ++r) { const float t = wave_sum(a[r]); if (lane == 0) out0[q * NQ + r] = t; }
    }
}

#define BUILD_TABS(S_, RS_, BS_) do { LAS float* rt_ = (LAS float*)(lds + RSTD_LDS); LAS float* bt_ = (LAS float*)(lds + BIAS_LDS); pg8::Unit u_; \
        for (int i_ = (tid >> 8); S_.next(i_, u_); i_ += 2) { const int t_ = tid & 255; rt_[i_ * 256 + t_] = RS_(u_.pm * 256 + t_); bt_[i_ * 256 + t_] = BS_(u_, t_); } \
        __syncthreads(); } while (0)
__device__ __forceinline__ float bias_sum(const float* slab, int ncol, int col) { float t = slab[col];
#pragma unroll
    for (int q = 1; q < NKQ; ++q) t += slab[q * ncol + col];
    return t; }
#define RS_SSQ(r) rstd_from_ssq(SSQ, (r))
#define RS_X(r) RSTDX[(r)]

#define WPREP_JOBS(job_lo, job_hi, gwq, ngwq) do { LAS float* tab = (LAS float*)lds; \
                for (int job = (job_lo); job < (job_hi); ++job) { \
                    const int jl = (job == 0) ? 0 : 1; const bool isci = (job == 1); \
                    const float* gain_ = (isci ? args.in[IN_NMIX] : args.in[IN_NFFN]) + jl * D; const float* ad = ADA + jl * 3 * NQ + (isci ? 0 : 3 * D); \
                    __syncthreads(); \
                    for (int i = tid; i < 2 * D; i += NTHR) { const int b_ = i >> 10, k = i & (D - 1); tab[i] = gain_[k] * (1.0f + ad[b_ * NQ + D + k]); tab[2 * D + i] = ad[b_ * NQ + k]; } \
                    __syncthreads(); \
                    const int nnb = isci ? 48 : 88, ncol = isci ? 3072 : 5632; \
                    float* bslab = isci ? BIAS5 : BIAS3 + jl * 2 * NKQ * 5632; \
                    for (int it = (gwq); it < nnb * NKQ; it += (ngwq)) { const int nb = it / NKQ, kq = it % NKQ, np = nb * 64; f32x4 a0 = {0.f, 0.f, 0.f, 0.f}, a1 = a0; \
                        for (int kb = kq * (16 / NKQ); kb < (kq + 1) * (16 / NKQ); ++kb) { \
                            if (isci) tr64<true>(args.in[IN_WCI], 3072, D, WCI, WCI + (size_t)3072 * D, kb * 64, map_wci(np), np, tab, a0, a1, lane); \
                            else { const int tile = np >> 8, cp = np & 255; const float* src = (cp < 128 ? args.in[IN_W1] : args.in[IN_W3]) + (size_t)jl * D * FF; \
                                tr64<true>(src, FF, D, W13[jl], W13[jl] + (size_t)5632 * D, kb * 64, 128 * tile + (cp & 127), np, tab, a0, a1, lane); } } \
                        _Pragma("unroll") for (int e = 0; e < 4; ++e) { a0[e] += __shfl_xor(a0[e], 16); a0[e] += __shfl_xor(a0[e], 32); a1[e] += __shfl_xor(a1[e], 16); a1[e] += __shfl_xor(a1[e], 32); } \
                        if (lane < 16) { *(f32x4*)(bslab + (0 * NKQ + kq) * ncol + np + 4 * lane) = a0; *(f32x4*)(bslab + (1 * NKQ + kq) * ncol + np + 4 * lane) = a1; } \
                    } } \
                __syncthreads(); } while (0)

__global__ void __launch_bounds__(NTHR, 2) fwd_kernel(Args args) {
    extern __shared__ __attribute__((aligned(16))) unsigned char lds_raw[];
    LAS unsigned char* lds = (LAS unsigned char*)lds_raw;
    volatile LAS unsigned* MISC = (volatile LAS unsigned*)(lds + MISC_OFF);
    const int tid0 = threadIdx.x, wave = __builtin_amdgcn_readfirstlane(tid0 >> 6);
    const int G = gridDim.x, bx = blockIdx.x;
    const int vcu = (G % 8 == 0) ? (bx % 8) * (G / 8) + bx / 8 : bx;
    const int gw = vcu * NWAVES + wave, NGW = G * NWAVES;
    unsigned char* ws = args.ws;
    unsigned* ctl = (unsigned*)(ws + WS_CTL);
    float* ADA = (float*)(ws + CTL_ADA);
    float* ROPE = (float*)(ws + MS_ROPE); float* RSTDX = (float*)(ws + MS_RSTDX); float* RSTDC = (float*)(ws + MS_RSTDC);
    float* BIAS1 = (float*)(ws + MS_BIAS1); float* BIAS3 = (float*)(ws + MS_BIAS3); float* BIAS5 = (float*)(ws + MS_BIAS5);
    float* SSQ = (float*)(ws + WS_SSQ);
    bf16* WQKVG = (bf16*)(ws + WS_WQKVG); bf16* WO = (bf16*)(ws + WS_WO); bf16* WCI = (bf16*)(ws + WS_WCI); bf16* WCO = (bf16*)(ws + WS_WCO);
    bf16* W13[2] = {(bf16*)(ws + WS_W13_0), (bf16*)(ws + WS_W13_1)};
    bf16* XB = (bf16*)(ws + WS_XB); bf16* QB = (bf16*)(ws + WS_Q); bf16* KB = (bf16*)(ws + WS_K); bf16* VT = (bf16*)(ws + WS_VT);
    bf16* SFB = (bf16*)(ws + WS_SF); bf16* SBB = (bf16*)(ws + WS_SB); bf16* KC = (bf16*)(ws + WS_KC); bf16* VCT = (bf16*)(ws + WS_VCT); bf16* ACB = (bf16*)(ws + WS_ACB);
    bf16* HID = (bf16*)(ws + WS_HID); bf16* CU = (bf16*)(ws + WS_CU); bf16* CB = (bf16*)(ws + WS_CB); bf16* ACV = (bf16*)(ws + WS_ACV);
    bf16* GB = (bf16*)args.out;
    const float* x = args.in[IN_X];

    for (int u = tid0; u < (LDS_BYTES - 131072) / 4; u += NTHR) ((LAS unsigned*)(lds + 131072))[u] = 0u;
    __syncthreads();
    const bool multi = (args.ph_hi - args.ph_lo) > 1;
    XcdBarrier bar; bar.bar = ctl + CW_BAR; bar.x = 0; bar.st = nullptr;
    if (multi) bar = xcd_barrier_post(ctl + CW_BAR, MISC + 8);

#ifndef PROBE_DUP
#define PROBE_DUP -1
#endif
#ifndef SSVAR
#define SSVAR 0
#endif
    for (int ph0 = args.ph_lo; ph0 < args.ph_hi; ) {
        const int sq_ = ph0++; const int ph = (sq_ < 4) ? sq_ : (sq_ == 4 ? 13 : sq_ - 1); constexpr int rep = 0;
        const int tid = opaque((int)threadIdx.x), lane = tid & 63;
        switch (ph) {
        case 0: if (PHMASK & (1<<0)) {
            { LAS float* sl = (LAS float*)(lds + 131072); LAS f32x4* red = (LAS f32x4*)lds;
              for (int i = tid; i < 3 * D; i += NTHR) { const int r = i >> 10, k = i & (D - 1); sl[i] = siluf(r < 2 ? args.in[IN_C][r * D + k] : args.in[IN_CCTX][k]); }
              __syncthreads();
              for (int it = bx; it < 256; it += G) {
                  const int l = it >> 7, c0 = (it & 127) * 48, cg = tid % 12, kg = tid / 12;
                  if (tid < 504) {
                      const float* W = args.in[IN_ADAW] + (size_t)l * D * NQ + c0 + 4 * cg;
                      f32x4 a0 = {0.f, 0.f, 0.f, 0.f}, a1 = a0, a2 = a0;
#pragma unroll 5
                      for (int k = kg; k < D; k += 42) { const f32x4 w = *(const f32x4*)(W + (size_t)k * NQ); a0 += w * sl[k]; a1 += w * sl[D + k]; a2 += w * sl[2 * D + k]; }
                      red[(kg * 12 + cg) * 3 + 0] = a0; red[(kg * 12 + cg) * 3 + 1] = a1; red[(kg * 12 + cg) * 3 + 2] = a2;
                  }
                  __syncthreads();
                  if (tid < 36) { const int cg2 = tid / 3, r = tid % 3; f32x4 t = *(const f32x4*)(args.in[IN_ADAB] + l * NQ + c0 + 4 * cg2);
                      for (int q = 0; q < 42; ++q) t += red[(q * 12 + cg2) * 3 + r];
                      *(f32x4*)(ADA + (l * 3 + r) * NQ + c0 + 4 * cg2) = t; }
                  __syncthreads();
              }
            }
            { constexpr int I_QKVG = 16 * 96, I_WO = 32 * 16, I_W2 = 44 * 16, I_WCO = 16 * 16;
              constexpr int NIT = I_QKVG + I_WO + 2 * I_W2 + I_WCO;
              f32x4 d0, d1;
              for (int it = gw; it < NIT; it += NGW) {
                  int r = it;
                  if (r < I_QKVG) { const int kb = r / 96, nb = r % 96; tr64<false>(args.in[IN_WQKVG], NQ, D, WQKVG, nullptr, kb * 64, map_qkvg(nb * 64), nb * 64, nullptr, d0, d1, lane); continue; } r -= I_QKVG;
                  if (r < I_WO) { const int kb = r / 16, nb = r % 16; tr64<false>(args.in[IN_WO], D, 2048, WO, nullptr, kb * 64, nb * 64, nb * 64, nullptr, d0, d1, lane); continue; } r -= I_WO;
                  if (r < 2 * I_W2) { const int l = r / I_W2; r %= I_W2; const int kb = r / 16, nb = r % 16;
                      tr64<false>(args.in[IN_W2] + (size_t)l * FF * D, D, FF, (bf16*)(ws + (l ? WS_W2_1 : WS_W2_0)), nullptr, kb * 64, nb * 64, nb * 64, nullptr, d0, d1, lane); continue; } r -= 2 * I_W2;
                  { const int kb = r / 16, nb = r % 16; tr64<false>(args.in[IN_WCO], D, D, WCO, nullptr, kb * 64, nb * 64, nb * 64, nullptr, d0, d1, lane); }
              }
            }
        } break;
        case 1: if (PHMASK & (1<<1)) {
            const float* gain = args.in[IN_NMIX];
            const bool hasctx = vcu < 192;
            const bool isv = vcu >= 64; const int tl = isv ? vcu - 64 : vcu, rb = tl & 7, cbk = tl >> 3, row0 = 64 * rb, col0 = 128 * cbk;
            const int wt0 = (isv ? 4096 : 1024) + col0;
            if (hasctx) {
                LAS float* wt_ = (LAS float*)lds; LAS float* sh_ = wt_ + D; LAS float* rs_ = (LAS float*)(lds + 8192); LAS float* bs_ = rs_ + 64;
                LAS unsigned char* abuf = lds + 16384; LAS unsigned char* bbuf = lds + 16384 + 2 * 9216;
                for (int k = tid; k < D; k += NTHR) { wt_[k] = gain[k] * (1.0f + ADA[2 * NQ + D + k]); sh_[k] = ADA[2 * NQ + k]; }
                __syncthreads();
                const int arow = tid >> 3, aseg = tid & 7, brow = tid >> 2, bseg = tid & 3;
                const float* ap = args.in[IN_CTX] + (size_t)(row0 + arow) * D + 8 * aseg; const bf16* bp = WQKVG + (size_t)(wt0 + brow) * D + 16 * bseg;
                const int w4 = wave & 3, wr2 = wave >> 2, fr = lane & 15, fq = lane >> 4;
                const unsigned awr = (unsigned)(arow * 144 + aseg * 16), bwr = (unsigned)(brow * 144 + bseg * 32);
                const unsigned ard = (unsigned)((32 * wr2 + fr) * 144 + fq * 16), brd = (unsigned)((32 * w4 + fr) * 144 + fq * 16);
                f32x4 a_r[2][2]; u32x4 b_r[2][2]; float ssq = 0.f, bsum = 0.f;
                f32x4 acc[2][2];
#pragma unroll
                for (int m = 0; m < 2; ++m)
#pragma unroll
                    for (int n = 0; n < 2; ++n) acc[m][n] = (f32x4){0.f, 0.f, 0.f, 0.f};
#pragma unroll
                for (int c = 0; c < 2; ++c) { a_r[c][0] = *(const f32x4*)(ap + 64 * c); a_r[c][1] = *(const f32x4*)(ap + 64 * c + 4); b_r[c][0] = *(const u32x4*)(bp + 64 * c); b_r[c][1] = *(const u32x4*)(bp + 64 * c + 8); }
#pragma unroll 1
                for (int c2 = 0; c2 < 16; c2 += 2)
#pragma unroll
                for (int cur = 0; cur < 2; ++cur) { const int c = c2 + cur;
                    { const int k0 = 64 * c + 8 * aseg; const f32x4 w0 = *(const LAS f32x4*)(wt_ + k0), w1 = *(const LAS f32x4*)(wt_ + k0 + 4); const f32x4 x0 = a_r[cur][0], x1 = a_r[cur][1];
                      ssq += (x0[0] * x0[0] + x0[1] * x0[1]) + (x0[2] * x0[2] + x0[3] * x0[3]) + (x1[0] * x1[0] + x1[1] * x1[1]) + (x1[2] * x1[2] + x1[3] * x1[3]);
                      *(LAS u32x4*)(abuf + cur * 9216 + awr) = pack8(x0 * w0, x1 * w1); }
                    { const int kb = 64 * c + 16 * bseg;
#pragma unroll
                      for (int h = 0; h < 2; ++h) { float f[8]; unpack8(b_r[cur][h], f); const f32x4 s0 = *(const LAS f32x4*)(sh_ + kb + 8 * h), s1 = *(const LAS f32x4*)(sh_ + kb + 8 * h + 4);
                          bsum += (f[0] * s0[0] + f[1] * s0[1]) + (f[2] * s0[2] + f[3] * s0[3]) + (f[4] * s1[0] + f[5] * s1[1]) + (f[6] * s1[2] + f[7] * s1[3]);
                          *(LAS u32x4*)(bbuf + cur * 18432 + bwr + 16 * h) = b_r[cur][h]; } }
                    { const int cn = (c + 2 < 16) ? c + 2 : 15;
                      a_r[cur][0] = *(const f32x4*)(ap + 64 * cn); a_r[cur][1] = *(const f32x4*)(ap + 64 * cn + 4); b_r[cur][0] = *(const u32x4*)(bp + 64 * cn); b_r[cur][1] = *(const u32x4*)(bp + 64 * cn + 8); }
                    __syncthreads();
#pragma unroll
                    for (int ks = 0; ks < 2; ++ks) { bf16x8 af[2], bfg[2];
#pragma unroll
                        for (int m = 0; m < 2; ++m) af[m] = *(const LAS bf16x8*)(abuf + cur * 9216 + ard + m * (16 * 144) + ks * 64);
#pragma unroll
                        for (int n = 0; n < 2; ++n) bfg[n] = *(const LAS bf16x8*)(bbuf + cur * 18432 + brd + n * (16 * 144) + ks * 64);
#pragma unroll
                        for (int m = 0; m < 2; ++m)
#pragma unroll
                            for (int n = 0; n < 2; ++n) acc[m][n] = isv ? __builtin_amdgcn_mfma_f32_16x16x32_bf16(af[m], bfg[n], acc[m][n], 0, 0, 0) : __builtin_amdgcn_mfma_f32_16x16x32_bf16(bfg[n], af[m], acc[m][n], 0, 0, 0); }
                }
                { float t = ssq; t += __shfl_xor(t, 1); t += __shfl_xor(t, 2); t += __shfl_xor(t, 4); if (aseg == 0) rs_[arow] = 1.0f / sqrtf(t * (1.0f / D) + EPS);
                  float u_ = bsum; u_ += __shfl_xor(u_, 1); u_ += __shfl_xor(u_, 2); if (bseg == 0) bs_[brow] = u_; }
                __syncthreads();
                const int b = rb >> 2;
                if (!isv) {
#pragma unroll
                    for (int m = 0; m < 2; ++m) { const int rl = 32 * wr2 + 16 * m + fr; const float rsd = rs_[rl];
#pragma unroll
                        for (int n = 0; n < 2; ++n) { const int cl = 32 * w4 + 16 * n + 4 * fq; const f32x4 bb = *(const LAS f32x4*)(bs_ + cl);
                            const f32x4 o = (acc[m][n] * rsd + bb) * 0.0625f;
                            u32x2 w; w.x = pk2(o[0], o[1]); w.y = pk2(o[2], o[3]); *(u32x2*)(KC + (size_t)(row0 + rl) * D + col0 + cl) = w; } }
                } else {
#pragma unroll
                    for (int m = 0; m < 2; ++m) { const int tl0 = 32 * wr2 + 16 * m + 4 * fq; const f32x4 rs = *(const LAS f32x4*)(rs_ + tl0);
#pragma unroll
                        for (int n = 0; n < 2; ++n) { const int cl = 32 * w4 + 16 * n + fr, c = col0 + cl, h = c >> 9, e = c & 511; const f32x4 o = acc[m][n] * rs + bs_[cl];
                            u32x2 w; w.x = pk2(o[0], o[1]); w.y = pk2(o[2], o[3]); *(u32x2*)(VCT + (size_t)((b * NH + h) * DV + e) * CTXL + ((row0 + tl0) & (CTXL - 1))) = w; } }
                }
                biasrows<4>(WQKVG + (size_t)(4 * (vcu * 8 + wave)) * D, ADA, 0, 2, BIAS1 + 4 * (vcu * 8 + wave), lane);
            } else {
                const int wk = (vcu - 192) * 8 + wave, NWK = (G - 192) * 8;
                for (int r = 4 * wk; r < P1_R1; r += 4 * NWK) modrows<4>(x + (size_t)r * D, gain, ADA + (r >> 13) * NQ + D, XB + (size_t)r * D, RSTDX + r, lane);
            }
            { const int r = P1_R1 + 4 * (vcu * 8 + wave); modrows<4>(x + (size_t)r * D, gain, ADA + (r >> 13) * NQ + D, XB + (size_t)r * D, RSTDX + r, lane); }
            if constexpr (P1_RW > 4) { const int r = P1_R1 + 8192 + (P1_RW - 4) * (vcu * 8 + wave); modrows<P1_RW - 4>(x + (size_t)r * D, gain, ADA + (r >> 13) * NQ + D, XB + (size_t)r * D, RSTDX + r, lane); }
        } break;
        case 2: if (PHMASK & (1<<2)) {
            if (G1SEL & 1) { pg8::Gemm g{XB, WQKVG, M, 4096, D, 0}; pg8::StaticOrder S; S.init(M, 4096, G, bx);
              EpiQKG E{QB, KB, GB, RSTDX, BIAS1};
              pg8::gemm_phase<EpiQKG, pg8::StaticOrder, true, true, false>(lds, g, S, E, tid); }
            { pg8::Gemm g{XB, WQKVG + (size_t)4096 * D, M, 2048, D, 0}; pg8::StaticOrder S; S.init(M, 2048, G, bx);
              EpiVT E{VT, RSTDX, BIAS1 + 4096, SEQ, 32, -1};
              pg8::gemm_phase<EpiVT, pg8::StaticOrder, true, true, true>(lds, g, S, E, tid); }
        } break;
        case 3: if (PHMASK & (1<<3)) {
            constexpr int KP = 136, BUFB = (64 + 64 + 128) * KP * 2, NST = 34;
            static_assert(2 * BUFB <= MISC_OFF, "SS LDS map");
            for (int u = bx; u < 256; u += G) {
                const int grp = u & 1, bh = (u >> 1) & 7, dkt = (u >> 4) & 3, dvt = u >> 6, b = bh >> 2, h = bh & 3, dk0 = 64 * dkt, dv0 = 128 * dvt;
                const float lgf = __builtin_bit_cast(float, __builtin_amdgcn_readfirstlane(__builtin_bit_cast(int, __builtin_amdgcn_logf(1.0f - __builtin_amdgcn_exp2f(-5.0f - (float)h)))));
                const float lgb = __builtin_bit_cast(float, __builtin_amdgcn_readfirstlane(__builtin_bit_cast(int, __builtin_amdgcn_logf(1.0f - __builtin_amdgcn_exp2f(-5.5f - (float)h)))));
                __syncthreads();
#define SS_DEC(s_) const bool ic_ = (s_) < 2; const int c_ = grp ? (ic_ ? 1 - (s_) : 65 - (s_)) : (ic_ ? (s_) : (s_) - 2); const int q_ = ic_ ? c_ : (c_ & 3), nq_ = ic_ ? 2 : 4
                if (wave >= 4) {
                    const int pt = tid - 256;
                    float wKf[4], wKb[4];
#pragma unroll
                    for (int p = 0; p < 4; ++p) { const int t = 4 * (pt >> 3) + p; wKf[p] = __builtin_amdgcn_exp2f((float)(127 - t) * lgf); wKb[p] = __builtin_amdgcn_exp2f((float)t * lgb); }
                    u32x4 kr0[4], vr0[8], kr1[4], vr1[8], kr2[4], vr2[8];
#define SSP_LOAD(step, kr, vr) do { const int s_ = (step); SS_DEC(s_); (void)q_; (void)nq_; const int t_ = opaque(pt); \
                        const bf16* ks_ = (ic_ ? KC + (size_t)(b * CTXL + c_ * 128) * D : KB + (size_t)(b * SEQ + c_ * 128) * D) + h * DK + dk0; \
                        const int ld_ = ic_ ? CTXL : 128; const bf16* vs_ = ic_ ? VCT + (size_t)(bh * DV + dv0) * CTXL + c_ * 128 : VT + ((size_t)((bh * 64 + c_) * DV + dv0)) * 128; \
                        _Pragma("unroll") for (int p = 0; p < 4; ++p) kr[p] = *(const u32x4*)(ks_ + (unsigned)((4 * (t_ >> 3) + p) * D + 8 * (t_ & 7))); \
                        _Pragma("unroll") for (int q = 0; q < 8; ++q) vr[q] = *(const u32x4*)(vs_ + (unsigned)(((t_ >> 4) + 16 * q) * ld_ + 8 * (t_ & 15))); } while (0)
#define SSP_WRITE(step, kr, vr) do { const int sw_ = (step); SS_DEC(sw_); (void)c_; LAS bf16* kf_ = (LAS bf16*)(lds + (sw_ & 1) * BUFB); LAS bf16* kb_ = kf_ + 64 * KP; LAS bf16* vt_ = kb_ + 64 * KP; const int t_ = opaque(pt); \
                        const float cf_ = __builtin_amdgcn_exp2f((float)(128 * (nq_ - 1 - q_)) * lgf), cb_ = __builtin_amdgcn_exp2f((float)(128 * q_) * lgb); \
                        { float f0_[8], f1_[8], f2_[8], f3_[8]; unpack8(kr[0], f0_); unpack8(kr[1], f1_); unpack8(kr[2], f2_); unpack8(kr[3], f3_); \
                          const int c8_ = t_ & 7, tg_ = t_ >> 3, pos_ = (((tg_ >> 1) ^ c8_) << 3) | (4 * (tg_ & 1)); \
                          const float wf0_ = wKf[0] * cf_, wf1_ = wKf[1] * cf_, wf2_ = wKf[2] * cf_, wf3_ = wKf[3] * cf_, wb0_ = wKb[0] * cb_, wb1_ = wKb[1] * cb_, wb2_ = wKb[2] * cb_, wb3_ = wKb[3] * cb_; \
                          _Pragma("unroll") for (int e = 0; e < 8; ++e) { u32x2 wf_, wb_; wf_.x = pk2(f0_[e] * wf0_, f1_[e] * wf1_); wf_.y = pk2(f2_[e] * wf2_, f3_[e] * wf3_); wb_.x = pk2(f0_[e] * wb0_, f1_[e] * wb1_); wb_.y = pk2(f2_[e] * wb2_, f3_[e] * wb3_); \
                              *(LAS u32x2*)(kf_ + (8 * c8_ + e) * KP + pos_) = wf_; *(LAS u32x2*)(kb_ + (8 * c8_ + e) * KP + pos_) = wb_; } } \
                        _Pragma("unroll") for (int q = 0; q < 8; ++q) *(LAS u32x4*)(vt_ + ((t_ >> 4) + 16 * q) * KP + 8 * (t_ & 15)) = vr[q]; } while (0)
#define SSP_STEP(s, krN, vrN, krF, vrF) do { const int s__ = (s); SSP_LOAD(s__ + 3 <= NST - 1 ? s__ + 3 : NST - 1, krF, vrF); SSP_WRITE(s__ + 1, krN, vrN); __syncthreads(); } while (0)
                    SSP_LOAD(0, kr0, vr0); SSP_LOAD(1, kr1, vr1); SSP_LOAD(2, kr2, vr2); SSP_WRITE(0, kr0, vr0); __syncthreads();
                    static_assert(NST % 3 == 1, "tail step below");
                    for (int s3 = 0; s3 < NST - 1; s3 += 3) { SSP_STEP(s3, kr1, vr1, kr0, vr0); SSP_STEP(s3 + 1, kr2, vr2, kr1, vr1); SSP_STEP(s3 + 2, kr0, vr0, kr2, vr2); }
                    SSP_STEP(NST - 1, kr1, vr1, kr0, vr0);
#undef SSP_LOAD
#undef SSP_WRITE
#undef SSP_STEP
                } else {
                    const int wr = wave >> 1, wc = wave & 1, fr = lane & 15, fq = lane >> 4;
                    f32x4 accf[2][4], accb[2][4];
#pragma unroll
                    for (int i = 0; i < 2; ++i)
#pragma unroll
                        for (int j = 0; j < 4; ++j) { accf[i][j] = (f32x4){0.f, 0.f, 0.f, 0.f}; accb[i][j] = (f32x4){0.f, 0.f, 0.f, 0.f}; }
                    __syncthreads();
                    for (int s = 0; s < NST; ++s) {
                        { const LAS bf16* kf = (const LAS bf16*)(lds + (s & 1) * BUFB); const LAS bf16* kb = kf + 64 * KP; const LAS bf16* vt = kb + 64 * KP;
#pragma unroll
                          for (int ks = 0; ks < 4; ++ks) { bf16x8 XF[2], XB_[2], Y[4];
#pragma unroll
                              for (int i = 0; i < 2; ++i) { const int o_ = (32 * wr + 16 * i + fr) * KP + (((4 * ks + fq) ^ (4 * wr + 2 * i + (fr >> 3))) & 7) * 8 + 64 * (ks >> 1);
                                  XF[i] = *(const LAS bf16x8*)(kf + o_); XB_[i] = *(const LAS bf16x8*)(kb + o_); }
#pragma unroll
                              for (int j = 0; j < 4; ++j) Y[j] = *(const LAS bf16x8*)(vt + (64 * wc + 16 * j + fr) * KP + 32 * ks + 8 * fq);
#pragma unroll
                              for (int i = 0; i < 2; ++i)
#pragma unroll
                                  for (int j = 0; j < 4; ++j) { accf[i][j] = __builtin_amdgcn_mfma_f32_16x16x32_bf16(XF[i], Y[j], accf[i][j], 0, 0, 0); accb[i][j] = __builtin_amdgcn_mfma_f32_16x16x32_bf16(XB_[i], Y[j], accb[i][j], 0, 0, 0); } } }
                        __syncthreads();
                        SS_DEC(s);
                        if (grp ? (q_ == 0) : (q_ == nq_ - 1)) {
                            const int sc = c_ >> 2;
                            const int fslot = grp ? ((!ic_ && sc <= 14) ? sc + 1 : -1) : (ic_ ? 0 : sc + 1), bslot = grp ? (ic_ ? 15 : sc - 1) : ((!ic_ && sc >= 1) ? sc - 1 : -1);
                            const size_t eo = (size_t)(dv0 + 64 * wc + fr) * DK + dk0 + 32 * wr + 4 * fq;
                            if (fslot >= 0) { bf16* dst = SFB + (size_t)(bh * NSC + fslot) * DV * DK + eo;
#pragma unroll
                                for (int i = 0; i < 2; ++i)
#pragma unroll
                                    for (int j = 0; j < 4; ++j) { u32x2 w; w.x = pk2(accf[i][j][0], accf[i][j][1]); w.y = pk2(accf[i][j][2], accf[i][j][3]); *(u32x2*)(dst + (size_t)(16 * j) * DK + 16 * i) = w; } }
                            if (bslot >= 0) { bf16* dst = SBB + (size_t)(bh * NSC + bslot) * DV * DK + eo;
#pragma unroll
                                for (int i = 0; i < 2; ++i)
#pragma unroll
                                    for (int j = 0; j < 4; ++j) { u32x2 w; w.x = pk2(accb[i][j][0], accb[i][j][1]); w.y = pk2(accb[i][j][2], accb[i][j][3]); *(u32x2*)(dst + (size_t)(16 * j) * DK + 16 * i) = w; } }
                            const float mf = grp ? 0.f : __builtin_amdgcn_exp2f(512.0f * lgf), mb = grp ? __builtin_amdgcn_exp2f(512.0f * lgb) : 0.f;
#pragma unroll
                            for (int i = 0; i < 2; ++i)
#pragma unroll
                                for (int j = 0; j < 4; ++j) { accf[i][j] *= mf; accb[i][j] *= mb; }
                        }
                    }
                }
#undef SS_DEC
            }
        } break;
        case 4: if (PHMASK & (1<<4)) {
            constexpr int SLOT = 40960, PBUF = 3 * SLOT, REDB = PBUF + 32768;
            static_assert(REDB + 2048 <= MISC_OFF, "B' LDS map");
            const int wr = wave >> 2, wc = wave & 3;
#define BP_WAITV(n) do { switch (n) { case 0: asm volatile("s_waitcnt vmcnt(0)" ::: "memory"); break; case 4: asm volatile("s_waitcnt vmcnt(4)" ::: "memory"); break; \
                    case 5: asm volatile("s_waitcnt vmcnt(5)" ::: "memory"); break; default: asm volatile("s_waitcnt vmcnt(0)" ::: "memory"); break; } } while (0)
#define BP_GLDS(srcp, dstoff) __builtin_amdgcn_global_load_lds((const unsigned*)(srcp), (LAS unsigned*)(lds + (dstoff)), 16, 0, 0)
            for (int unit = vcu; unit < 512; unit += G) {
                const int bh = unit >> 6, c = unit & 63, b = bh >> 2, h = bh & 3, sc = c >> 2, cq = c & 3;
                const float lgf = __builtin_amdgcn_logf(1.0f - __builtin_amdgcn_exp2f(-5.0f - (float)h)), lgb = __builtin_amdgcn_logf(1.0f - __builtin_amdgcn_exp2f(-5.5f - (float)h));
                const bf16* Qsrc = QB + (size_t)(b * SEQ + c * 128) * D + h * DK;
                const bf16* Ksrc = KB + (size_t)(b * SEQ + sc * SC) * D + h * DK;
                const bf16* SFsrc = SFB + (size_t)((bh * NSC + sc) * DV) * DK; const bf16* SBsrc = SBB + (size_t)((bh * NSC + sc) * DV) * DK;
                const bf16* Vsrc = VT + (size_t)((bh * 64 + sc * 4) * DV) * 128;
                f32x4 acc[4][8], sacc[4][2];
#pragma unroll
                for (int m = 0; m < 4; ++m)
#pragma unroll
                    for (int n = 0; n < 8; ++n) acc[m][n] = (f32x4){0.f, 0.f, 0.f, 0.f};
#define BP_ISSUE(idx) do { const int i_ = (idx); const int so_ = (i_ % 3) * SLOT; const int l_ = opaque(lane); \
                    if (i_ < 16) { const int s_ = i_ & 7; const bf16* bs_ = (i_ < 8 ? SFsrc : SBsrc) + 32 * s_; const int rr_ = l_ >> 2, ch_ = (l_ & 3) ^ ((l_ >> 4) & 3); \
                        BP_GLDS(Qsrc + (unsigned)((16 * wave + rr_) * D + 32 * s_ + 8 * ch_), so_ + wave * 1024); \
                        _Pragma("unroll") for (int q = 0; q < 4; ++q) BP_GLDS(bs_ + (unsigned)((16 * (wave + 8 * q) + rr_) * DK + 8 * ch_), so_ + 8192 + (wave + 8 * q) * 1024); } \
                    else { const int j_ = (i_ - 16) >> 3, r8_ = (i_ - 16) & 7; \
                        if (r8_ < 4) { const int rr_ = l_ >> 3, ch_ = (l_ & 7) ^ ((l_ >> 4) & 3) ^ (4 * (wave & 1)); \
                            _Pragma("unroll") for (int q = 0; q < 2; ++q) { const int row_ = 8 * (wave + 8 * q) + rr_; \
                                BP_GLDS(Qsrc + (unsigned)(row_ * D + 64 * r8_ + 8 * ch_), so_ + (wave + 8 * q) * 1024); \
                                BP_GLDS(Ksrc + (unsigned)((128 * j_ + row_) * D + 64 * r8_ + 8 * ch_), so_ + 16384 + (wave + 8 * q) * 1024); } } \
                        else { const int rr_ = l_ >> 2, ch_ = (l_ & 3) ^ ((l_ >> 4) & 3); const bf16* bs_ = Vsrc + (size_t)j_ * (DV * 128) + 32 * (r8_ - 4); \
                            _Pragma("unroll") for (int q = 0; q < 4; ++q) BP_GLDS(bs_ + (unsigned)((16 * (wave + 8 * q) + rr_) * 128 + 8 * ch_), so_ + 8192 + (wave + 8 * q) * 1024); } } } while (0)
#define BP_NLOADS(idx) (((idx) >= 48) ? 0 : ((idx) < 16 ? 5 : 4))
#define BP_TOP(idx) do { BP_WAITV(BP_NLOADS((idx) + 1)); asm volatile("s_waitcnt lgkmcnt(0)" ::: "memory"); __builtin_amdgcn_s_barrier(); asm volatile("" ::: "memory"); \
                    if ((idx) + 2 < 48) BP_ISSUE((idx) + 2); } while (0)
#define BP_MMA_FULL(AADDR, so) do { bf16x8 af_[4]; const int l_ = opaque(lane), fr = l_ & 15, fq = l_ >> 4; \
                    _Pragma("unroll") for (int m = 0; m < 4; ++m) af_[m] = *(const LAS bf16x8*)(lds + AADDR(64 * wr + 16 * m + fr, fr, fq)); \
                    _Pragma("unroll") for (int nh = 0; nh < 4; ++nh) { bf16x8 bf_[2]; \
                        _Pragma("unroll") for (int n = 0; n < 2; ++n) bf_[n] = *(const LAS bf16x8*)(lds + (so) + 8192 + (128 * wc + 32 * nh + 16 * n + fr) * 64 + ((fq ^ (fr >> 2)) & 3) * 16); \
                        _Pragma("unroll") for (int m = 0; m < 4; ++m) _Pragma("unroll") for (int n = 0; n < 2; ++n) \
                            acc[m][2 * nh + n] = __builtin_amdgcn_mfma_f32_16x16x32_bf16(bf_[n], af_[m], acc[m][2 * nh + n], 0, 0, 0); } } while (0)
                __builtin_amdgcn_s_barrier();
                BP_ISSUE(0); BP_ISSUE(1);
                for (int idx = 0; idx < 16; ++idx) {
                    BP_TOP(idx);
                    const int so = (idx % 3) * SLOT;
#define AADDR_X(row, fr, fq) (so + (row) * 64 + (((fq) ^ ((fr) >> 2)) & 3) * 16)
                    BP_MMA_FULL(AADDR_X, so);
#undef AADDR_X
                    if (idx == 7 || idx == 15) { const int fr = opaque(lane) & 15;
#pragma unroll
                        for (int m = 0; m < 4; ++m) { const int il = 128 * cq + 64 * wr + 16 * m + fr;
                            const float sc_ = (idx == 7) ? __builtin_amdgcn_exp2f((float)(il + 1) * lgf - (float)(SC - il) * lgb) : __builtin_amdgcn_exp2f((float)(SC - il) * lgb);
#pragma unroll
                            for (int n = 0; n < 8; ++n) acc[m][n] *= sc_; }
                    }
                }
                for (int j = 0; j < 4; ++j) {
#pragma unroll
                    for (int m = 0; m < 4; ++m) { sacc[m][0] = (f32x4){0.f, 0.f, 0.f, 0.f}; sacc[m][1] = (f32x4){0.f, 0.f, 0.f, 0.f}; }
                    for (int r = 0; r < 4; ++r) {
                        const int idx = 16 + 8 * j + r;
                        BP_TOP(idx);
                        const int so = (idx % 3) * SLOT;
                        { const int l_ = opaque(lane), fr = l_ & 15, fq = l_ >> 4;
#pragma unroll
                          for (int ks = 0; ks < 2; ++ks) { bf16x8 af_[4], kf_[2]; const int cx = ((4 * ks + fq) ^ (fr >> 1)) & 7;
#pragma unroll
                              for (int m = 0; m < 4; ++m) af_[m] = *(const LAS bf16x8*)(lds + so + (64 * wr + 16 * m + fr) * 128 + cx * 16);
#pragma unroll
                              for (int n = 0; n < 2; ++n) kf_[n] = *(const LAS bf16x8*)(lds + so + 16384 + (32 * wc + 16 * n + fr) * 128 + cx * 16);
#pragma unroll
                              for (int m = 0; m < 4; ++m)
#pragma unroll
                                  for (int n = 0; n < 2; ++n) sacc[m][n] = __builtin_amdgcn_mfma_f32_16x16x32_bf16(kf_[n], af_[m], sacc[m][n], 0, 0, 0); } }
                        if (r == 3) {
                            const int l_ = opaque(lane), fr = l_ & 15, fq = l_ >> 4;
#pragma unroll
                            for (int m = 0; m < 4; ++m)
#pragma unroll
                                for (int n = 0; n < 2; ++n) { const int il = 128 * cq + 64 * wr + 16 * m + fr, jl0 = 128 * j + 32 * wc + 16 * n + 4 * fq; float pv[4];
#pragma unroll
                                    for (int e = 0; e < 4; ++e) { const int dl = il - (jl0 + e);
                                        const float dec = dl > 0 ? __builtin_amdgcn_exp2f((float)dl * lgf) : (dl < 0 ? __builtin_amdgcn_exp2f((float)(-dl) * lgb) : 2.0f); pv[e] = sacc[m][n][e] * dec; }
                                    u32x2 w; w.x = pk2(pv[0], pv[1]); w.y = pk2(pv[2], pv[3]);
                                    *(LAS u32x2*)(lds + PBUF + (64 * wr + 16 * m + fr) * 256 + (((4 * wc + 2 * n + (fq >> 1)) ^ fr) & 15) * 16 + (fq & 1) * 8) = w; }
                        }
                    }
                    for (int r = 0; r < 4; ++r) {
                        const int idx = 16 + 8 * j + 4 + r;
                        BP_TOP(idx);
                        const int so = (idx % 3) * SLOT;
#define AADDR_P(row, fr, fq) (PBUF + (row) * 256 + (((4 * r + (fq)) ^ (fr)) & 15) * 16)
                        BP_MMA_FULL(AADDR_P, so);
#undef AADDR_P
                    }
                }
                asm volatile("s_waitcnt vmcnt(0) lgkmcnt(0)" ::: "memory"); __builtin_amdgcn_s_barrier(); asm volatile("" ::: "memory");
                { LAS float* red = (LAS float*)(lds + REDB); const int l_ = opaque(lane), fr = l_ & 15, fq = l_ >> 4;
#pragma unroll
                  for (int m = 0; m < 4; ++m) { float ss = 0.f;
#pragma unroll
                      for (int n = 0; n < 8; ++n) ss += (acc[m][n][0] * acc[m][n][0] + acc[m][n][1] * acc[m][n][1]) + (acc[m][n][2] * acc[m][n][2] + acc[m][n][3] * acc[m][n][3]);
                      ss += __shfl_xor(ss, 16); ss += __shfl_xor(ss, 32);
                      if (fq == 0) red[(64 * wr + 16 * m + fr) * 4 + wc] = ss; }
                  __syncthreads();
                  bf16* gp0 = GB + (size_t)(b * SEQ + c * 128 + 64 * wr + fr) * 2048 + h * DV + 128 * wc + 4 * fq;
#pragma unroll
                  for (int mh = 0; mh < 4; mh += 2) {
                      u32x2 gw[2][8];
#pragma unroll
                      for (int q = 0; q < 2; ++q)
#pragma unroll
                          for (int n = 0; n < 8; ++n) gw[q][n] = *(const u32x2*)(gp0 + (size_t)(16 * (mh + q)) * 2048 + 16 * n);
#pragma unroll
                      for (int q = 0; q < 2; ++q) { const int m = mh + q, row = 64 * wr + 16 * m + fr; const f32x4 t4 = *(const LAS f32x4*)(red + row * 4);
                          const float rs = 1.0f / sqrtf(((t4[0] + t4[1]) + (t4[2] + t4[3])) * (1.0f / DV) + EPS);
                          bf16* gp = gp0 + (size_t)(16 * m) * 2048;
#pragma unroll
                          for (int n = 0; n < 8; ++n) {
                              const float o0 = siluf(bflo(gw[q][n].x)) * acc[m][n][0] * rs, o1 = siluf(bfhi(gw[q][n].x)) * acc[m][n][1] * rs, o2 = siluf(bflo(gw[q][n].y)) * acc[m][n][2] * rs, o3 = siluf(bfhi(gw[q][n].y)) * acc[m][n][3] * rs;
                              u32x2 w; w.x = pk2(o0, o1); w.y = pk2(o2, o3); if (!(PROBE_DUP == 4 && rep == 1)) *(u32x2*)(gp + 16 * n) = w; } } }
                  __syncthreads();
                }
            }
#undef BP_WAITV
#undef BP_GLDS
#undef BP_ISSUE
#undef BP_NLOADS
#undef BP_TOP
#undef BP_MMA_FULL
        } break;
        case 5: case 7: case 10: case 12: if (PHMASK & (1<<5)) {
            const int l = (ph >= 10) ? 1 : 0; const float* adal = ADA + l * 3 * NQ;
            if (ph == 5) WPREP_JOBS(0, 1, gw, NGW);
            pg8::StaticOrder S; S.init(M, D, G, bx);
            if (ph == 12) {
                pg8::Gemm g{HID, (const bf16*)(ws + WS_W2_1), M, D, FF, 0};
                EpiResFinal E{XB, args.out, adal + 5 * D, args.in[IN_FN], (float*)(ws + MS_XPART), ctl, lds + RSTD_LDS};
                pg8::gemm_phase<EpiResFinal, pg8::StaticOrder, true, true, false>(lds, g, S, E, tid);
            } else {
                pg8::Gemm g; EpiRes E;
                if (ph == 5) { g = pg8::Gemm{GB, WO, M, D, 2048, 0}; E = EpiRes{x, nullptr, XB, adal + 2 * D, SSQ, 0}; }
                else if (ph == 7) { g = pg8::Gemm{HID, (const bf16*)(ws + WS_W2_0), M, D, FF, 0}; E = EpiRes{nullptr, XB, XB, adal + 5 * D, SSQ, 0}; }
                else { g = pg8::Gemm{ACV, WCO, M, D, D, 0}; E = EpiRes{nullptr, XB, XB, adal + 2 * D, SSQ, 0}; }
                E.dry = (PROBE_DUP == ph && rep == 1) ? 1 : 0;
                pg8::gemm_phase<EpiRes, pg8::StaticOrder, true, true, false>(lds, g, S, E, tid);
            }
        } break;
        case 6: case 11: if (PHMASK & (1<<6)) {
            const int l = (ph == 11) ? 1 : 0;
            pg8::Gemm g{XB, W13[l], M, 5632, D, (size_t)5632 * D * 2}; pg8::StaticOrder S; S.init(M, 5632, G, bx);
#define BS_FFN(u, t) bias_sum(BIAS3 + (l * 2 + ((u).pm >> 5)) * NKQ * 5632, 5632, (u).pn * 256 + (t))
            BUILD_TABS(S, RS_SSQ, BS_FFN);
#undef BS_FFN
            EpiSwiGLU E{HID, (const LAS float*)(lds + RSTD_LDS), (const LAS float*)(lds + BIAS_LDS), (PROBE_DUP == ph && rep == 1 && SSVAR == 21) ? 1 : 0};
            pg8::gemm_phase<EpiSwiGLU, pg8::StaticOrder, true, true, false>(lds, g, S, E, tid);
            if (ph == 6 && bx >= 128) WPREP_JOBS(1, 3, (bx - 128) * NWAVES + wave, (G - 128) * NWAVES);
        } break;
        case 8: if (PHMASK & (1<<8)) {
            pg8::Gemm g{XB, WCI, M, 3072, D, (size_t)3072 * D * 2}; pg8::StaticOrder S; S.init(M, 3072, G, bx);
#define BS_CI(u, t) bias_sum(BIAS5 + ((u).pm >> 5) * NKQ * 3072, 3072, (u).pn * 256 + (t))
            BUILD_TABS(S, RS_SSQ, BS_CI);
#undef BS_CI
            EpiConvIn E{CU, CB, (const LAS float*)(lds + RSTD_LDS), (const LAS float*)(lds + BIAS_LDS)};
            pg8::gemm_phase<EpiConvIn, pg8::StaticOrder, true, true, false>(lds, g, S, E, tid);
        } break;
        case 9: if (PHMASK & (1<<9)) {
            const float* cw = args.in[IN_CW];
            for (int st = bx * NTHR + tid; st < 128 * (M / 16); st += G * NTHR) {
                const int k = (st & 127) * 8, r0 = (st >> 7) * 16;
                float w0[8], w1[8], w2[8];
#pragma unroll
                for (int q = 0; q < 2; ++q) { const f32x4 a0 = *(const f32x4*)(cw + k + 4 * q), a1 = *(const f32x4*)(cw + D + k + 4 * q), a2 = *(const f32x4*)(cw + 2 * D + k + 4 * q);
#pragma unroll
                    for (int e = 0; e < 4; ++e) { w0[4 * q + e] = a0[e]; w1[4 * q + e] = a1[e]; w2[4 * q + e] = a2[e]; } }
#pragma unroll 1
                for (int hf = 0; hf < 2; ++hf) {
                    const int rb = r0 + 8 * hf;
                    const bool lo_ok = (rb & (SEQ - 1)) != 0, hi_ok = ((rb + 8) & (SEQ - 1)) != 0;
                    u32x4 cu[10], cb[8];
#pragma unroll
                    for (int i = 0; i < 10; ++i) { const int rr = rb - 1 + i; const bool ok = (i == 0) ? lo_ok : ((i == 9) ? hi_ok : true);
                        cu[i] = *(const u32x4*)(CU + (size_t)(ok ? rr : rb) * D + k); if (!ok) cu[i] = (u32x4){0u, 0u, 0u, 0u}; }
#pragma unroll
                    for (int i = 0; i < 8; ++i) cb[i] = *(const u32x4*)(CB + (size_t)(rb + i) * D + k);
#pragma unroll
                    for (int i = 0; i < 8; ++i) { float um[8], u0[8], up[8], bb[8], o[8]; unpack8(cu[i], um); unpack8(cu[i + 1], u0); unpack8(cu[i + 2], up); unpack8(cb[i], bb);
#pragma unroll
                        for (int q = 0; q < 8; ++q) o[q] = bb[q] * (w0[q] * um[q] + w1[q] * u0[q] + w2[q] * up[q]);
                        u32x4 w; w.x = pk2(o[0], o[1]); w.y = pk2(o[2], o[3]); w.z = pk2(o[4], o[5]); w.w = pk2(o[6], o[7]);
                        *(u32x4*)(ACV + (size_t)(rb + i) * D + k) = w; }
                }
            }
        } break;
        case 13: if (PHMASK & (1<<13)) {
            for (int v = bx * NTHR + tid; v < 2 * 131072; v += G * NTHR) {
                const int dir = v >> 17, w = v & 131071, bh_ = w >> 14, h = bh_ & 3;
                bf16* base = (dir ? SBB : SFB) + (size_t)bh_ * NSC * DV * DK + (size_t)(w & 16383) * 8;
                const float g512 = __builtin_amdgcn_exp2f(512.0f * __builtin_amdgcn_logf(1.0f - __builtin_amdgcn_exp2f(-(dir ? 5.5f : 5.0f) - (float)h)));
                u32x4 r[8];
#pragma unroll
                for (int k = 0; k < 8; ++k) r[k] = *(const u32x4*)(base + (size_t)(dir ? 7 - k : 8 + k) * DV * DK);
                float S[8]; unpack8(r[0], S);
#pragma unroll
                for (int k = 1; k < 8; ++k) { float f[8]; unpack8(r[k], f);
#pragma unroll
                    for (int e = 0; e < 8; ++e) S[e] = S[e] * g512 + f[e];
                    u32x4 o; o.x = pk2(S[0], S[1]); o.y = pk2(S[2], S[3]); o.z = pk2(S[4], S[5]); o.w = pk2(S[6], S[7]);
                    *(u32x4*)(base + (size_t)(dir ? 7 - k : 8 + k) * DV * DK) = o; }
            }
        } break;
        default: break;
        }
        if (ph0 < args.ph_hi) xcd_barrier(bar);
        if (SSVAR == 6 && ph == 6) { for (int e_ = 0; e_ < 10; ++e_) xcd_barrier(bar); }
    }
}

#ifndef MK_PER_PHASE
#define MK_PER_PHASE 0
#endif
extern "C" void kernel_launch(void* const* d_in, const int* in_sizes, int n_in, void* d_out, int out_size, void* d_ws, size_t ws_size, hipStream_t stream) {
    static int grid = 0;
    if (grid == 0) {
        if (n_in != N_IN || out_size != M * D || ws_size < WS_END) { fprintf(stderr, "kernel_launch: unexpected shapes (n_in %d, out %d, ws %zu); nothing launched\n", n_in, out_size, ws_size); grid = -1; return; }
        int dev = 0, cus = 0, per_cu = 0;
        if (hipGetDevice(&dev) != hipSuccess || hipDeviceGetAttribute(&cus, hipDeviceAttributeMultiprocessorCount, dev) != hipSuccess) { grid = -1; return; }
        if (hipFuncSetAttribute((const void*)fwd_kernel, hipFuncAttributeMaxDynamicSharedMemorySize, LDS_BYTES) != hipSuccess) { fprintf(stderr, "kernel_launch: hipFuncSetAttribute failed\n"); grid = -1; return; }
        if (hipOccupancyMaxActiveBlocksPerMultiprocessor(&per_cu, (const void*)fwd_kernel, NTHR, LDS_BYTES) != hipSuccess || per_cu < 1) { fprintf(stderr, "kernel_launch: occupancy query says %d blocks per CU\n", per_cu); }
        (void)hipGetLastError();
        grid = cus;
    }
    if (grid < 0) return;
    (void)hipMemsetAsync((char*)d_ws + WS_CTL, 0, CTL_ZERO_BYTES, stream);
    Args a{};
    for (int i = 0; i < N_IN; ++i) a.in[i] = (const float*)d_in[i];
    a.out = (float*)d_out; a.ws = (unsigned char*)d_ws;
#if MK_PER_PHASE
    for (int p = 0; p < NPH; ++p) { a.ph_lo = p; a.ph_hi = p + 1; hipLaunchKernelGGL(fwd_kernel, dim3(grid), dim3(NTHR), LDS_BYTES, stream, a); }
#else
    a.ph_lo = 0; a.ph_hi = NPH; hipLaunchKernelGGL(fwd_kernel, dim3(grid), dim3(NTHR), LDS_BYTES, stream, a);
#if SSVAR == 7
    (void)hipMemsetAsync((char*)d_ws + WS_CTL, 0, CTL_ZERO_BYTES, stream); hipLaunchKernelGGL(fwd_kernel, dim3(grid), dim3(NTHR), LDS_BYTES, stream, a);
#endif
#endif
}
```

```cpp
#include <hip/hip_runtime.h>
#include <cstdio>
#include <cstdint>

#define LAS __attribute__((address_space(3)))
#define GAS __attribute__((address_space(1)))
typedef unsigned short bf16;
typedef short bf16x8 __attribute__((ext_vector_type(8)));
typedef float f32x4 __attribute__((ext_vector_type(4)));
typedef float f32x2 __attribute__((ext_vector_type(2)));
typedef unsigned u32x4 __attribute__((ext_vector_type(4)));
typedef unsigned u32x2 __attribute__((ext_vector_type(2)));

__device__ __forceinline__ int opaque(int v) { asm volatile("" : "+v"(v)); return v; }
constexpr int D = 1024, BATCH = 2, SEQ = 8192, M = BATCH * SEQ, CTXL = 256, MC = BATCH * CTXL, NH = 4, DK = 256, DV = 512, FF = 2816, NQ = 6 * D;
constexpr int SC = 512, NSC = SEQ / SC;
constexpr float EPS = 1e-6f;
constexpr int NWAVES = 8, NTHR = 512;

constexpr size_t MiB = 1u << 20, HMiB = 1u << 19;
constexpr size_t WS_CTL = 0, CTL_ZERO_BYTES = 1 * MiB;
constexpr size_t CTL_ADA = 65536;
constexpr size_t WS_MISC = 1 * MiB;
constexpr size_t MS_ROPE = WS_MISC;
constexpr size_t MS_RSTDX = MS_ROPE + 65536;
constexpr size_t MS_RSTDC = MS_RSTDX + 65536;
constexpr size_t MS_BIAS1 = MS_RSTDC + 4096;
constexpr int NKQ = 8;
constexpr size_t MS_BIAS3 = 262144;
constexpr size_t MS_BIAS5 = MS_BIAS1 + 3 * 6144 * 4;
static_assert(MS_BIAS3 + 4 * NKQ * 5632 * 4 <= 1 * MiB && MS_BIAS5 + 2 * NKQ * 3072 * 4 <= 1 * MiB + 512 * 1024, "misc region");
constexpr size_t MS_XPART = 1 * MiB + 512 * 1024;
constexpr size_t WS_SSQ = 2 * MiB;
constexpr size_t WS_WQKVG = 3 * MiB;
constexpr size_t WS_WO = 15 * MiB;
constexpr size_t WS_W2_0 = 19 * MiB;
constexpr size_t WS_W2_1 = 24 * MiB + HMiB;
constexpr size_t WS_WCO = 30 * MiB;
constexpr size_t WS_ACB = 60 * MiB;
constexpr size_t WS_XB = 61 * MiB;
constexpr size_t WS_Q = 93 * MiB;
constexpr size_t WS_K = 125 * MiB;
constexpr size_t WS_VT = 157 * MiB;
constexpr size_t WS_SB = 221 * MiB;
constexpr size_t WS_KC = 253 * MiB;
constexpr size_t WS_VCT = 254 * MiB;
constexpr size_t WS_SF = WS_XB;
constexpr size_t WS_HID = 93 * MiB;
constexpr size_t WS_CU = 93 * MiB, WS_CB = 125 * MiB, WS_ACV = 157 * MiB;
constexpr size_t WS_W13_0 = 181 * MiB;
constexpr size_t WS_WCI = 203 * MiB;
constexpr size_t WS_W13_1 = 215 * MiB;
constexpr size_t WS_END = 256 * MiB;

namespace pg8 {
typedef unsigned short bf16_t;
constexpr int BM = 256, BK = 64, HALF = 128, HTB = HALF * BK * 2, STAGE_BYTES = 8 * HTB, NXCD = 8, WGM = 8;
__host__ __device__ __forceinline__ int lds_byte(int r, int c) { const int st = (r >> 4) * 2 + (c >> 5), rr = r & 15, cc = c & 31, ob = rr * 64 + cc * 2; return st * 1024 + (ob ^ (((ob >> 9) & 1) << 5)); }
__host__ __device__ __forceinline__ void stage_rc(int b, int& R, int& C) { const int st = b / 1024, sb = b % 1024, swz = sb ^ (((sb >> 9) & 1) << 5); R = (st >> 1) * 16 + swz / 64; C = (st & 1) * 32 + (swz % 64) / 2; }
__host__ __device__ __forceinline__ int perm32(int rho) { const int n = rho >> 4, i = rho & 15; return 8 * (i >> 2) + 4 * n + (i & 3); }
struct Unit { int pm, pn; };
struct Gemm { const bf16_t* A; const bf16_t* Bt; int M, N, K; size_t bstride; };
struct StaticOrder {
    int nM, nN, nwg, G, c;
    __host__ __device__ void init(int M_, int N_, int G_, int c_) { nM = M_ / BM; nN = N_ / BM; nwg = nM * nN; G = G_; c = c_; }
    __host__ __device__ bool next(int i, Unit& u) const {
        const long L = (long)i * G + c; if (L >= nwg) return false;
        int wgid = (int)L; { const int q = nwg / NXCD, r = nwg % NXCD, xcd = wgid % NXCD, off = wgid / NXCD; wgid = (xcd < r ? xcd * (q + 1) : r * (q + 1) + (xcd - r) * q) + off; }
        const int nig = WGM * nN, gid = wgid / nig, fm = gid * WGM, gsz = (nM - fm) < WGM ? (nM - fm) : WGM;
        u.pm = fm + ((wgid % nig) % gsz); u.pn = (wgid % nig) / gsz; return true;
    }
    __device__ __forceinline__ void a_ready(const Unit&) const {}
    __device__ __forceinline__ void done(const Unit&) const {}
};
struct OneUnit { int pm, pn; bool have;
    __device__ __forceinline__ bool next(int i, Unit& u) const { if (i != 0 || !have) return false; u.pm = pm; u.pn = pn; return true; }
    __device__ __forceinline__ void a_ready(const Unit&) const {}
    __device__ __forceinline__ void done(const Unit&) const {}
};
template <class Epi, class Sched, bool ALIGN_EPI, bool SP2, bool SWAP>
__device__ __forceinline__ void gemm_phase(LAS unsigned char* lds, const Gemm g, const Sched& S, const Epi& E, const int tid) {
    const int wid = __builtin_amdgcn_readfirstlane(tid >> 6), wr = wid >> 2, wc = wid & 3;
    int lane = tid & 63, fr = lane & 15, fq = lane >> 4;
    const int K = g.K, nt = K / BK;
    unsigned voffA[2], voffB[2]; int aoff, boff;
#define PG8_SETUP() do { const int t_ = opaque(tid); lane = t_ & 63; fr = lane & 15; fq = lane >> 4; \
        _Pragma("unroll") for (int i = 0; i < 2; ++i) { int R, C; stage_rc(t_ * 16 + i * 8192, R, C); const int Rp = (R & ~31) + perm32(R & 31); \
            voffA[i] = (unsigned)((SWAP ? Rp : R) * K + C) * 2u; voffB[i] = (unsigned)((SWAP ? R : Rp) * K + C) * 2u; } \
        aoff = lds_byte(wr * 64 + fr, fq * 8); boff = lds_byte(wc * 32 + fr, fq * 8); } while (0)
    PG8_SETUP();
    const size_t kstep = (size_t)(BK * 2);
    const size_t hstep = (size_t)HALF * K * 2;
    const size_t tstep = 2 * hstep;
    const unsigned ldsw = (unsigned)wid * 1024u;
#define PG8_SA(b, h) (((b) * 2 + (h)) * HTB)
#define PG8_SB(b, h) ((4 + (b) * 2 + (h)) * HTB)
#define PG8_STAGE(bufoff, gbase, voff) do { _Pragma("unroll") for (int _i = 0; _i < 2; ++_i) \
        __builtin_amdgcn_global_load_lds((const unsigned*)((const char*)(gbase) + (voff)[_i]), (LAS unsigned*)(lds + (bufoff) + ldsw + _i * 8192), 16, 0, 0); } while (0)
#define PG8_LDA(dst, b, h) do { _Pragma("unroll") for (int m = 0; m < 4; ++m) _Pragma("unroll") for (int k = 0; k < 2; ++k) dst[m][k] = *(const LAS bf16x8*)(lds + PG8_SA(b, h) + aoff + m * 2048 + k * 1024); } while (0)
#define PG8_LDB(dst, b, h) do { _Pragma("unroll") for (int n = 0; n < 2; ++n) _Pragma("unroll") for (int k = 0; k < 2; ++k) dst[n][k] = *(const LAS bf16x8*)(lds + PG8_SB(b, h) + boff + n * 2048 + k * 1024); } while (0)
#define PG8_MMA(ai, bj, At, Bt) do { __builtin_amdgcn_s_setprio(1); _Pragma("unroll") for (int m = 0; m < 4; ++m) _Pragma("unroll") for (int n = 0; n < 2; ++n) _Pragma("unroll") for (int k = 0; k < 2; ++k) \
        acc[ai][bj][m][n] = SWAP ? __builtin_amdgcn_mfma_f32_16x16x32_bf16(At[m][k], Bt[n][k], acc[ai][bj][m][n], 0, 0, 0) \
                                 : __builtin_amdgcn_mfma_f32_16x16x32_bf16(Bt[n][k], At[m][k], acc[ai][bj][m][n], 0, 0, 0); __builtin_amdgcn_s_setprio(0); } while (0)
#define PG8_WAIT_V(n) asm volatile("s_waitcnt vmcnt(" #n ")" ::: "memory")
#define PG8_WAIT_L(n) asm volatile("s_waitcnt lgkmcnt(" #n ")" ::: "memory")
#define PG8_BAR __builtin_amdgcn_s_barrier()
#define PG8_SCHED __builtin_amdgcn_sched_barrier(0)
    Unit cur, nxt; int ui = 0;
    if (!S.next(0, cur)) return;
    f32x4 acc[2][2][4][2];
#pragma unroll
    for (int a = 0; a < 2; ++a)
#pragma unroll
        for (int b = 0; b < 2; ++b)
#pragma unroll
            for (int m = 0; m < 4; ++m)
#pragma unroll
                for (int n = 0; n < 2; ++n) acc[a][b][m][n] = (f32x4){0.f, 0.f, 0.f, 0.f};
    bf16x8 At[4][2], B0[2][2], B1[2][2];
    const char* cA = (const char*)g.A + (size_t)cur.pm * tstep; const char* cB = (const char*)g.Bt + (size_t)cur.pn * tstep + (cur.pm >= 32 ? g.bstride : 0);
    S.a_ready(cur);
    if constexpr (SP2) {
        PG8_STAGE(PG8_SB(0, 0), cB, voffB); PG8_STAGE(PG8_SB(0, 1), cB + hstep, voffB); PG8_STAGE(PG8_SA(0, 0), cA, voffA); PG8_STAGE(PG8_SA(0, 1), cA + hstep, voffA);
        if (wr == 1) PG8_BAR;
        PG8_WAIT_V(2); PG8_BAR;
        PG8_STAGE(PG8_SB(1, 0), cB + kstep, voffB); PG8_STAGE(PG8_SA(1, 0), cA + kstep, voffA); PG8_STAGE(PG8_SB(1, 1), cB + hstep + kstep, voffB);
        PG8_WAIT_V(6); PG8_BAR;
    } else {
        PG8_STAGE(PG8_SB(0, 0), cB, voffB); PG8_STAGE(PG8_SA(0, 0), cA, voffA); PG8_STAGE(PG8_SB(0, 1), cB + hstep, voffB); PG8_STAGE(PG8_SA(0, 1), cA + hstep, voffA);
        if (wr == 1) PG8_BAR;
        PG8_WAIT_V(4); PG8_BAR;
        PG8_STAGE(PG8_SB(1, 0), cB + kstep, voffB); PG8_STAGE(PG8_SA(1, 0), cA + kstep, voffA); PG8_STAGE(PG8_SB(1, 1), cB + hstep + kstep, voffB);
        PG8_WAIT_V(6); PG8_BAR;
    }
    for (;;) {
        const bool has_next = S.next(ui + 1, nxt);
        const char* nA = has_next ? (const char*)g.A + (size_t)nxt.pm * tstep : cA; const char* nB = has_next ? (const char*)g.Bt + (size_t)nxt.pn * tstep + (nxt.pm >= 32 ? g.bstride : 0) : cB;
        for (int t = 0; t < nt; t += 2) {
            const bool last = (t == nt - 2);
            const char* a1 = cA + (size_t)(t + 1) * kstep;
            const char* a2 = last ? nA : cA + (size_t)(t + 2) * kstep; const char* b2 = last ? nB : cB + (size_t)(t + 2) * kstep;
            const char* a3 = a2 + kstep; const char* b3 = b2 + kstep;
            if (last && has_next) S.a_ready(nxt);
            if constexpr (SP2) {
            PG8_LDB(B0, 0, 0); PG8_LDB(B1, 0, 1); PG8_SCHED; PG8_LDA(At, 0, 0); PG8_STAGE(PG8_SA(1, 1), a1 + hstep, voffA);
            PG8_WAIT_V(8); PG8_WAIT_L(0); PG8_BAR; PG8_MMA(0, 0, At, B0); PG8_MMA(0, 1, At, B1); PG8_BAR; PG8_SCHED;
            PG8_LDA(At, 0, 1); PG8_STAGE(PG8_SB(0, 0), b2, voffB); PG8_STAGE(PG8_SB(0, 1), b2 + hstep, voffB); PG8_STAGE(PG8_SA(0, 0), a2, voffA);
            PG8_WAIT_V(8); PG8_WAIT_L(0); PG8_BAR; PG8_MMA(1, 0, At, B0); PG8_MMA(1, 1, At, B1); PG8_BAR; PG8_SCHED;
            PG8_LDB(B0, 1, 0); PG8_LDB(B1, 1, 1); PG8_SCHED; PG8_LDA(At, 1, 0); PG8_STAGE(PG8_SA(0, 1), a2 + hstep, voffA);
            PG8_WAIT_V(8); PG8_WAIT_L(0); PG8_BAR; PG8_MMA(0, 0, At, B0); PG8_MMA(0, 1, At, B1); PG8_BAR; PG8_SCHED;
            PG8_LDA(At, 1, 1); PG8_STAGE(PG8_SB(1, 0), b3, voffB); PG8_STAGE(PG8_SB(1, 1), b3 + hstep, voffB); PG8_STAGE(PG8_SA(1, 0), a3, voffA);
            PG8_WAIT_V(8); PG8_WAIT_L(0); PG8_BAR; PG8_MMA(1, 0, At, B0); PG8_MMA(1, 1, At, B1); PG8_BAR; PG8_SCHED;
            } else {
            PG8_LDB(B0, 0, 0); PG8_SCHED; PG8_LDA(At, 0, 0); PG8_STAGE(PG8_SA(1, 1), a1 + hstep, voffA);
            PG8_WAIT_L(8); PG8_BAR; PG8_WAIT_L(0); PG8_MMA(0, 0, At, B0); PG8_BAR; PG8_SCHED;
            PG8_LDB(B1, 0, 1); PG8_STAGE(PG8_SB(0, 0), b2, voffB);
            PG8_BAR; PG8_WAIT_L(0); PG8_MMA(0, 1, At, B1); PG8_BAR;
            PG8_LDA(At, 0, 1); PG8_STAGE(PG8_SA(0, 0), a2, voffA);
            PG8_BAR; PG8_WAIT_L(0); PG8_MMA(1, 0, At, B0); PG8_BAR; PG8_SCHED;
            PG8_STAGE(PG8_SB(0, 1), b2 + hstep, voffB);
            PG8_WAIT_V(6); PG8_BAR; PG8_MMA(1, 1, At, B1); PG8_BAR;
            PG8_LDB(B0, 1, 0); PG8_SCHED; PG8_LDA(At, 1, 0); PG8_STAGE(PG8_SA(0, 1), a2 + hstep, voffA);
            PG8_WAIT_L(8); PG8_BAR; PG8_WAIT_L(0); PG8_MMA(0, 0, At, B0); PG8_BAR; PG8_SCHED;
            PG8_LDB(B1, 1, 1); PG8_STAGE(PG8_SB(1, 0), b3, voffB);
            PG8_BAR; PG8_WAIT_L(0); PG8_MMA(0, 1, At, B1); PG8_BAR;
            PG8_LDA(At, 1, 1); PG8_STAGE(PG8_SA(1, 0), a3, voffA);
            PG8_BAR; PG8_WAIT_L(0); PG8_MMA(1, 0, At, B0); PG8_BAR; PG8_SCHED;
            PG8_STAGE(PG8_SB(1, 1), b3 + hstep, voffB);
            PG8_WAIT_V(6); PG8_BAR; PG8_MMA(1, 1, At, B1); PG8_BAR;
            }
        }
        if constexpr (ALIGN_EPI) { if (wr == 0) PG8_BAR; }
        E(acc, cur, wr, wc, fr, fq, ui); S.done(cur);
        PG8_SETUP();
        if (!has_next) break;
#pragma unroll
        for (int a = 0; a < 2; ++a)
#pragma unroll
            for (int b = 0; b < 2; ++b)
#pragma unroll
                for (int m = 0; m < 4; ++m)
#pragma unroll
                    for (int n = 0; n < 2; ++n) acc[a][b][m][n] = (f32x4){0.f, 0.f, 0.f, 0.f};
        cur = nxt; cA = nA; cB = nB; ++ui;
        if constexpr (ALIGN_EPI) { if (wr == 1) PG8_BAR; }
    }
    PG8_WAIT_V(0);
    if constexpr (!ALIGN_EPI) { if (wr == 0) PG8_BAR; }
    PG8_BAR;
#undef PG8_SETUP
#undef PG8_SA
#undef PG8_SB
#undef PG8_STAGE
#undef PG8_LDA
#undef PG8_LDB
#undef PG8_MMA
#undef PG8_WAIT_V
#undef PG8_WAIT_L
#undef PG8_BAR
#undef PG8_SCHED
}
}

#define RLX_AGENT __ATOMIC_RELAXED, __HIP_MEMORY_SCOPE_AGENT
#define LDS_WAIT() asm volatile("s_waitcnt lgkmcnt(0)" ::: "memory")
typedef __bf16 hbf16x2 __attribute__((ext_vector_type(2)));
__device__ __forceinline__ unsigned pk2(float lo, float hi) { const f32x2 v = {lo, hi}; return __builtin_bit_cast(unsigned, __builtin_convertvector(v, hbf16x2)); }
__device__ __forceinline__ unsigned f2bf(float f) { return pk2(f, 0.f) & 0xffffu; }
__device__ __forceinline__ float bf2f(unsigned h) { return __builtin_bit_cast(float, h << 16); }
__device__ __forceinline__ float bflo(unsigned w) { return __builtin_bit_cast(float, w << 16); }
__device__ __forceinline__ float bfhi(unsigned w) { return __builtin_bit_cast(float, w & 0xffff0000u); }
__device__ __forceinline__ float siluf(float x) { return x * __builtin_amdgcn_rcpf(1.0f + __builtin_amdgcn_exp2f(-1.44269504089f * x)); }
__device__ __forceinline__ float wave_sum(float v) {
#pragma unroll
    for (int o = 1; o < 64; o <<= 1) v += __shfl_xor(v, o);
    return v;
}
__device__ __forceinline__ u32x4 pack8(const f32x4 a, const f32x4 b) { u32x4 w; w.x = pk2(a[0], a[1]); w.y = pk2(a[2], a[3]); w.z = pk2(b[0], b[1]); w.w = pk2(b[2], b[3]); return w; }

using pg8::Unit;
typedef f32x4 Acc[2][2][4][2];
struct EpiQKG {
    bf16* Q; bf16* K; bf16* G; const float* rstd; const float* bias;
    __device__ __forceinline__ void operator()(const Acc& acc, const Unit& u, int wr, int wc, int fr_, int fq_, int ui) const {
        const int fr = opaque(fr_), fq = opaque(fq_);
        const int b = u.pm >> 5; const float* bb = bias + b * NQ + u.pn * 256 + wc * 32 + 8 * fq;
        const int row0 = u.pm * 256 + wr * 64 + fr;
        f32x4 bv[2][2]; float rs[2][4];
#pragma unroll
        for (int ai = 0; ai < 2; ++ai)
#pragma unroll
            for (int m = 0; m < 4; ++m) rs[ai][m] = rstd[row0 + ai * 128 + m * 16];
#pragma unroll
        for (int bj = 0; bj < 2; ++bj)
#pragma unroll
            for (int n = 0; n < 2; ++n) bv[bj][n] = *(const f32x4*)(bb + bj * 128 + 4 * n);
        if (u.pn < 8) {
            const bool isk = u.pn >= 4; bf16* O = isk ? K : Q; const float osc = isk ? 0.0625f : 1.0f;
            const int a = wc >> 1, i0 = (wc & 1) * 32 + 8 * fq, colo = (u.pn & 3) * 256 + wc * 32 + 8 * fq;
            f32x4 frv[2];
#pragma unroll
            for (int n = 0; n < 2; ++n)
#pragma unroll
                for (int j = 0; j < 4; ++j) frv[n][j] = __builtin_amdgcn_exp2f(-(float)(i0 + 4 * n + j) * (13.287712379549449f / 64.0f)) * 0.15915494309189535f;
#pragma unroll
            for (int ai = 0; ai < 2; ++ai)
#pragma unroll
                for (int m = 0; m < 4; ++m) {
                    const int r = row0 + ai * 128 + m * 16; const float rsv = rs[ai][m]; const int t = r & (SEQ - 1); const float pos = (float)(a ? (t & 63) : (t >> 6));
                    f32x4 o1[2], o2[2];
#pragma unroll
                    for (int n = 0; n < 2; ++n) {
                        f32x4 cs, sn;
#pragma unroll
                        for (int j = 0; j < 4; ++j) { const float rv = __builtin_amdgcn_fractf(pos * frv[n][j]); cs[j] = __builtin_amdgcn_cosf(rv); sn[j] = __builtin_amdgcn_sinf(rv); }
                        const f32x4 x1 = acc[ai][0][m][n] * rsv + bv[0][n], x2 = acc[ai][1][m][n] * rsv + bv[1][n];
                        o1[n] = (x1 * cs - x2 * sn) * osc; o2[n] = (x1 * sn + x2 * cs) * osc;
                    }
                    bf16* rowp = O + (size_t)r * D + colo;
                    *(u32x4*)(rowp) = pack8(o1[0], o1[1]); *(u32x4*)(rowp + 128) = pack8(o2[0], o2[1]);
                }
        } else {
            const int colo = (u.pn - 8) * 256 + wc * 32 + 8 * fq;
#pragma unroll
            for (int ai = 0; ai < 2; ++ai)
#pragma unroll
                for (int m = 0; m < 4; ++m) {
                    const int r = row0 + ai * 128 + m * 16; const float rsv = rs[ai][m]; bf16* rowp = G + (size_t)r * 2048 + colo;
#pragma unroll
                    for (int bj = 0; bj < 2; ++bj) *(u32x4*)(rowp + bj * 128) = pack8(acc[ai][bj][m][0] * rsv + bv[bj][0], acc[ai][bj][m][1] * rsv + bv[bj][1]);
                }
        }
    }
};
struct EpiVT {
    bf16* VT; const float* rstd; const float* bias; int ldt; int tiles_per_b; int bias_row;
    __device__ __forceinline__ void operator()(const Acc& acc, const Unit& u, int wr, int wc, int fr_, int fq_, int ui) const {
        const int fr = opaque(fr_), fq = opaque(fq_);
        const int b = u.pm / tiles_per_b, t00 = (u.pm % tiles_per_b) * 256 + wr * 64 + 8 * fq, h = u.pn >> 1, e0 = (u.pn & 1) * 256 + wc * 32 + fr;
        const float* bb = bias + (bias_row < 0 ? b : bias_row) * NQ;
        float bs[2][2];
#pragma unroll
        for (int bj = 0; bj < 2; ++bj)
#pragma unroll
            for (int n = 0; n < 2; ++n) bs[bj][n] = bb[u.pn * 256 + bj * 128 + wc * 32 + n * 16 + fr];
        f32x4 rsv[2][2][2];
#pragma unroll
        for (int ai = 0; ai < 2; ++ai)
#pragma unroll
            for (int mp = 0; mp < 2; ++mp) { const float* rp = rstd + b * ldt + t00 + ai * 128 + mp * 32; rsv[ai][mp][0] = *(const f32x4*)rp; rsv[ai][mp][1] = *(const f32x4*)(rp + 4); }
#pragma unroll
        for (int ai = 0; ai < 2; ++ai)
#pragma unroll
            for (int mp = 0; mp < 2; ++mp) {
                const int tl = t00 + ai * 128 + mp * 32;
                const f32x4 r0 = rsv[ai][mp][0], r1 = rsv[ai][mp][1];
#pragma unroll
                for (int bj = 0; bj < 2; ++bj)
#pragma unroll
                    for (int n = 0; n < 2; ++n) {
                        const f32x4 v0 = acc[ai][bj][2 * mp][n] * r0 + bs[bj][n], v1 = acc[ai][bj][2 * mp + 1][n] * r1 + bs[bj][n];
                        bf16* p = VT + ((size_t)(((b * NH + h) * (ldt >> 7) + (tl >> 7)) * DV + e0 + bj * 128 + n * 16)) * 128 + (tl & 127);
                        *(u32x4*)p = pack8(v0, v1);
                    }
            }
    }
};
struct EpiRes {
    const float* res32; const bf16* res16; bf16* hx; const float* gate; float* ssq; int dry;
    __device__ __forceinline__ void operator()(const Acc& acc, const Unit& u, int wr, int wc, int fr_, int fq_, int ui) const {
        const int fr = opaque(fr_), fq = opaque(fq_);
        const int b = u.pm >> 5, col0 = u.pn * 256 + wc * 32 + 8 * fq, row0 = u.pm * 256 + wr * 64 + fr;
        f32x4 gv[2][2];
#pragma unroll
        for (int bj = 0; bj < 2; ++bj)
#pragma unroll
            for (int n = 0; n < 2; ++n) gv[bj][n] = *(const f32x4*)(gate + b * NQ + col0 + bj * 128 + 4 * n);
#pragma unroll
        for (int am = 0; am < 8; am += 2) {
            f32x4 rv[2][2][2];
            if (res32) {
#pragma unroll
                for (int q = 0; q < 2; ++q)
#pragma unroll
                    for (int bj = 0; bj < 2; ++bj) { const float* p = res32 + (size_t)(row0 + ((am + q) >> 2) * 128 + ((am + q) & 3) * 16) * D + col0 + bj * 128; rv[q][bj][0] = *(const f32x4*)p; rv[q][bj][1] = *(const f32x4*)(p + 4); }
            } else {
                u32x4 rw[2][2];
#pragma unroll
                for (int q = 0; q < 2; ++q)
#pragma unroll
                    for (int bj = 0; bj < 2; ++bj) rw[q][bj] = *(const u32x4*)(res16 + (size_t)(row0 + ((am + q) >> 2) * 128 + ((am + q) & 3) * 16) * D + col0 + bj * 128);
#pragma unroll
                for (int q = 0; q < 2; ++q)
#pragma unroll
                    for (int bj = 0; bj < 2; ++bj) { const u32x4 w = rw[q][bj]; rv[q][bj][0] = (f32x4){bflo(w.x), bfhi(w.x), bflo(w.y), bfhi(w.y)}; rv[q][bj][1] = (f32x4){bflo(w.z), bfhi(w.z), bflo(w.w), bfhi(w.w)}; }
            }
#pragma unroll
            for (int q = 0; q < 2; ++q) {
                const int ai = (am + q) >> 2, m = (am + q) & 3;
                const int r = row0 + ai * 128 + m * 16; const size_t off = (size_t)r * D + col0; float ss = 0.f;
#pragma unroll
                for (int bj = 0; bj < 2; ++bj) {
                    const f32x4 o0 = rv[q][bj][0] + gv[bj][0] * acc[ai][bj][m][0], o1 = rv[q][bj][1] + gv[bj][1] * acc[ai][bj][m][1];
                    ss += (o0[0] * o0[0] + o0[1] * o0[1]) + (o0[2] * o0[2] + o0[3] * o0[3]) + (o1[0] * o1[0] + o1[1] * o1[1]) + (o1[2] * o1[2] + o1[3] * o1[3]);
                    if (!dry) *(u32x4*)(hx + off + bj * 128) = pack8(o0, o1);
                }
                ss += __shfl_xor(ss, 16); ss += __shfl_xor(ss, 32);
                if (fq == 0) ssq[(size_t)r * 16 + u.pn * 4 + wc] = ss;
            }
        }
    }
};
constexpr int CW_PANEL = 8192;
struct EpiResFinal {
    const bf16* res16; float* out; const float* gate; const float* fn; float* xpart; unsigned* cnt; LAS unsigned char* ldsb;
    __device__ __forceinline__ void operator()(Acc& acc, const Unit& u, int wr, int wc, int fr_, int fq_, int ui) const {
        const int fr = opaque(fr_), fq = opaque(fq_), tid = opaque((int)threadIdx.x);
        const int b = u.pm >> 5, col0 = u.pn * 256 + wc * 32 + 8 * fq, row0 = u.pm * 256 + wr * 64 + fr;
        LAS float* part = (LAS float*)ldsb;
        LAS float* rtab = (LAS float*)(ldsb + 4096);
        f32x4 gv[2][2];
#pragma unroll
        for (int bj = 0; bj < 2; ++bj)
#pragma unroll
            for (int n = 0; n < 2; ++n) gv[bj][n] = *(const f32x4*)(gate + b * NQ + col0 + bj * 128 + 4 * n);
#pragma unroll
        for (int am = 0; am < 8; am += 2) {
            u32x4 rw[2][2];
#pragma unroll
            for (int q = 0; q < 2; ++q)
#pragma unroll
                for (int bj = 0; bj < 2; ++bj) rw[q][bj] = *(const u32x4*)(res16 + (size_t)(row0 + ((am + q) >> 2) * 128 + ((am + q) & 3) * 16) * D + col0 + bj * 128);
#pragma unroll
            for (int q = 0; q < 2; ++q) { const int ai = (am + q) >> 2, m = (am + q) & 3; float ss = 0.f;
#pragma unroll
                for (int bj = 0; bj < 2; ++bj) { const u32x4 w = rw[q][bj];
                    const f32x4 o0 = (f32x4){bflo(w.x), bfhi(w.x), bflo(w.y), bfhi(w.y)} + gv[bj][0] * acc[ai][bj][m][0], o1 = (f32x4){bflo(w.z), bfhi(w.z), bflo(w.w), bfhi(w.w)} + gv[bj][1] * acc[ai][bj][m][1];
                    ss += (o0[0] * o0[0] + o0[1] * o0[1]) + (o0[2] * o0[2] + o0[3] * o0[3]) + (o1[0] * o1[0] + o1[1] * o1[1]) + (o1[2] * o1[2] + o1[3] * o1[3]);
                    acc[ai][bj][m][0] = o0; acc[ai][bj][m][1] = o1; }
                ss += __shfl_xor(ss, 16); ss += __shfl_xor(ss, 32);
                if (fq == 0) part[(ai * 128 + wr * 64 + m * 16 + fr) * 4 + wc] = ss; }
        }
        asm volatile("s_waitcnt lgkmcnt(0)" ::: "memory"); __builtin_amdgcn_s_barrier(); asm volatile("" ::: "memory");
        if (tid < 256) { const f32x4 p4 = *(const LAS f32x4*)(part + tid * 4);
            __hip_atomic_store(xpart + (size_t)(u.pm * 256 + tid) * 4 + u.pn, (p4[0] + p4[1]) + (p4[2] + p4[3]), __ATOMIC_RELAXED, __HIP_MEMORY_SCOPE_AGENT); }
        asm volatile("s_waitcnt vmcnt(0)" ::: "memory"); __builtin_amdgcn_s_barrier(); asm volatile("" ::: "memory");
        if (tid == 0) { __hip_atomic_fetch_add(cnt + CW_PANEL + 64 * u.pm, 1u, __ATOMIC_RELAXED, __HIP_MEMORY_SCOPE_AGENT);
            unsigned sp = 0; while (__hip_atomic_load(cnt + CW_PANEL + 64 * u.pm, __ATOMIC_RELAXED, __HIP_MEMORY_SCOPE_AGENT) < 4u) { __builtin_amdgcn_s_sleep(2); if (++sp > (1u << 22)) break; } }
        asm volatile("s_waitcnt vmcnt(0) lgkmcnt(0)" ::: "memory"); __builtin_amdgcn_s_barrier(); asm volatile("" ::: "memory");
        if (tid < 256) { const float* xp = xpart + (size_t)(u.pm * 256 + tid) * 4; float t = 0.f;
#pragma unroll
            for (int q = 0; q < 4; ++q) t += __hip_atomic_load(xp + q, __ATOMIC_RELAXED, __HIP_MEMORY_SCOPE_AGENT);
            rtab[tid] = 1.0f / sqrtf(t * (1.0f / D) + EPS); }
        asm volatile("s_waitcnt vmcnt(0) lgkmcnt(0)" ::: "memory"); __builtin_amdgcn_s_barrier(); asm volatile("" ::: "memory");
        f32x4 fv[2][2];
#pragma unroll
        for (int bj = 0; bj < 2; ++bj)
#pragma unroll
            for (int n = 0; n < 2; ++n) fv[bj][n] = *(const f32x4*)(fn + col0 + bj * 128 + 4 * n);
#pragma unroll
        for (int ai = 0; ai < 2; ++ai)
#pragma unroll
            for (int m = 0; m < 4; ++m) { const float rs = rtab[ai * 128 + wr * 64 + m * 16 + fr]; float* op = out + (size_t)(row0 + ai * 128 + m * 16) * D + col0;
#pragma unroll
                for (int bj = 0; bj < 2; ++bj) { *(f32x4*)(op + bj * 128) = acc[ai][bj][m][0] * rs * fv[bj][0]; *(f32x4*)(op + bj * 128 + 4) = acc[ai][bj][m][1] * rs * fv[bj][1]; } }
    }
};
__device__ __forceinline__ float rstd_from_ssq(const float* ssq, int r) {
    const f32x4* p = (const f32x4*)(ssq + (size_t)r * 16); const f32x4 a = p[0], b = p[1], c = p[2], d = p[3];
    const float s = ((a[0] + a[1]) + (a[2] + a[3])) + ((b[0] + b[1]) + (b[2] + b[3])) + ((c[0] + c[1]) + (c[2] + c[3])) + ((d[0] + d[1]) + (d[2] + d[3]));
    return 1.0f / sqrtf(s * (1.0f / D) + EPS);
}
constexpr int RSTD_LDS = 131072, BIAS_LDS = 131072 + 8192;
struct EpiSwiGLU {
    bf16* HID; const LAS float* rtab; const LAS float* btab; int dry;
    __device__ __forceinline__ void operator()(const Acc& acc, const Unit& u, int wr, int wc, int fr_, int fq_, int ui) const {
        const int fr = opaque(fr_), fq = opaque(fq_); if (dry) return;
        f32x4 bv[2][2]; float rs[2][4];
#pragma unroll
        for (int ai = 0; ai < 2; ++ai)
#pragma unroll
            for (int m = 0; m < 4; ++m) rs[ai][m] = rtab[ui * 256 + ai * 128 + wr * 64 + m * 16 + fr];
#pragma unroll
        for (int bj = 0; bj < 2; ++bj)
#pragma unroll
            for (int n = 0; n < 2; ++n) bv[bj][n] = *(const LAS f32x4*)(btab + ui * 256 + bj * 128 + wc * 32 + 8 * fq + 4 * n);
        const int row0 = u.pm * 256 + wr * 64 + fr, colo = u.pn * 128 + wc * 32 + 8 * fq;
#pragma unroll
        for (int ai = 0; ai < 2; ++ai)
#pragma unroll
            for (int m = 0; m < 4; ++m) {
                const int r = row0 + ai * 128 + m * 16;
                f32x4 hv[2];
#pragma unroll
                for (int n = 0; n < 2; ++n) { const f32x4 a1 = acc[ai][0][m][n] * rs[ai][m] + bv[0][n], a3 = acc[ai][1][m][n] * rs[ai][m] + bv[1][n];
#pragma unroll
                    for (int j = 0; j < 4; ++j) hv[n][j] = siluf(a1[j]) * a3[j]; }
                *(u32x4*)(HID + (size_t)r * FF + colo) = pack8(hv[0], hv[1]);
            }
    }
};
struct EpiConvIn {
    bf16* CU; bf16* CB; const LAS float* rtab; const LAS float* btab;
    __device__ __forceinline__ void operator()(const Acc& acc, const Unit& u, int wr, int wc, int fr_, int fq_, int ui) const {
        const int fr = opaque(fr_), fq = opaque(fq_);
        f32x4 bv[2][2]; float rs[2][4];
#pragma unroll
        for (int ai = 0; ai < 2; ++ai)
#pragma unroll
            for (int m = 0; m < 4; ++m) rs[ai][m] = rtab[ui * 256 + ai * 128 + wr * 64 + m * 16 + fr];
#pragma unroll
        for (int bj = 0; bj < 2; ++bj)
#pragma unroll
            for (int n = 0; n < 2; ++n) bv[bj][n] = *(const LAS f32x4*)(btab + ui * 256 + bj * 128 + wc * 32 + 8 * fq + 4 * n);
        const int row0 = u.pm * 256 + wr * 64 + fr;
#pragma unroll
        for (int ai = 0; ai < 2; ++ai)
#pragma unroll
            for (int m = 0; m < 4; ++m) {
                const int r = row0 + ai * 128 + m * 16; const float rs_ = rs[ai][m];
                if (u.pn < 8) {
                    const f32x4 u0 = (acc[ai][0][m][0] * rs_ + bv[0][0]) * (acc[ai][1][m][0] * rs_ + bv[1][0]), u1 = (acc[ai][0][m][1] * rs_ + bv[0][1]) * (acc[ai][1][m][1] * rs_ + bv[1][1]);
                    *(u32x4*)(CU + (size_t)r * D + u.pn * 128 + wc * 32 + 8 * fq) = pack8(u0, u1);
                } else {
#pragma unroll
                    for (int bj = 0; bj < 2; ++bj) *(u32x4*)(CB + (size_t)r * D + (u.pn - 8) * 256 + bj * 128 + wc * 32 + 8 * fq) = pack8(acc[ai][bj][m][0] * rs_ + bv[bj][0], acc[ai][bj][m][1] * rs_ + bv[bj][1]);
                }
            }
    }
};

#define XB_TMO      128
#define XB_XCNT(j)  (256  + 64 * (j))
#define XB_XSUB(j)  (1280 + 64 * (j))
#define XB_XGEN(j)  (2304 + 64 * (j))
#define XB_TOP      3328
#define XB_TOPGEN   3392
#define XCD_BAR_WORDS 3456
#define XB_SPIN_CAP (1u << 20)
__device__ __forceinline__ unsigned xb_ld(unsigned* p)              { return __hip_atomic_load(p, __ATOMIC_RELAXED, __HIP_MEMORY_SCOPE_AGENT); }
__device__ __forceinline__ unsigned xb_add(unsigned* p, unsigned v) { return __hip_atomic_fetch_add(p, v, __ATOMIC_RELAXED, __HIP_MEMORY_SCOPE_AGENT); }
__device__ __forceinline__ unsigned xb_xcc_id() { return (unsigned)__builtin_amdgcn_s_getreg((3 << 11) | 20) & 0xFu; }
#define XB_SPIN(cond, bar) do { unsigned _sp = 0; while (cond) { __builtin_amdgcn_s_sleep(1); \
    if ((++_sp & 255u) == 0u) { if (xb_ld(&(bar)[XB_TMO])) break; if (_sp > XB_SPIN_CAP) { atomicAdd(&(bar)[XB_TMO], 1u); break; } } } } while (0)
struct XcdBarrier { unsigned* bar; unsigned x; volatile LAS unsigned* st; };
__device__ __forceinline__ XcdBarrier xcd_barrier_post(unsigned* bar, volatile LAS unsigned* st) {
    XcdBarrier b; b.bar = bar; b.x = xb_xcc_id(); b.st = st;
    if (threadIdx.x == 0) (void)xb_add(&bar[XB_XCNT(b.x)], 1u);
    return b;
}
__device__ __forceinline__ void xcd_barrier_complete(unsigned* bar, unsigned x, unsigned& nloc, unsigned& nx) {
    const unsigned G = gridDim.x * gridDim.y * gridDim.z;
    unsigned sum, cnt, mine, sp = 0u;
    for (;;) {
        sum = 0u; cnt = 0u; mine = 0u;
#pragma unroll
        for (unsigned j = 0; j < 16; ++j) { const unsigned c = xb_ld(&bar[XB_XCNT(j)]); sum += c; cnt += (c > 0u) ? 1u : 0u; mine = (j == x) ? c : mine; }
        if (sum == G) break;
        __builtin_amdgcn_s_sleep(1);
        if ((++sp & 255u) == 0u) { if (xb_ld(&bar[XB_TMO])) break; if (sp > XB_SPIN_CAP) { atomicAdd(&bar[XB_TMO], 1u); break; } }
    }
    nloc = mine > 0u ? mine : 1u; nx = cnt > 0u ? cnt : 1u;
}
__device__ __forceinline__ void xcd_barrier(const XcdBarrier& b) {
    asm volatile("s_waitcnt vmcnt(0)" ::: "memory");
    __syncthreads();
    if (threadIdx.x == 0) {
        unsigned* bar = b.bar;
        __builtin_amdgcn_s_waitcnt(0);
        unsigned nloc = b.st[0], nx = b.st[1];
        if (nloc == 0u) { xcd_barrier_complete(bar, b.x, nloc, nx); b.st[0] = nloc; b.st[1] = nx; }
        const unsigned old = xb_add(&bar[XB_XSUB(b.x)], 1u);
        const unsigned gen = old / nloc;
        if (old + 1u == (gen + 1u) * nloc) {
            __builtin_amdgcn_fence(__ATOMIC_RELEASE, "agent");
            asm volatile("s_waitcnt vmcnt(0)" ::: "memory");
            const unsigned og = xb_add(&bar[XB_TOP], 1u);
            const unsigned tg = og / nx;
            if (og + 1u == (tg + 1u) * nx) xb_add(&bar[XB_TOPGEN], 1u);
            else XB_SPIN(xb_ld(&bar[XB_TOPGEN]) == tg, bar);
            __builtin_amdgcn_fence(__ATOMIC_ACQUIRE, "agent");
            xb_add(&bar[XB_XGEN(b.x)], 1u);
            asm volatile("s_waitcnt vmcnt(0)" ::: "memory");
        } else {
            XB_SPIN(xb_ld(&bar[XB_XGEN(b.x)]) == gen, bar);
            __builtin_amdgcn_fence(__ATOMIC_ACQUIRE, "agent");
            asm volatile("s_waitcnt vmcnt(0)" ::: "memory");
        }
    }
    __syncthreads();
}

enum { IN_X = 0, IN_C, IN_CTX, IN_CCTX, IN_ADAW, IN_ADAB, IN_NMIX, IN_NFFN, IN_WQKVG, IN_WO, IN_WCI, IN_CW, IN_WCO, IN_W1, IN_W3, IN_W2, IN_FN, N_IN };
struct Args { const float* in[N_IN]; float* out; unsigned char* ws; int ph_lo, ph_hi; };
constexpr int CW_BAR = 4096;
constexpr int LDS_BYTES = 163840, MISC_OFF = 163712;
constexpr int NPH = 14;
#ifndef P1_RW
#define P1_RW 5
#endif
#define P1_R1 (16384 - 2048 * P1_RW)
#ifndef G1SEL
#define G1SEL 7
#endif
#ifndef PHMASK
#define PHMASK 0xFFFF
#endif

__device__ __forceinline__ void transpose_item(const float* W, int Nsrc, int K, bf16* WT, int k0, int n_src0, int dst_row0, LAS float* scr, int lane) {
#pragma unroll
    for (int i = 0; i < 32; ++i) { const int kk = 2 * i + (lane >> 5); scr[kk * 33 + (lane & 31)] = W[(size_t)(k0 + kk) * Nsrc + n_src0 + (lane & 31)]; }
    LDS_WAIT(); asm volatile("" ::: "memory");
    const int c = lane & 7;
#pragma unroll
    for (int j = 0; j < 4; ++j) { const int n = (lane >> 3) + 8 * j; const LAS float* s = scr + (8 * c) * 33 + n;
        u32x4 o; o.x = pk2(s[0 * 33], s[1 * 33]); o.y = pk2(s[2 * 33], s[3 * 33]); o.z = pk2(s[4 * 33], s[5 * 33]); o.w = pk2(s[6 * 33], s[7 * 33]);
        *(u32x4*)(WT + (size_t)(dst_row0 + n) * K + k0 + 8 * c) = o; }
    LDS_WAIT(); asm volatile("" ::: "memory");
}
__device__ __forceinline__ void transpose_item_scaled(const float* W, int Nsrc, bf16* WT0, bf16* WT1, int k0, int n_src0, int dst_row0, LAS float* scr, const LAS float* tab, float& a0, float& a1, int lane) {
    LAS float* s0 = scr; LAS float* s1 = scr + 64 * 33;
#pragma unroll
    for (int i = 0; i < 32; ++i) { const int kk = 2 * i + (lane >> 5); const float w = W[(size_t)(k0 + kk) * Nsrc + n_src0 + (lane & 31)];
        s0[kk * 33 + (lane & 31)] = w * tab[k0 + kk]; s1[kk * 33 + (lane & 31)] = w * tab[1024 + k0 + kk]; a0 += w * tab[2048 + k0 + kk]; a1 += w * tab[3072 + k0 + kk]; }
    LDS_WAIT(); asm volatile("" ::: "memory");
    const int c = lane & 7;
#pragma unroll
    for (int j = 0; j < 4; ++j) { const int n = (lane >> 3) + 8 * j; const LAS float* p0 = s0 + (8 * c) * 33 + n; const LAS float* p1 = s1 + (8 * c) * 33 + n;
        u32x4 o; o.x = pk2(p0[0 * 33], p0[1 * 33]); o.y = pk2(p0[2 * 33], p0[3 * 33]); o.z = pk2(p0[4 * 33], p0[5 * 33]); o.w = pk2(p0[6 * 33], p0[7 * 33]);
        *(u32x4*)(WT0 + (size_t)(dst_row0 + n) * D + k0 + 8 * c) = o;
        o.x = pk2(p1[0 * 33], p1[1 * 33]); o.y = pk2(p1[2 * 33], p1[3 * 33]); o.z = pk2(p1[4 * 33], p1[5 * 33]); o.w = pk2(p1[6 * 33], p1[7 * 33]);
        *(u32x4*)(WT1 + (size_t)(dst_row0 + n) * D + k0 + 8 * c) = o; }
    LDS_WAIT(); asm volatile("" ::: "memory");
}
template <bool SCALED>
__device__ __forceinline__ void tr64(const float* W, int Nsrc, int K, bf16* WT0, bf16* WT1, int k0, int n_src0, int dst_row0, const LAS float* tab, f32x4& a0, f32x4& a1, int lane) {
    const int n4 = lane & 15, kr = lane >> 4;
    const float* src = W + (size_t)(k0 + 16 * kr) * Nsrc + n_src0 + 4 * n4;
    f32x4 v[16];
#pragma unroll
    for (int i = 0; i < 16; ++i) v[i] = *(const f32x4*)(src + (size_t)i * Nsrc);
    if constexpr (!SCALED) {
#pragma unroll
        for (int j = 0; j < 4; ++j) { bf16* drow = WT0 + (size_t)(dst_row0 + 4 * n4 + j) * K + k0 + 16 * kr;
#pragma unroll
            for (int h = 0; h < 2; ++h) { u32x4 o; o.x = pk2(v[8 * h][j], v[8 * h + 1][j]); o.y = pk2(v[8 * h + 2][j], v[8 * h + 3][j]); o.z = pk2(v[8 * h + 4][j], v[8 * h + 5][j]); o.w = pk2(v[8 * h + 6][j], v[8 * h + 7][j]);
                *(u32x4*)(drow + 8 * h) = o; } }
    } else {
        float s0[16], s1[16];
#pragma unroll
        for (int i = 0; i < 16; ++i) { const int k = k0 + 16 * kr + i; s0[i] = tab[k]; s1[i] = tab[1024 + k]; a0 += v[i] * tab[2048 + k]; a1 += v[i] * tab[3072 + k]; }
#pragma unroll
        for (int j = 0; j < 4; ++j) { bf16* d0 = WT0 + (size_t)(dst_row0 + 4 * n4 + j) * K + k0 + 16 * kr; bf16* d1 = WT1 + (size_t)(dst_row0 + 4 * n4 + j) * K + k0 + 16 * kr;
#pragma unroll
            for (int h = 0; h < 2; ++h) { u32x4 o;
                o.x = pk2(v[8 * h][j] * s0[8 * h], v[8 * h + 1][j] * s0[8 * h + 1]); o.y = pk2(v[8 * h + 2][j] * s0[8 * h + 2], v[8 * h + 3][j] * s0[8 * h + 3]);
                o.z = pk2(v[8 * h + 4][j] * s0[8 * h + 4], v[8 * h + 5][j] * s0[8 * h + 5]); o.w = pk2(v[8 * h + 6][j] * s0[8 * h + 6], v[8 * h + 7][j] * s0[8 * h + 7]);
                *(u32x4*)(d0 + 8 * h) = o;
                o.x = pk2(v[8 * h][j] * s1[8 * h], v[8 * h + 1][j] * s1[8 * h + 1]); o.y = pk2(v[8 * h + 2][j] * s1[8 * h + 2], v[8 * h + 3][j] * s1[8 * h + 3]);
                o.z = pk2(v[8 * h + 4][j] * s1[8 * h + 4], v[8 * h + 5][j] * s1[8 * h + 5]); o.w = pk2(v[8 * h + 6][j] * s1[8 * h + 6], v[8 * h + 7][j] * s1[8 * h + 7]);
                *(u32x4*)(d1 + 8 * h) = o; } }
    }
}
__device__ __forceinline__ int map_qkvg(int np) {
    if (np < 2048) { const int qk = np >> 10, h = (np >> 8) & 3, cp = np & 255; const int d = 128 * ((cp >> 6) & 1) + 64 * (cp >> 7) + (cp & 63); return qk * 1024 + h * 256 + d; }
    if (np < 4096) return 4096 + (np - 2048);
    return 2048 + (np - 4096);
}
__device__ __forceinline__ int map_wci(int np) { const int tile = np >> 8, cp = np & 255; if (tile < 8) return (cp < 128) ? (1024 + 128 * tile + cp) : (2048 + 128 * tile + cp - 128); return 256 * (tile - 8) + cp; }
__device__ __forceinline__ void unpack8(const u32x4 w, float (&f)[8]) { f[0] = bflo(w.x); f[1] = bfhi(w.x); f[2] = bflo(w.y); f[3] = bfhi(w.y); f[4] = bflo(w.z); f[5] = bfhi(w.z); f[6] = bflo(w.w); f[7] = bfhi(w.w); }

template <int RB>
__device__ __forceinline__ void modrows(const float* xrow0, const float* gain, const float* scale, bf16* orow0, float* rstd0, int lane) {
    f32x4 v[RB][4]; float ss[RB];
#pragma unroll
    for (int r = 0; r < RB; ++r)
#pragma unroll
        for (int j = 0; j < 4; ++j) v[r][j] = ((const f32x4*)(xrow0 + (size_t)r * D) + lane)[64 * j];
    f32x4 w[4];
#pragma unroll
    for (int j = 0; j < 4; ++j) w[j] = ((const f32x4*)gain + lane)[64 * j] * (((const f32x4*)scale + lane)[64 * j] + 1.0f);
#pragma unroll
    for (int r = 0; r < RB; ++r) { float s_ = 0.f;
#pragma unroll
        for (int j = 0; j < 4; ++j) s_ += (v[r][j][0] * v[r][j][0] + v[r][j][1] * v[r][j][1]) + (v[r][j][2] * v[r][j][2] + v[r][j][3] * v[r][j][3]);
        ss[r] = wave_sum(s_); }
#pragma unroll
    for (int r = 0; r < RB; ++r) { if (lane == 0) rstd0[r] = 1.0f / sqrtf(ss[r] * (1.0f / D) + EPS);
        unsigned long long* o8 = (unsigned long long*)(orow0 + (size_t)r * D) + lane;
#pragma unroll
        for (int j = 0; j < 4; ++j) { const f32x4 o = v[r][j] * w[j]; o8[64 * j] = (unsigned long long)pk2(o[0], o[1]) | ((unsigned long long)pk2(o[2], o[3]) << 32); } }
}
template <int RB>
__device__ __forceinline__ void biasrows(const bf16* wrow0, const float* sh, int q_lo, int q_hi, float* out0, int lane) {
    u32x4 wv[RB][2];
#pragma unroll
    for (int r = 0; r < RB; ++r)
#pragma unroll
        for (int j = 0; j < 2; ++j) wv[r][j] = *(const u32x4*)(wrow0 + (size_t)r * D + j * 512 + lane * 8);
#pragma unroll
    for (int q = 0; q < 3; ++q) if (q >= q_lo && q < q_hi) {
        float a[RB];
#pragma unroll
        for (int r = 0; r < RB; ++r) a[r] = 0.f;
#pragma unroll
        for (int j = 0; j < 2; ++j) { const float* s_ = sh + q * NQ + j * 512 + lane * 8; const f32x4 s0 = *(const f32x4*)s_, s1 = *(const f32x4*)(s_ + 4);
#pragma unroll
            for (int r = 0; r < RB; ++r) { float wf[8]; unpack8(wv[r][j], wf);
                a[r] += (wf[0] * s0[0] + wf[1] * s0[1]) + (wf[2] * s0[2] + wf[3] * s0[3]) + (wf[4] * s1[0] + wf[5] * s1[1]) + (wf[6] * s1[2] + wf[7] * s1[3]); } }
#pragma unroll
        for (int r = 0; r < RB; ++r) { const float t = wave_sum(a[r]); if (lane == 0) out0[q * NQ + r] = t; }
    }
}

#define BUILD_TABS(S_, RS_, BS_) do { LAS float* rt_ = (LAS float*)(lds + RSTD_LDS); LAS float* bt_ = (LAS float*)(lds + BIAS_LDS); const int t_ = tid & 255, i0_ = tid >> 8; \
        pg8::Unit uu_[4]; bool ok_[4]; float rv_[4], bv_[4]; \
        _Pragma("unroll") for (int k_ = 0; k_ < 4; ++k_) { ok_[k_] = S_.next(i0_ + 2 * k_, uu_[k_]); if (!ok_[k_]) uu_[k_] = uu_[0]; } \
        _Pragma("unroll") for (int k_ = 0; k_ < 4; ++k_) { rv_[k_] = RS_(uu_[k_].pm * 256 + t_); bv_[k_] = BS_(uu_[k_], t_); } \
        _Pragma("unroll") for (int k_ = 0; k_ < 4; ++k_) if (ok_[k_]) { rt_[(i0_ + 2 * k_) * 256 + t_] = rv_[k_]; bt_[(i0_ + 2 * k_) * 256 + t_] = bv_[k_]; } \
        __syncthreads(); } while (0)
__device__ __forceinline__ float bias_sum(const float* slab, int ncol, int col) { float t = slab[col];
#pragma unroll
    for (int q = 1; q < NKQ; ++q) t += slab[q * ncol + col];
    return t; }
#define RS_SSQ(r) rstd_from_ssq(SSQ, (r))
#define RS_X(r) RSTDX[(r)]

#define WPREP_JOBS(job_lo, job_hi, gwq, ngwq) do { LAS float* tab = (LAS float*)lds; \
                for (int job = (job_lo); job < (job_hi); ++job) { \
                    const int jl = (job == 0) ? 0 : 1; const bool isci = (job == 1); \
                    const float* gain_ = (isci ? args.in[IN_NMIX] : args.in[IN_NFFN]) + jl * D; const float* ad = ADA + jl * 3 * NQ + (isci ? 0 : 3 * D); \
                    __syncthreads(); \
                    { float g_[4], s_[4], h_[4]; \
                      _Pragma("unroll") for (int j = 0; j < 4; ++j) { const int i = tid + j * NTHR, b_ = i >> 10, k = i & (D - 1); g_[j] = gain_[k]; s_[j] = ad[b_ * NQ + D + k]; h_[j] = ad[b_ * NQ + k]; } \
                      _Pragma("unroll") for (int j = 0; j < 4; ++j) { const int i = tid + j * NTHR; tab[i] = g_[j] * (1.0f + s_[j]); tab[2 * D + i] = h_[j]; } } \
                    __syncthreads(); \
                    const int nnb = isci ? 48 : 88, ncol = isci ? 3072 : 5632; \
                    float* bslab = isci ? BIAS5 : BIAS3 + jl * 2 * NKQ * 5632; \
                    for (int it = (gwq); it < nnb * NKQ; it += (ngwq)) { const int nb = it / NKQ, kq = it % NKQ, np = nb * 64; f32x4 a0 = {0.f, 0.f, 0.f, 0.f}, a1 = a0; \
                        _Pragma("unroll") for (int kb = kq * (16 / NKQ); kb < (kq + 1) * (16 / NKQ); ++kb) { \
                            if (isci) tr64<true>(args.in[IN_WCI], 3072, D, WCI, WCI + (size_t)3072 * D, kb * 64, map_wci(np), np, tab, a0, a1, lane); \
                            else { const int tile = np >> 8, cp = np & 255; const float* src = (cp < 128 ? args.in[IN_W1] : args.in[IN_W3]) + (size_t)jl * D * FF; \
                                tr64<true>(src, FF, D, W13[jl], W13[jl] + (size_t)5632 * D, kb * 64, 128 * tile + (cp & 127), np, tab, a0, a1, lane); } } \
                        _Pragma("unroll") for (int e = 0; e < 4; ++e) { a0[e] += __shfl_xor(a0[e], 16); a0[e] += __shfl_xor(a0[e], 32); a1[e] += __shfl_xor(a1[e], 16); a1[e] += __shfl_xor(a1[e], 32); } \
                        if (lane < 16) { *(f32x4*)(bslab + (0 * NKQ + kq) * ncol + np + 4 * lane) = a0; *(f32x4*)(bslab + (1 * NKQ + kq) * ncol + np + 4 * lane) = a1; } \
                    } } \
                __syncthreads(); } while (0)

__global__ void __launch_bounds__(NTHR, 2) fwd_kernel(Args args) {
    extern __shared__ __attribute__((aligned(16))) unsigned char lds_raw[];
    LAS unsigned char* lds = (LAS unsigned char*)lds_raw;
    volatile LAS unsigned* MISC = (volatile LAS unsigned*)(lds + MISC_OFF);
    const int tid0 = threadIdx.x, wave = __builtin_amdgcn_readfirstlane(tid0 >> 6);
    const int G = gridDim.x, bx = blockIdx.x;
    const int vcu = (G % 8 == 0) ? (bx % 8) * (G / 8) + bx / 8 : bx;
    const int gw = vcu * NWAVES + wave, NGW = G * NWAVES;
    unsigned char* ws = args.ws;
    unsigned* ctl = (unsigned*)(ws + WS_CTL);
    float* ADA = (float*)(ws + CTL_ADA);
    float* ROPE = (float*)(ws + MS_ROPE); float* RSTDX = (float*)(ws + MS_RSTDX); float* RSTDC = (float*)(ws + MS_RSTDC);
    float* BIAS1 = (float*)(ws + MS_BIAS1); float* BIAS3 = (float*)(ws + MS_BIAS3); float* BIAS5 = (float*)(ws + MS_BIAS5);
    float* SSQ = (float*)(ws + WS_SSQ);
    bf16* WQKVG = (bf16*)(ws + WS_WQKVG); bf16* WO = (bf16*)(ws + WS_WO); bf16* WCI = (bf16*)(ws + WS_WCI); bf16* WCO = (bf16*)(ws + WS_WCO);
    bf16* W13[2] = {(bf16*)(ws + WS_W13_0), (bf16*)(ws + WS_W13_1)};
    bf16* XB = (bf16*)(ws + WS_XB); bf16* QB = (bf16*)(ws + WS_Q); bf16* KB = (bf16*)(ws + WS_K); bf16* VT = (bf16*)(ws + WS_VT);
    bf16* SFB = (bf16*)(ws + WS_SF); bf16* SBB = (bf16*)(ws + WS_SB); bf16* KC = (bf16*)(ws + WS_KC); bf16* VCT = (bf16*)(ws + WS_VCT); bf16* ACB = (bf16*)(ws + WS_ACB);
    bf16* HID = (bf16*)(ws + WS_HID); bf16* CU = (bf16*)(ws + WS_CU); bf16* CB = (bf16*)(ws + WS_CB); bf16* ACV = (bf16*)(ws + WS_ACV);
    bf16* GB = (bf16*)args.out;
    const float* x = args.in[IN_X];

    for (int u = tid0; u < (LDS_BYTES - 131072) / 4; u += NTHR) ((LAS unsigned*)(lds + 131072))[u] = 0u;
    __syncthreads();
    const bool multi = (args.ph_hi - args.ph_lo) > 1;
    XcdBarrier bar; bar.bar = ctl + CW_BAR; bar.x = 0; bar.st = nullptr;
    if (multi) bar = xcd_barrier_post(ctl + CW_BAR, MISC + 8);

#ifndef PROBE_DUP
#define PROBE_DUP -1
#endif
#ifndef SSVAR
#define SSVAR 0
#endif
    for (int ph0 = args.ph_lo; ph0 < args.ph_hi; ) {
        const int sq_ = ph0++; const int ph = (sq_ < 4) ? sq_ : (sq_ == 4 ? 13 : sq_ - 1); constexpr int rep = 0;
        const int tid = opaque((int)threadIdx.x), lane = tid & 63;
        switch (ph) {
        case 0: if (PHMASK & (1<<0)) {
            { LAS float* sl = (LAS float*)(lds + 131072); LAS f32x4* red = (LAS f32x4*)lds;
              { float cv[6];
#pragma unroll
                for (int j = 0; j < 6; ++j) { const int i = tid + j * NTHR, r = i >> 10, k = i & (D - 1); cv[j] = (r < 2) ? args.in[IN_C][r * D + k] : args.in[IN_CCTX][k]; }
#pragma unroll
                for (int j = 0; j < 6; ++j) sl[tid + j * NTHR] = siluf(cv[j]); }
              __syncthreads();
              for (int it = bx; it < 256; it += G) {
                  const int l = it >> 7, c0 = (it & 127) * 48, cg = tid % 12, kg = tid / 12;
                  if (tid < 504) {
                      const float* W = args.in[IN_ADAW] + (size_t)l * D * NQ + c0 + 4 * cg;
                      f32x4 a0 = {0.f, 0.f, 0.f, 0.f}, a1 = a0, a2 = a0;
#pragma unroll
                      for (int jb = 0; jb < 25; jb += 13) { f32x4 w[13];
#pragma unroll
                          for (int j = 0; j < 13; ++j) if (jb + j < 25) { const int k = kg + 42 * (jb + j); w[j] = *(const f32x4*)(W + (size_t)(k < D ? k : kg) * NQ); }
#pragma unroll
                          for (int j = 0; j < 13; ++j) if (jb + j < 25) { const int k = kg + 42 * (jb + j); if (k < D) { a0 += w[j] * sl[k]; a1 += w[j] * sl[D + k]; a2 += w[j] * sl[2 * D + k]; } } }
                      red[(kg * 12 + cg) * 3 + 0] = a0; red[(kg * 12 + cg) * 3 + 1] = a1; red[(kg * 12 + cg) * 3 + 2] = a2;
                  }
                  __syncthreads();
                  if (tid < 36) { const int cg2 = tid / 3, r = tid % 3; f32x4 t = *(const f32x4*)(args.in[IN_ADAB] + l * NQ + c0 + 4 * cg2);
                      for (int q = 0; q < 42; ++q) t += red[(q * 12 + cg2) * 3 + r];
                      *(f32x4*)(ADA + (l * 3 + r) * NQ + c0 + 4 * cg2) = t; }
                  __syncthreads();
              }
            }
            { constexpr int I_QKVG = 16 * 96, I_WO = 32 * 16, I_W2 = 44 * 16, I_WCO = 16 * 16;
              constexpr int NIT = I_QKVG + I_WO + 2 * I_W2 + I_WCO;
              f32x4 d0, d1;
              for (int it = gw; it < NIT; it += NGW) {
                  int r = it;
                  if (r < I_QKVG) { const int kb = r / 96, nb = r % 96; tr64<false>(args.in[IN_WQKVG], NQ, D, WQKVG, nullptr, kb * 64, map_qkvg(nb * 64), nb * 64, nullptr, d0, d1, lane); continue; } r -= I_QKVG;
                  if (r < I_WO) { const int kb = r / 16, nb = r % 16; tr64<false>(args.in[IN_WO], D, 2048, WO, nullptr, kb * 64, nb * 64, nb * 64, nullptr, d0, d1, lane); continue; } r -= I_WO;
                  if (r < 2 * I_W2) { const int l = r / I_W2; r %= I_W2; const int kb = r / 16, nb = r % 16;
                      tr64<false>(args.in[IN_W2] + (size_t)l * FF * D, D, FF, (bf16*)(ws + (l ? WS_W2_1 : WS_W2_0)), nullptr, kb * 64, nb * 64, nb * 64, nullptr, d0, d1, lane); continue; } r -= 2 * I_W2;
                  { const int kb = r / 16, nb = r % 16; tr64<false>(args.in[IN_WCO], D, D, WCO, nullptr, kb * 64, nb * 64, nb * 64, nullptr, d0, d1, lane); }
              }
            }
        } break;
        case 1: if (PHMASK & (1<<1)) {
            const float* gain = args.in[IN_NMIX];
            const bool hasctx = vcu < 192;
            const bool isv = vcu >= 64; const int tl = isv ? vcu - 64 : vcu, rb = tl & 7, cbk = tl >> 3, row0 = 64 * rb, col0 = 128 * cbk;
            const int wt0 = (isv ? 4096 : 1024) + col0;
            if (hasctx) {
                LAS float* wt_ = (LAS float*)lds; LAS float* sh_ = wt_ + D; LAS float* rs_ = (LAS float*)(lds + 8192); LAS float* bs_ = rs_ + 64;
                LAS unsigned char* abuf = lds + 16384; LAS unsigned char* bbuf = lds + 16384 + 2 * 9216;
                { float g_[2], s_[2], h_[2];
#pragma unroll
                  for (int j = 0; j < 2; ++j) { const int k = tid + j * NTHR; g_[j] = gain[k]; s_[j] = ADA[2 * NQ + D + k]; h_[j] = ADA[2 * NQ + k]; }
#pragma unroll
                  for (int j = 0; j < 2; ++j) { const int k = tid + j * NTHR; wt_[k] = g_[j] * (1.0f + s_[j]); sh_[k] = h_[j]; } }
                __syncthreads();
                const int arow = tid >> 3, aseg = tid & 7, brow = tid >> 2, bseg = tid & 3;
                const float* ap = args.in[IN_CTX] + (size_t)(row0 + arow) * D + 8 * aseg; const bf16* bp = WQKVG + (size_t)(wt0 + brow) * D + 16 * bseg;
                const int w4 = wave & 3, wr2 = wave >> 2, fr = lane & 15, fq = lane >> 4;
                const unsigned awr = (unsigned)(arow * 144 + aseg * 16), bwr = (unsigned)(brow * 144 + bseg * 32);
                const unsigned ard = (unsigned)((32 * wr2 + fr) * 144 + fq * 16), brd = (unsigned)((32 * w4 + fr) * 144 + fq * 16);
                f32x4 a_r[2][2]; u32x4 b_r[2][2]; float ssq = 0.f, bsum = 0.f;
                f32x4 acc[2][2];
#pragma unroll
                for (int m = 0; m < 2; ++m)
#pragma unroll
                    for (int n = 0; n < 2; ++n) acc[m][n] = (f32x4){0.f, 0.f, 0.f, 0.f};
#pragma unroll
                for (int c = 0; c < 2; ++c) { a_r[c][0] = *(const f32x4*)(ap + 64 * c); a_r[c][1] = *(const f32x4*)(ap + 64 * c + 4); b_r[c][0] = *(const u32x4*)(bp + 64 * c); b_r[c][1] = *(const u32x4*)(bp + 64 * c + 8); }
#pragma unroll 1
                for (int c2 = 0; c2 < 16; c2 += 2)
#pragma unroll
                for (int cur = 0; cur < 2; ++cur) { const int c = c2 + cur;
                    { const int k0 = 64 * c + 8 * aseg; const f32x4 w0 = *(const LAS f32x4*)(wt_ + k0), w1 = *(const LAS f32x4*)(wt_ + k0 + 4); const f32x4 x0 = a_r[cur][0], x1 = a_r[cur][1];
                      ssq += (x0[0] * x0[0] + x0[1] * x0[1]) + (x0[2] * x0[2] + x0[3] * x0[3]) + (x1[0] * x1[0] + x1[1] * x1[1]) + (x1[2] * x1[2] + x1[3] * x1[3]);
                      *(LAS u32x4*)(abuf + cur * 9216 + awr) = pack8(x0 * w0, x1 * w1); }
                    { const int kb = 64 * c + 16 * bseg;
#pragma unroll
                      for (int h = 0; h < 2; ++h) { float f[8]; unpack8(b_r[cur][h], f); const f32x4 s0 = *(const LAS f32x4*)(sh_ + kb + 8 * h), s1 = *(const LAS f32x4*)(sh_ + kb + 8 * h + 4);
                          bsum += (f[0] * s0[0] + f[1] * s0[1]) + (f[2] * s0[2] + f[3] * s0[3]) + (f[4] * s1[0] + f[5] * s1[1]) + (f[6] * s1[2] + f[7] * s1[3]);
                          *(LAS u32x4*)(bbuf + cur * 18432 + bwr + 16 * h) = b_r[cur][h]; } }
                    { const int cn = (c + 2 < 16) ? c + 2 : 15;
                      a_r[cur][0] = *(const f32x4*)(ap + 64 * cn); a_r[cur][1] = *(const f32x4*)(ap + 64 * cn + 4); b_r[cur][0] = *(const u32x4*)(bp + 64 * cn); b_r[cur][1] = *(const u32x4*)(bp + 64 * cn + 8); }
                    __syncthreads();
#pragma unroll
                    for (int ks = 0; ks < 2; ++ks) { bf16x8 af[2], bfg[2];
#pragma unroll
                        for (int m = 0; m < 2; ++m) af[m] = *(const LAS bf16x8*)(abuf + cur * 9216 + ard + m * (16 * 144) + ks * 64);
#pragma unroll
                        for (int n = 0; n < 2; ++n) bfg[n] = *(const LAS bf16x8*)(bbuf + cur * 18432 + brd + n * (16 * 144) + ks * 64);
#pragma unroll
                        for (int m = 0; m < 2; ++m)
#pragma unroll
                            for (int n = 0; n < 2; ++n) acc[m][n] = isv ? __builtin_amdgcn_mfma_f32_16x16x32_bf16(af[m], bfg[n], acc[m][n], 0, 0, 0) : __builtin_amdgcn_mfma_f32_16x16x32_bf16(bfg[n], af[m], acc[m][n], 0, 0, 0); }
                }
                { float t = ssq; t += __shfl_xor(t, 1); t += __shfl_xor(t, 2); t += __shfl_xor(t, 4); if (aseg == 0) rs_[arow] = 1.0f / sqrtf(t * (1.0f / D) + EPS);
                  float u_ = bsum; u_ += __shfl_xor(u_, 1); u_ += __shfl_xor(u_, 2); if (bseg == 0) bs_[brow] = u_; }
                __syncthreads();
                const int b = rb >> 2;
                if (!isv) {
#pragma unroll
                    for (int m = 0; m < 2; ++m) { const int rl = 32 * wr2 + 16 * m + fr; const float rsd = rs_[rl];
#pragma unroll
                        for (int n = 0; n < 2; ++n) { const int cl = 32 * w4 + 16 * n + 4 * fq; const f32x4 bb = *(const LAS f32x4*)(bs_ + cl);
                            const f32x4 o = (acc[m][n] * rsd + bb) * 0.0625f;
                            u32x2 w; w.x = pk2(o[0], o[1]); w.y = pk2(o[2], o[3]); *(u32x2*)(KC + (size_t)(row0 + rl) * D + col0 + cl) = w; } }
                } else {
#pragma unroll
                    for (int m = 0; m < 2; ++m) { const int tl0 = 32 * wr2 + 16 * m + 4 * fq; const f32x4 rs = *(const LAS f32x4*)(rs_ + tl0);
#pragma unroll
                        for (int n = 0; n < 2; ++n) { const int cl = 32 * w4 + 16 * n + fr, c = col0 + cl, h = c >> 9, e = c & 511; const f32x4 o = acc[m][n] * rs + bs_[cl];
                            u32x2 w; w.x = pk2(o[0], o[1]); w.y = pk2(o[2], o[3]); *(u32x2*)(VCT + (size_t)((b * NH + h) * DV + e) * CTXL + ((row0 + tl0) & (CTXL - 1))) = w; } }
                }
                biasrows<4>(WQKVG + (size_t)(4 * (vcu * 8 + wave)) * D, ADA, 0, 2, BIAS1 + 4 * (vcu * 8 + wave), lane);
            } else {
                const int wk = (vcu - 192) * 8 + wave, NWK = (G - 192) * 8;
                for (int r = 4 * wk; r < P1_R1; r += 4 * NWK) modrows<4>(x + (size_t)r * D, gain, ADA + (r >> 13) * NQ + D, XB + (size_t)r * D, RSTDX + r, lane);
            }
            { const int r = P1_R1 + 4 * (vcu * 8 + wave); modrows<4>(x + (size_t)r * D, gain, ADA + (r >> 13) * NQ + D, XB + (size_t)r * D, RSTDX + r, lane); }
            if constexpr (P1_RW > 4) { const int r = P1_R1 + 8192 + (P1_RW - 4) * (vcu * 8 + wave); modrows<P1_RW - 4>(x + (size_t)r * D, gain, ADA + (r >> 13) * NQ + D, XB + (size_t)r * D, RSTDX + r, lane); }
        } break;
        case 2: if (PHMASK & (1<<2)) {
            if (G1SEL & 1) { pg8::Gemm g{XB, WQKVG, M, 4096, D, 0}; pg8::StaticOrder S; S.init(M, 4096, G, bx);
              EpiQKG E{QB, KB, GB, RSTDX, BIAS1};
              pg8::gemm_phase<EpiQKG, pg8::StaticOrder, true, true, false>(lds, g, S, E, tid); }
            { pg8::Gemm g{XB, WQKVG + (size_t)4096 * D, M, 2048, D, 0}; pg8::StaticOrder S; S.init(M, 2048, G, bx);
              EpiVT E{VT, RSTDX, BIAS1 + 4096, SEQ, 32, -1};
              pg8::gemm_phase<EpiVT, pg8::StaticOrder, true, true, true>(lds, g, S, E, tid); }
        } break;
        case 3: if (PHMASK & (1<<3)) {
            constexpr int KP = 136, BUFB = (64 + 64 + 128) * KP * 2, NST = 34;
            static_assert(2 * BUFB <= MISC_OFF, "SS LDS map");
            for (int u = bx; u < 256; u += G) {
                const int grp = u & 1, bh = (u >> 1) & 7, dkt = (u >> 4) & 3, dvt = u >> 6, b = bh >> 2, h = bh & 3, dk0 = 64 * dkt, dv0 = 128 * dvt;
                const float lgf = __builtin_bit_cast(float, __builtin_amdgcn_readfirstlane(__builtin_bit_cast(int, __builtin_amdgcn_logf(1.0f - __builtin_amdgcn_exp2f(-5.0f - (float)h)))));
                const float lgb = __builtin_bit_cast(float, __builtin_amdgcn_readfirstlane(__builtin_bit_cast(int, __builtin_amdgcn_logf(1.0f - __builtin_amdgcn_exp2f(-5.5f - (float)h)))));
                __syncthreads();
#define SS_DEC(s_) const bool ic_ = (s_) < 2; const int c_ = grp ? (ic_ ? 1 - (s_) : 65 - (s_)) : (ic_ ? (s_) : (s_) - 2); const int q_ = ic_ ? c_ : (c_ & 3), nq_ = ic_ ? 2 : 4
                if (wave >= 4) {
                    const int pt = tid - 256;
                    float wKf[4], wKb[4];
#pragma unroll
                    for (int p = 0; p < 4; ++p) { const int t = 4 * (pt >> 3) + p; wKf[p] = __builtin_amdgcn_exp2f((float)(127 - t) * lgf); wKb[p] = __builtin_amdgcn_exp2f((float)t * lgb); }
                    u32x4 kr0[4], vr0[8], kr1[4], vr1[8], kr2[4], vr2[8];
#define SSP_LOAD(step, kr, vr) do { const int s_ = (step); SS_DEC(s_); (void)q_; (void)nq_; const int t_ = opaque(pt); \
                        const bf16* ks_ = (ic_ ? KC + (size_t)(b * CTXL + c_ * 128) * D : KB + (size_t)(b * SEQ + c_ * 128) * D) + h * DK + dk0; \
                        const int ld_ = ic_ ? CTXL : 128; const bf16* vs_ = ic_ ? VCT + (size_t)(bh * DV + dv0) * CTXL + c_ * 128 : VT + ((size_t)((bh * 64 + c_) * DV + dv0)) * 128; \
                        _Pragma("unroll") for (int p = 0; p < 4; ++p) kr[p] = *(const u32x4*)(ks_ + (unsigned)((4 * (t_ >> 3) + p) * D + 8 * (t_ & 7))); \
                        _Pragma("unroll") for (int q = 0; q < 8; ++q) vr[q] = *(const u32x4*)(vs_ + (unsigned)(((t_ >> 4) + 16 * q) * ld_ + 8 * (t_ & 15))); } while (0)
#define SSP_WRITE(step, kr, vr) do { const int sw_ = (step); SS_DEC(sw_); (void)c_; LAS bf16* kf_ = (LAS bf16*)(lds + (sw_ & 1) * BUFB); LAS bf16* kb_ = kf_ + 64 * KP; LAS bf16* vt_ = kb_ + 64 * KP; const int t_ = opaque(pt); \
                        const float cf_ = __builtin_amdgcn_exp2f((float)(128 * (nq_ - 1 - q_)) * lgf), cb_ = __builtin_amdgcn_exp2f((float)(128 * q_) * lgb); \
                        { float f0_[8], f1_[8], f2_[8], f3_[8]; unpack8(kr[0], f0_); unpack8(kr[1], f1_); unpack8(kr[2], f2_); unpack8(kr[3], f3_); \
                          const int c8_ = t_ & 7, tg_ = t_ >> 3, pos_ = (((tg_ >> 1) ^ c8_) << 3) | (4 * (tg_ & 1)); \
                          const float wf0_ = wKf[0] * cf_, wf1_ = wKf[1] * cf_, wf2_ = wKf[2] * cf_, wf3_ = wKf[3] * cf_, wb0_ = wKb[0] * cb_, wb1_ = wKb[1] * cb_, wb2_ = wKb[2] * cb_, wb3_ = wKb[3] * cb_; \
                          _Pragma("unroll") for (int e = 0; e < 8; ++e) { u32x2 wf_, wb_; wf_.x = pk2(f0_[e] * wf0_, f1_[e] * wf1_); wf_.y = pk2(f2_[e] * wf2_, f3_[e] * wf3_); wb_.x = pk2(f0_[e] * wb0_, f1_[e] * wb1_); wb_.y = pk2(f2_[e] * wb2_, f3_[e] * wb3_); \
                              *(LAS u32x2*)(kf_ + (8 * c8_ + e) * KP + pos_) = wf_; *(LAS u32x2*)(kb_ + (8 * c8_ + e) * KP + pos_) = wb_; } } \
                        _Pragma("unroll") for (int q = 0; q < 8; ++q) *(LAS u32x4*)(vt_ + ((t_ >> 4) + 16 * q) * KP + 8 * (t_ & 15)) = vr[q]; } while (0)
#define SSP_STEP(s, krN, vrN, krF, vrF) do { const int s__ = (s); SSP_LOAD(s__ + 3 <= NST - 1 ? s__ + 3 : NST - 1, krF, vrF); SSP_WRITE(s__ + 1, krN, vrN); __syncthreads(); } while (0)
                    SSP_LOAD(0, kr0, vr0); SSP_LOAD(1, kr1, vr1); SSP_LOAD(2, kr2, vr2); SSP_WRITE(0, kr0, vr0); __syncthreads();
                    static_assert(NST % 3 == 1, "tail step below");
                    for (int s3 = 0; s3 < NST - 1; s3 += 3) { SSP_STEP(s3, kr1, vr1, kr0, vr0); SSP_STEP(s3 + 1, kr2, vr2, kr1, vr1); SSP_STEP(s3 + 2, kr0, vr0, kr2, vr2); }
                    SSP_STEP(NST - 1, kr1, vr1, kr0, vr0);
#undef SSP_LOAD
#undef SSP_WRITE
#undef SSP_STEP
                } else {
                    const int wr = wave >> 1, wc = wave & 1, fr = lane & 15, fq = lane >> 4;
                    f32x4 accf[2][4], accb[2][4];
#pragma unroll
                    for (int i = 0; i < 2; ++i)
#pragma unroll
                        for (int j = 0; j < 4; ++j) { accf[i][j] = (f32x4){0.f, 0.f, 0.f, 0.f}; accb[i][j] = (f32x4){0.f, 0.f, 0.f, 0.f}; }
                    __syncthreads();
                    for (int s = 0; s < NST; ++s) {
                        { const LAS bf16* kf = (const LAS bf16*)(lds + (s & 1) * BUFB); const LAS bf16* kb = kf + 64 * KP; const LAS bf16* vt = kb + 64 * KP;
#pragma unroll
                          for (int ks = 0; ks < 4; ++ks) { bf16x8 XF[2], XB_[2], Y[4];
#pragma unroll
                              for (int i = 0; i < 2; ++i) { const int o_ = (32 * wr + 16 * i + fr) * KP + (((4 * ks + fq) ^ (4 * wr + 2 * i + (fr >> 3))) & 7) * 8 + 64 * (ks >> 1);
                                  XF[i] = *(const LAS bf16x8*)(kf + o_); XB_[i] = *(const LAS bf16x8*)(kb + o_); }
#pragma unroll
                              for (int j = 0; j < 4; ++j) Y[j] = *(const LAS bf16x8*)(vt + (64 * wc + 16 * j + fr) * KP + 32 * ks + 8 * fq);
#pragma unroll
                              for (int i = 0; i < 2; ++i)
#pragma unroll
                                  for (int j = 0; j < 4; ++j) { accf[i][j] = __builtin_amdgcn_mfma_f32_16x16x32_bf16(XF[i], Y[j], accf[i][j], 0, 0, 0); accb[i][j] = __builtin_amdgcn_mfma_f32_16x16x32_bf16(XB_[i], Y[j], accb[i][j], 0, 0, 0); } } }
                        __syncthreads();
                        SS_DEC(s);
                        if (grp ? (q_ == 0) : (q_ == nq_ - 1)) {
                            const int sc = c_ >> 2;
                            const int fslot = grp ? ((!ic_ && sc <= 14) ? sc + 1 : -1) : (ic_ ? 0 : sc + 1), bslot = grp ? (ic_ ? 15 : sc - 1) : ((!ic_ && sc >= 1) ? sc - 1 : -1);
                            const size_t eo = (size_t)(dv0 + 64 * wc + fr) * DK + dk0 + 32 * wr + 4 * fq;
                            if (fslot >= 0) { bf16* dst = SFB + (size_t)(bh * NSC + fslot) * DV * DK + eo;
#pragma unroll
                                for (int i = 0; i < 2; ++i)
#pragma unroll
                                    for (int j = 0; j < 4; ++j) { u32x2 w; w.x = pk2(accf[i][j][0], accf[i][j][1]); w.y = pk2(accf[i][j][2], accf[i][j][3]); *(u32x2*)(dst + (size_t)(16 * j) * DK + 16 * i) = w; } }
                            if (bslot >= 0) { bf16* dst = SBB + (size_t)(bh * NSC + bslot) * DV * DK + eo;
#pragma unroll
                                for (int i = 0; i < 2; ++i)
#pragma unroll
                                    for (int j = 0; j < 4; ++j) { u32x2 w; w.x = pk2(accb[i][j][0], accb[i][j][1]); w.y = pk2(accb[i][j][2], accb[i][j][3]); *(u32x2*)(dst + (size_t)(16 * j) * DK + 16 * i) = w; } }
                            const float mf = grp ? 0.f : __builtin_amdgcn_exp2f(512.0f * lgf), mb = grp ? __builtin_amdgcn_exp2f(512.0f * lgb) : 0.f;
#pragma unroll
                            for (int i = 0; i < 2; ++i)
#pragma unroll
                                for (int j = 0; j < 4; ++j) { accf[i][j] *= mf; accb[i][j] *= mb; }
                        }
                    }
                }
#undef SS_DEC
            }
        } break;
        case 4: if (PHMASK & (1<<4)) {
            constexpr int SLOT = 40960, PBUF = 3 * SLOT, REDB = PBUF + 32768;
            static_assert(REDB + 2048 <= MISC_OFF, "B' LDS map");
            const int wr = wave >> 2, wc = wave & 3;
#define BP_WAITV(n) do { switch (n) { case 0: asm volatile("s_waitcnt vmcnt(0)" ::: "memory"); break; case 4: asm volatile("s_waitcnt vmcnt(4)" ::: "memory"); break; \
                    case 5: asm volatile("s_waitcnt vmcnt(5)" ::: "memory"); break; default: asm volatile("s_waitcnt vmcnt(0)" ::: "memory"); break; } } while (0)
#define BP_GLDS(srcp, dstoff) __builtin_amdgcn_global_load_lds((const unsigned*)(srcp), (LAS unsigned*)(lds + (dstoff)), 16, 0, 0)
            for (int unit = vcu; unit < 512; unit += G) {
                const int bh = unit >> 6, c = unit & 63, b = bh >> 2, h = bh & 3, sc = c >> 2, cq = c & 3;
                const float lgf = __builtin_amdgcn_logf(1.0f - __builtin_amdgcn_exp2f(-5.0f - (float)h)), lgb = __builtin_amdgcn_logf(1.0f - __builtin_amdgcn_exp2f(-5.5f - (float)h));
                const bf16* Qsrc = QB + (size_t)(b * SEQ + c * 128) * D + h * DK;
                const bf16* Ksrc = KB + (size_t)(b * SEQ + sc * SC) * D + h * DK;
                const bf16* SFsrc = SFB + (size_t)((bh * NSC + sc) * DV) * DK; const bf16* SBsrc = SBB + (size_t)((bh * NSC + sc) * DV) * DK;
                const bf16* Vsrc = VT + (size_t)((bh * 64 + sc * 4) * DV) * 128;
                f32x4 acc[4][8], sacc[4][2];
#pragma unroll
                for (int m = 0; m < 4; ++m)
#pragma unroll
                    for (int n = 0; n < 8; ++n) acc[m][n] = (f32x4){0.f, 0.f, 0.f, 0.f};
#define BP_ISSUE(idx) do { const int i_ = (idx); const int so_ = (i_ % 3) * SLOT; const int l_ = opaque(lane); \
                    if (i_ < 16) { const int s_ = i_ & 7; const bf16* bs_ = (i_ < 8 ? SFsrc : SBsrc) + 32 * s_; const int rr_ = l_ >> 2, ch_ = (l_ & 3) ^ ((l_ >> 4) & 3); \
                        BP_GLDS(Qsrc + (unsigned)((16 * wave + rr_) * D + 32 * s_ + 8 * ch_), so_ + wave * 1024); \
                        _Pragma("unroll") for (int q = 0; q < 4; ++q) BP_GLDS(bs_ + (unsigned)((16 * (wave + 8 * q) + rr_) * DK + 8 * ch_), so_ + 8192 + (wave + 8 * q) * 1024); } \
                    else { const int j_ = (i_ - 16) >> 3, r8_ = (i_ - 16) & 7; \
                        if (r8_ < 4) { const int rr_ = l_ >> 3, ch_ = (l_ & 7) ^ ((l_ >> 4) & 3) ^ (4 * (wave & 1)); \
                            _Pragma("unroll") for (int q = 0; q < 2; ++q) { const int row_ = 8 * (wave + 8 * q) + rr_; \
                                BP_GLDS(Qsrc + (unsigned)(row_ * D + 64 * r8_ + 8 * ch_), so_ + (wave + 8 * q) * 1024); \
                                BP_GLDS(Ksrc + (unsigned)((128 * j_ + row_) * D + 64 * r8_ + 8 * ch_), so_ + 16384 + (wave + 8 * q) * 1024); } } \
                        else { const int rr_ = l_ >> 2, ch_ = (l_ & 3) ^ ((l_ >> 4) & 3); const bf16* bs_ = Vsrc + (size_t)j_ * (DV * 128) + 32 * (r8_ - 4); \
                            _Pragma("unroll") for (int q = 0; q < 4; ++q) BP_GLDS(bs_ + (unsigned)((16 * (wave + 8 * q) + rr_) * 128 + 8 * ch_), so_ + 8192 + (wave + 8 * q) * 1024); } } } while (0)
#define BP_NLOADS(idx) (((idx) >= 48) ? 0 : ((idx) < 16 ? 5 : 4))
#define BP_TOP(idx) do { BP_WAITV(BP_NLOADS((idx) + 1)); asm volatile("s_waitcnt lgkmcnt(0)" ::: "memory"); __builtin_amdgcn_s_barrier(); asm volatile("" ::: "memory"); \
                    if ((idx) + 2 < 48) BP_ISSUE((idx) + 2); } while (0)
#define BP_MMA_FULL(AADDR, so) do { bf16x8 af_[4]; const int l_ = opaque(lane), fr = l_ & 15, fq = l_ >> 4; \
                    _Pragma("unroll") for (int m = 0; m < 4; ++m) af_[m] = *(const LAS bf16x8*)(lds + AADDR(64 * wr + 16 * m + fr, fr, fq)); \
                    _Pragma("unroll") for (int nh = 0; nh < 4; ++nh) { bf16x8 bf_[2]; \
                        _Pragma("unroll") for (int n = 0; n < 2; ++n) bf_[n] = *(const LAS bf16x8*)(lds + (so) + 8192 + (128 * wc + 32 * nh + 16 * n + fr) * 64 + ((fq ^ (fr >> 2)) & 3) * 16); \
                        _Pragma("unroll") for (int m = 0; m < 4; ++m) _Pragma("unroll") for (int n = 0; n < 2; ++n) \
                            acc[m][2 * nh + n] = __builtin_amdgcn_mfma_f32_16x16x32_bf16(bf_[n], af_[m], acc[m][2 * nh + n], 0, 0, 0); } } while (0)
                __builtin_amdgcn_s_barrier();
                BP_ISSUE(0); BP_ISSUE(1);
                for (int idx = 0; idx < 16; ++idx) {
                    BP_TOP(idx);
                    const int so = (idx % 3) * SLOT;
#define AADDR_X(row, fr, fq) (so + (row) * 64 + (((fq) ^ ((fr) >> 2)) & 3) * 16)
                    BP_MMA_FULL(AADDR_X, so);
#undef AADDR_X
                    if (idx == 7 || idx == 15) { const int fr = opaque(lane) & 15;
#pragma unroll
                        for (int m = 0; m < 4; ++m) { const int il = 128 * cq + 64 * wr + 16 * m + fr;
                            const float sc_ = (idx == 7) ? __builtin_amdgcn_exp2f((float)(il + 1) * lgf - (float)(SC - il) * lgb) : __builtin_amdgcn_exp2f((float)(SC - il) * lgb);
#pragma unroll
                            for (int n = 0; n < 8; ++n) acc[m][n] *= sc_; }
                    }
                }
                for (int j = 0; j < 4; ++j) {
#pragma unroll
                    for (int m = 0; m < 4; ++m) { sacc[m][0] = (f32x4){0.f, 0.f, 0.f, 0.f}; sacc[m][1] = (f32x4){0.f, 0.f, 0.f, 0.f}; }
                    for (int r = 0; r < 4; ++r) {
                        const int idx = 16 + 8 * j + r;
                        BP_TOP(idx);
                        const int so = (idx % 3) * SLOT;
                        { const int l_ = opaque(lane), fr = l_ & 15, fq = l_ >> 4;
#pragma unroll
                          for (int ks = 0; ks < 2; ++ks) { bf16x8 af_[4], kf_[2]; const int cx = ((4 * ks + fq) ^ (fr >> 1)) & 7;
#pragma unroll
                              for (int m = 0; m < 4; ++m) af_[m] = *(const LAS bf16x8*)(lds + so + (64 * wr + 16 * m + fr) * 128 + cx * 16);
#pragma unroll
                              for (int n = 0; n < 2; ++n) kf_[n] = *(const LAS bf16x8*)(lds + so + 16384 + (32 * wc + 16 * n + fr) * 128 + cx * 16);
#pragma unroll
                              for (int m = 0; m < 4; ++m)
#pragma unroll
                                  for (int n = 0; n < 2; ++n) sacc[m][n] = __builtin_amdgcn_mfma_f32_16x16x32_bf16(kf_[n], af_[m], sacc[m][n], 0, 0, 0); } }
                        if (r == 3) {
                            const int l_ = opaque(lane), fr = l_ & 15, fq = l_ >> 4;
#pragma unroll
                            for (int m = 0; m < 4; ++m)
#pragma unroll
                                for (int n = 0; n < 2; ++n) { const int il = 128 * cq + 64 * wr + 16 * m + fr, jl0 = 128 * j + 32 * wc + 16 * n + 4 * fq; float pv[4];
#pragma unroll
                                    for (int e = 0; e < 4; ++e) { const int dl = il - (jl0 + e);
                                        const float dec = dl > 0 ? __builtin_amdgcn_exp2f((float)dl * lgf) : (dl < 0 ? __builtin_amdgcn_exp2f((float)(-dl) * lgb) : 2.0f); pv[e] = sacc[m][n][e] * dec; }
                                    u32x2 w; w.x = pk2(pv[0], pv[1]); w.y = pk2(pv[2], pv[3]);
                                    *(LAS u32x2*)(lds + PBUF + (64 * wr + 16 * m + fr) * 256 + (((4 * wc + 2 * n + (fq >> 1)) ^ fr) & 15) * 16 + (fq & 1) * 8) = w; }
                        }
                    }
                    for (int r = 0; r < 4; ++r) {
                        const int idx = 16 + 8 * j + 4 + r;
                        BP_TOP(idx);
                        const int so = (idx % 3) * SLOT;
#define AADDR_P(row, fr, fq) (PBUF + (row) * 256 + (((4 * r + (fq)) ^ (fr)) & 15) * 16)
                        BP_MMA_FULL(AADDR_P, so);
#undef AADDR_P
                    }
                }
                asm volatile("s_waitcnt vmcnt(0) lgkmcnt(0)" ::: "memory"); __builtin_amdgcn_s_barrier(); asm volatile("" ::: "memory");
                { LAS float* red = (LAS float*)(lds + REDB); const int l_ = opaque(lane), fr = l_ & 15, fq = l_ >> 4;
#pragma unroll
                  for (int m = 0; m < 4; ++m) { float ss = 0.f;
#pragma unroll
                      for (int n = 0; n < 8; ++n) ss += (acc[m][n][0] * acc[m][n][0] + acc[m][n][1] * acc[m][n][1]) + (acc[m][n][2] * acc[m][n][2] + acc[m][n][3] * acc[m][n][3]);
                      ss += __shfl_xor(ss, 16); ss += __shfl_xor(ss, 32);
                      if (fq == 0) red[(64 * wr + 16 * m + fr) * 4 + wc] = ss; }
                  __syncthreads();
                  bf16* gp0 = GB + (size_t)(b * SEQ + c * 128 + 64 * wr + fr) * 2048 + h * DV + 128 * wc + 4 * fq;
#pragma unroll
                  for (int mh = 0; mh < 4; mh += 2) {
                      u32x2 gw[2][8];
#pragma unroll
                      for (int q = 0; q < 2; ++q)
#pragma unroll
                          for (int n = 0; n < 8; ++n) gw[q][n] = *(const u32x2*)(gp0 + (size_t)(16 * (mh + q)) * 2048 + 16 * n);
#pragma unroll
                      for (int q = 0; q < 2; ++q) { const int m = mh + q, row = 64 * wr + 16 * m + fr; const f32x4 t4 = *(const LAS f32x4*)(red + row * 4);
                          const float rs = 1.0f / sqrtf(((t4[0] + t4[1]) + (t4[2] + t4[3])) * (1.0f / DV) + EPS);
                          bf16* gp = gp0 + (size_t)(16 * m) * 2048;
#pragma unroll
                          for (int n = 0; n < 8; ++n) {
                              const float o0 = siluf(bflo(gw[q][n].x)) * acc[m][n][0] * rs, o1 = siluf(bfhi(gw[q][n].x)) * acc[m][n][1] * rs, o2 = siluf(bflo(gw[q][n].y)) * acc[m][n][2] * rs, o3 = siluf(bfhi(gw[q][n].y)) * acc[m][n][3] * rs;
                              u32x2 w; w.x = pk2(o0, o1); w.y = pk2(o2, o3); if (!(PROBE_DUP == 4 && rep == 1)) *(u32x2*)(gp + 16 * n) = w; } } }
                  __syncthreads();
                }
            }
#undef BP_WAITV
#undef BP_GLDS
#undef BP_ISSUE
#undef BP_NLOADS
#undef BP_TOP
#undef BP_MMA_FULL
        } break;
        case 5: case 7: case 10: case 12: if (PHMASK & (1<<5)) {
            const int l = (ph >= 10) ? 1 : 0; const float* adal = ADA + l * 3 * NQ;
            if (ph == 5) WPREP_JOBS(0, 1, gw, NGW);
            pg8::StaticOrder S; S.init(M, D, G, bx);
            if (ph == 12) {
                pg8::Gemm g{HID, (const bf16*)(ws + WS_W2_1), M, D, FF, 0};
                EpiResFinal E{XB, args.out, adal + 5 * D, args.in[IN_FN], (float*)(ws + MS_XPART), ctl, lds + RSTD_LDS};
                pg8::gemm_phase<EpiResFinal, pg8::StaticOrder, true, true, false>(lds, g, S, E, tid);
            } else {
                pg8::Gemm g; EpiRes E;
                if (ph == 5) { g = pg8::Gemm{GB, WO, M, D, 2048, 0}; E = EpiRes{x, nullptr, XB, adal + 2 * D, SSQ, 0}; }
                else if (ph == 7) { g = pg8::Gemm{HID, (const bf16*)(ws + WS_W2_0), M, D, FF, 0}; E = EpiRes{nullptr, XB, XB, adal + 5 * D, SSQ, 0}; }
                else { g = pg8::Gemm{ACV, WCO, M, D, D, 0}; E = EpiRes{nullptr, XB, XB, adal + 2 * D, SSQ, 0}; }
                E.dry = (PROBE_DUP == ph && rep == 1) ? 1 : 0;
                pg8::gemm_phase<EpiRes, pg8::StaticOrder, true, true, false>(lds, g, S, E, tid);
            }
        } break;
        case 6: case 11: if (PHMASK & (1<<6)) {
            const int l = (ph == 11) ? 1 : 0;
            pg8::Gemm g{XB, W13[l], M, 5632, D, (size_t)5632 * D * 2}; pg8::StaticOrder S; S.init(M, 5632, G, bx);
#define BS_FFN(u, t) bias_sum(BIAS3 + (l * 2 + ((u).pm >> 5)) * NKQ * 5632, 5632, (u).pn * 256 + (t))
            BUILD_TABS(S, RS_SSQ, BS_FFN);
#undef BS_FFN
            EpiSwiGLU E{HID, (const LAS float*)(lds + RSTD_LDS), (const LAS float*)(lds + BIAS_LDS), (PROBE_DUP == ph && rep == 1 && SSVAR == 21) ? 1 : 0};
            pg8::gemm_phase<EpiSwiGLU, pg8::StaticOrder, true, true, false>(lds, g, S, E, tid);
            if (ph == 6 && bx >= 128) WPREP_JOBS(1, 3, (bx - 128) * NWAVES + wave, (G - 128) * NWAVES);
        } break;
        case 8: if (PHMASK & (1<<8)) {
            pg8::Gemm g{XB, WCI, M, 3072, D, (size_t)3072 * D * 2}; pg8::StaticOrder S; S.init(M, 3072, G, bx);
#define BS_CI(u, t) bias_sum(BIAS5 + ((u).pm >> 5) * NKQ * 3072, 3072, (u).pn * 256 + (t))
            BUILD_TABS(S, RS_SSQ, BS_CI);
#undef BS_CI
            EpiConvIn E{CU, CB, (const LAS float*)(lds + RSTD_LDS), (const LAS float*)(lds + BIAS_LDS)};
            pg8::gemm_phase<EpiConvIn, pg8::StaticOrder, true, true, false>(lds, g, S, E, tid);
        } break;
        case 9: if (PHMASK & (1<<9)) {
            const float* cw = args.in[IN_CW];
            for (int st = bx * NTHR + tid; st < 128 * (M / 16); st += G * NTHR) {
                const int k = (st & 127) * 8, r0 = (st >> 7) * 16;
                float w0[8], w1[8], w2[8];
#pragma unroll
                for (int q = 0; q < 2; ++q) { const f32x4 a0 = *(const f32x4*)(cw + k + 4 * q), a1 = *(const f32x4*)(cw + D + k + 4 * q), a2 = *(const f32x4*)(cw + 2 * D + k + 4 * q);
#pragma unroll
                    for (int e = 0; e < 4; ++e) { w0[4 * q + e] = a0[e]; w1[4 * q + e] = a1[e]; w2[4 * q + e] = a2[e]; } }
#pragma unroll 1
                for (int hf = 0; hf < 2; ++hf) {
                    const int rb = r0 + 8 * hf;
                    const bool lo_ok = (rb & (SEQ - 1)) != 0, hi_ok = ((rb + 8) & (SEQ - 1)) != 0;
                    u32x4 cu[10], cb[8];
#pragma unroll
                    for (int i = 0; i < 10; ++i) { const int rr = rb - 1 + i; const bool ok = (i == 0) ? lo_ok : ((i == 9) ? hi_ok : true);
                        cu[i] = *(const u32x4*)(CU + (size_t)(ok ? rr : rb) * D + k); if (!ok) cu[i] = (u32x4){0u, 0u, 0u, 0u}; }
#pragma unroll
                    for (int i = 0; i < 8; ++i) cb[i] = *(const u32x4*)(CB + (size_t)(rb + i) * D + k);
#pragma unroll
                    for (int i = 0; i < 8; ++i) { float um[8], u0[8], up[8], bb[8], o[8]; unpack8(cu[i], um); unpack8(cu[i + 1], u0); unpack8(cu[i + 2], up); unpack8(cb[i], bb);
#pragma unroll
                        for (int q = 0; q < 8; ++q) o[q] = bb[q] * (w0[q] * um[q] + w1[q] * u0[q] + w2[q] * up[q]);
                        u32x4 w; w.x = pk2(o[0], o[1]); w.y = pk2(o[2], o[3]); w.z = pk2(o[4], o[5]); w.w = pk2(o[6], o[7]);
                        *(u32x4*)(ACV + (size_t)(rb + i) * D + k) = w; }
                }
            }
        } break;
        case 13: if (PHMASK & (1<<13)) {
            for (int v = bx * NTHR + tid; v < 2 * 131072; v += G * NTHR) {
                const int dir = v >> 17, w = v & 131071, bh_ = w >> 14, h = bh_ & 3;
                bf16* base = (dir ? SBB : SFB) + (size_t)bh_ * NSC * DV * DK + (size_t)(w & 16383) * 8;
                const float g512 = __builtin_amdgcn_exp2f(512.0f * __builtin_amdgcn_logf(1.0f - __builtin_amdgcn_exp2f(-(dir ? 5.5f : 5.0f) - (float)h)));
                u32x4 r[8];
#pragma unroll
                for (int k = 0; k < 8; ++k) r[k] = *(const u32x4*)(base + (size_t)(dir ? 7 - k : 8 + k) * DV * DK);
                float S[8]; unpack8(r[0], S);
#pragma unroll
                for (int k = 1; k < 8; ++k) { float f[8]; unpack8(r[k], f);
#pragma unroll
                    for (int e = 0; e < 8; ++e) S[e] = S[e] * g512 + f[e];
                    u32x4 o; o.x = pk2(S[0], S[1]); o.y = pk2(S[2], S[3]); o.z = pk2(S[4], S[5]); o.w = pk2(S[6], S[7]);
                    *(u32x4*)(base + (size_t)(dir ? 7 - k : 8 + k) * DV * DK) = o; }
            }
        } break;
        default: break;
        }
        if (ph0 < args.ph_hi) xcd_barrier(bar);
        if (SSVAR == 6 && ph == 6) { for (int e_ = 0; e_ < 10; ++e_) xcd_barrier(bar); }
    }
}

#ifndef MK_PER_PHASE
#define MK_PER_PHASE 0
#endif
extern "C" void kernel_launch(void* const* d_in, const int* in_sizes, int n_in, void* d_out, int out_size, void* d_ws, size_t ws_size, hipStream_t stream) {
    static int grid = 0;
    if (grid == 0) {
        if (n_in != N_IN || out_size != M * D || ws_size < WS_END) { fprintf(stderr, "kernel_launch: unexpected shapes (n_in %d, out %d, ws %zu); nothing launched\n", n_in, out_size, ws_size); grid = -1; return; }
        int dev = 0, cus = 0, per_cu = 0;
        if (hipGetDevice(&dev) != hipSuccess || hipDeviceGetAttribute(&cus, hipDeviceAttributeMultiprocessorCount, dev) != hipSuccess) { grid = -1; return; }
        if (hipFuncSetAttribute((const void*)fwd_kernel, hipFuncAttributeMaxDynamicSharedMemorySize, LDS_BYTES) != hipSuccess) { fprintf(stderr, "kernel_launch: hipFuncSetAttribute failed\n"); grid = -1; return; }
        if (hipOccupancyMaxActiveBlocksPerMultiprocessor(&per_cu, (const void*)fwd_kernel, NTHR, LDS_BYTES) != hipSuccess || per_cu < 1) { fprintf(stderr, "kernel_launch: occupancy query says %d blocks per CU\n", per_cu); }
        (void)hipGetLastError();
        grid = cus;
    }
    if (grid < 0) return;
    (void)hipMemsetAsync((char*)d_ws + WS_CTL, 0, CTL_ZERO_BYTES, stream);
    Args a{};
    for (int i = 0; i < N_IN; ++i) a.in[i] = (const float*)d_in[i];
    a.out = (float*)d_out; a.ws = (unsigned char*)d_ws;
#if MK_PER_PHASE
    for (int p = 0; p < NPH; ++p) { a.ph_lo = p; a.ph_hi = p + 1; hipLaunchKernelGGL(fwd_kernel, dim3(grid), dim3(NTHR), LDS_BYTES, stream, a); }
#else
    a.ph_lo = 0; a.ph_hi = NPH; hipLaunchKernelGGL(fwd_kernel, dim3(grid), dim3(NTHR), LDS_BYTES, stream, a);
#if SSVAR == 7
    (void)hipMemsetAsync((char*)d_ws + WS_CTL, 0, CTL_ZERO_BYTES, stream); hipLaunchKernelGGL(fwd_kernel, dim3(grid), dim3(NTHR), LDS_BYTES, stream, a);
#endif
#endif
}
```
